# Optimizing an MI355X kernel written in HIP

```python
import math
import jax, jax.numpy as jnp
from jax import lax
import numpy as np

D_MODEL = 1024
BATCH = 32
SEQ = 2048
DEPTH = 2
DEC_BATCH = 2
DEC_SEQ = 16384
PAST_LEN = 128

GRID_W = 64
HEAD_DIM = 64
EPS = 1e-6
NA_HEADS = 4
NA_WIN_ROWS = 8
NA_WIN_COLS = 16
NA_QCOLS = 16
NA_KCOLS = 32
S5_WIDTH = 256
S5_GROUP = 16
S5_GROUPS = S5_WIDTH // S5_GROUP
S5_STATE = 64
S5_DT_MIN = 1e-3
S5_DT_MAX = 1e-1
GQA_Q_HEADS = 4
GQA_KV_HEADS = 2
GQA_BLOCK = 128
ROPE_THETA = 10000.0
ROPE_AXIS_DIM = HEAD_DIM // 2
HGRN_HEADS = 4
HGRN_DK = 64
HGRN_DV = 64
HGRN_CHUNK = 64
MEM_TOKENS = 256
XA_HEADS = 4
XA_HEAD_DIM = 64
XA_W = XA_HEADS * XA_HEAD_DIM
D_FF = 2816
CONV_W = 3

NA_W = NA_HEADS * HEAD_DIM
GQA_W = GQA_Q_HEADS * HEAD_DIM
GQA_KV_W = GQA_KV_HEADS * HEAD_DIM
HGRN_KW = HGRN_HEADS * HGRN_DK
HGRN_W = HGRN_HEADS * HGRN_DV
MIX_W = NA_W + S5_WIDTH + GQA_W + HGRN_W
IN_SPLITS = (NA_W, NA_W, NA_W, S5_WIDTH, GQA_W, GQA_KV_W, GQA_KV_W, HGRN_KW, HGRN_KW, HGRN_KW, HGRN_W, HGRN_W)
IN_W = sum(IN_SPLITS)

kernel_name = "hybrid_bidir_na_s5_gqa_hgrn2_encoder"


def rms_norm(x, w):
    xf = x.astype(jnp.float32)
    y = xf * lax.rsqrt(jnp.mean(xf * xf, axis=-1, keepdims=True) + EPS)
    return y.astype(x.dtype) * w.astype(x.dtype)


def neighbourhood_attention(q, k, v, rpb):
    B, S, H, d = q.shape
    rows = S // GRID_W
    win_r = min(NA_WIN_ROWS, rows)
    qg = q.reshape(B, rows, GRID_W, H, d)
    kg = k.reshape(B, rows, GRID_W, H, d)
    vg = v.reshape(B, rows, GRID_W, H, d)
    r = np.arange(rows)
    r0 = np.clip(r - win_r // 2, 0, rows - win_r)
    row_idx = r0[:, None] + np.arange(win_r)[None, :]
    kr = kg[:, row_idx]
    vr = vg[:, row_idx]
    dr = row_idx - r[:, None] + (NA_WIN_ROWS - 1)
    scale = 1.0 / math.sqrt(d)
    outs = []
    for cb in range(GRID_W // NA_QCOLS):
        qs = cb * NA_QCOLS
        qcols = np.arange(qs, qs + NA_QCOLS)
        ks = int(np.clip(qs - NA_WIN_COLS // 2, 0, GRID_W - NA_KCOLS))
        kcols = np.arange(ks, ks + NA_KCOLS)
        c0 = np.clip(qcols - NA_WIN_COLS // 2, 0, GRID_W - NA_WIN_COLS)
        in_win = (kcols[None, :] >= c0[:, None]) & (kcols[None, :] < c0[:, None] + NA_WIN_COLS)
        dc = np.clip(kcols[None, :] - qcols[:, None], -(NA_WIN_COLS - 1), NA_WIN_COLS - 1) + (NA_WIN_COLS - 1)
        bias = rpb[:, dr[:, None, :, None], dc[None, :, None, :]]
        kb = kr[:, :, :, ks:ks + NA_KCOLS]
        vb = vr[:, :, :, ks:ks + NA_KCOLS]
        s = jnp.einsum('brqhd,brikhd->bhrqik', qg[:, :, qs:qs + NA_QCOLS], kb).astype(jnp.float32) * scale
        s = s + bias.astype(jnp.float32)[None]
        s = jnp.where(in_win[:, None, :], s, -jnp.inf)
        p = jax.nn.softmax(s.reshape(B, H, rows, NA_QCOLS, win_r * NA_KCOLS), axis=-1)
        p = p.reshape(s.shape).astype(v.dtype)
        outs.append(jnp.einsum('bhrqik,brikhd->brqhd', p, vb))
    o = jnp.concatenate(outs, axis=2)
    return o.reshape(B, S, H * d)


def s5_combine(e1, e2):
    a1r, a1i, b1r, b1i = e1
    a2r, a2i, b2r, b2i = e2
    return (a2r * a1r - a2i * a1i,
            a2r * a1i + a2i * a1r,
            a2r * b1r - a2i * b1i + b2r,
            a2r * b1i + a2i * b1r + b2i)


def s5_direction(u, lam_re, lam_im, log_dt, b_re, b_im, c_re, c_im):
    lre = jnp.minimum(lam_re.astype(jnp.float32), -1e-4)
    lim = lam_im.astype(jnp.float32)
    dt = jnp.exp(log_dt.astype(jnp.float32))[:, None]
    mag = jnp.exp(lre * dt)
    abar_re = mag * jnp.cos(lim * dt)
    abar_im = mag * jnp.sin(lim * dt)
    den = lre * lre + lim * lim
    nre = abar_re - 1.0
    nim = abar_im
    coef_re = (nre * lre + nim * lim) / den
    coef_im = (nim * lre - nre * lim) / den
    bre = b_re.astype(jnp.float32)
    bim = b_im.astype(jnp.float32)
    bbar_re = coef_re[..., None] * bre - coef_im[..., None] * bim
    bbar_im = coef_re[..., None] * bim + coef_im[..., None] * bre
    bu_re = jnp.einsum('bsgc,gnc->bsgn', u, bbar_re)
    bu_im = jnp.einsum('bsgc,gnc->bsgn', u, bbar_im)
    a_re = jnp.broadcast_to(abar_re, bu_re.shape)
    a_im = jnp.broadcast_to(abar_im, bu_im.shape)
    _, _, xr, xi = lax.associative_scan(s5_combine, (a_re, a_im, bu_re, bu_im), axis=1)
    return (jnp.einsum('bsgn,gcn->bsgc', xr, c_re.astype(jnp.float32))
            - jnp.einsum('bsgn,gcn->bsgc', xi, c_im.astype(jnp.float32)))


def s5_mixer(u, lam_re, lam_im, log_dt, b_re, b_im, c_re, c_im, d_skip, glu_w, glu_b):
    B, S, _ = u.shape
    uf = u.astype(jnp.float32)
    ug = uf.reshape(B, S, S5_GROUPS, S5_GROUP)
    y_f = s5_direction(ug, lam_re[0], lam_im[0], log_dt[0], b_re[0], b_im[0], c_re[0], c_im[0])
    y_b = jnp.flip(s5_direction(jnp.flip(ug, axis=1), lam_re[1], lam_im[1], log_dt[1],
                                b_re[1], b_im[1], c_re[1], c_im[1]), axis=1)
    y = (y_f + y_b).reshape(B, S, S5_WIDTH) + d_skip.astype(jnp.float32) * uf
    h = jax.nn.gelu(y).astype(u.dtype)
    return h * jax.nn.sigmoid(h @ glu_w + glu_b)


def axial_rope(S, dtype):
    t = jnp.arange(S)
    inv = 1.0 / (ROPE_THETA ** (jnp.arange(0, ROPE_AXIS_DIM, 2, dtype=jnp.float32) / ROPE_AXIS_DIM))
    ang = jnp.concatenate([(t // GRID_W).astype(jnp.float32)[:, None] * inv,
                           (t % GRID_W).astype(jnp.float32)[:, None] * inv], axis=-1)
    return jnp.cos(ang)[:, None, :].astype(dtype), jnp.sin(ang)[:, None, :].astype(dtype)


def apply_rope(x, cos, sin):
    x1 = x[..., :ROPE_AXIS_DIM]
    x2 = x[..., ROPE_AXIS_DIM:]
    return jnp.concatenate([x1 * cos - x2 * sin, x2 * cos + x1 * sin], axis=-1)


def gqa_axial(q, k, v, q_norm_w, k_norm_w):
    B, S, Hq, d = q.shape
    Hkv = k.shape[2]
    grp = Hq // Hkv
    cos, sin = axial_rope(S, q.dtype)
    q = apply_rope(rms_norm(q, q_norm_w), cos, sin)
    k = apply_rope(rms_norm(k, k_norm_w), cos, sin)
    nb = S // GQA_BLOCK
    qb = q.reshape(B, nb, GQA_BLOCK, Hkv, grp, d).transpose(1, 0, 2, 3, 4, 5)
    scale = 1.0 / math.sqrt(d)

    def attend_block(qi):
        s = jnp.einsum('bqhgd,bkhd->bhgqk', qi, k).astype(jnp.float32) * scale
        p = jax.nn.softmax(s, axis=-1).astype(v.dtype)
        return jnp.einsum('bhgqk,bkhd->bqhgd', p, v)

    o = lax.map(attend_block, qb)
    return o.transpose(1, 0, 2, 3, 4, 5).reshape(B, S, Hq * d)


def hgrn2_lower_bounds(lb_param):
    sm = jax.nn.softmax(lb_param.astype(jnp.float32), axis=0)
    return jnp.concatenate([jnp.zeros_like(sm[:1]), jnp.cumsum(sm, axis=0)[:-1]], axis=0)


def hgrn2_scan(q, logf, kin, v):
    B, S, H, dk = q.shape
    dv = v.shape[-1]
    C = HGRN_CHUNK
    nc = S // C

    def to_chunks(a):
        return a.reshape(B, nc, C, H, a.shape[-1]).transpose(1, 0, 3, 2, 4)

    tri = jnp.tril(jnp.ones((C, C), dtype=bool))

    def step(state, xs):
        qc, lfc, kc, vc = xs
        b = jnp.cumsum(lfc, axis=2)
        o_inter = jnp.einsum('bhtk,bhkv->bhtv', qc * jnp.exp(b), state)
        diff = b[:, :, :, None, :] - b[:, :, None, :, :]
        decay = jnp.exp(jnp.where(tri[:, :, None], diff, -jnp.inf))
        att = jnp.einsum('bhtsk,bhsk->bhts', decay * qc[:, :, :, None, :], kc)
        o_intra = jnp.einsum('bhts,bhsv->bhtv', att, vc)
        b_last = b[:, :, -1:, :]
        new_state = (jnp.exp(b_last[:, :, 0, :])[..., None] * state
                     + jnp.einsum('bhsk,bhsv->bhkv', kc * jnp.exp(b_last - b), vc))
        return new_state, o_inter + o_intra

    state0 = jnp.zeros((B, H, dk, dv), dtype=jnp.float32)
    _, o = lax.scan(step, state0, (to_chunks(q), to_chunks(logf), to_chunks(kin), to_chunks(v)))
    return o.transpose(1, 0, 3, 2, 4).reshape(B, S, H, dv)


def hgrn2_bidir(q, zf_fwd, zf_bwd, v, lb):
    B, S, _ = q.shape
    q4 = q.astype(jnp.float32).reshape(B, S, HGRN_HEADS, HGRN_DK)
    v4 = v.astype(jnp.float32).reshape(B, S, HGRN_HEADS, HGRN_DV)
    lbf = lb.astype(jnp.float32).reshape(HGRN_HEADS, HGRN_DK)

    def gates(z):
        z4 = z.astype(jnp.float32).reshape(B, S, HGRN_HEADS, HGRN_DK)
        logf = jnp.logaddexp(jnp.log(lbf), jnp.log1p(-lbf) + jax.nn.log_sigmoid(z4))
        kin = (1.0 - lbf) * jax.nn.sigmoid(-z4)
        return logf, kin

    lf_f, k_f = gates(zf_fwd)
    lf_b, k_b = gates(zf_bwd)
    o_f = hgrn2_scan(q4, lf_f, k_f, v4)
    o_b = jnp.flip(hgrn2_scan(jnp.flip(q4, 1), jnp.flip(lf_b, 1), jnp.flip(k_b, 1), jnp.flip(v4, 1)), 1)
    return (o_f + o_b).reshape(B, S, HGRN_W).astype(q.dtype)


def token_mixer(h, w_in, na_rpb, s5_lambda_re, s5_lambda_im, s5_log_dt, s5_b_re, s5_b_im,
                s5_c_re, s5_c_im, s5_d, s5_glu_w, s5_glu_b, gqa_q_norm_w, gqa_k_norm_w,
                hgrn_lb, mix_out_norm_w, w_out):
    B, S, _ = h.shape
    proj = h @ w_in
    offs = [int(i) for i in np.cumsum(IN_SPLITS)[:-1]]
    qa, ka, va, ub, qc, kc, vc, qd, zf_f, zf_b, vd, gd = jnp.split(proj, offs, axis=-1)
    o_a = neighbourhood_attention(qa.reshape(B, S, NA_HEADS, HEAD_DIM), ka.reshape(B, S, NA_HEADS, HEAD_DIM),
                                  va.reshape(B, S, NA_HEADS, HEAD_DIM), na_rpb)
    o_b = s5_mixer(ub, s5_lambda_re, s5_lambda_im, s5_log_dt, s5_b_re, s5_b_im, s5_c_re, s5_c_im,
                   s5_d, s5_glu_w, s5_glu_b)
    o_c = gqa_axial(qc.reshape(B, S, GQA_Q_HEADS, HEAD_DIM), kc.reshape(B, S, GQA_KV_HEADS, HEAD_DIM),
                    vc.reshape(B, S, GQA_KV_HEADS, HEAD_DIM), gqa_q_norm_w, gqa_k_norm_w)
    o_d = hgrn2_bidir(qd, zf_f, zf_b, vd, hgrn_lb)
    g_a, g_b, g_c, g_d = jnp.split(mix_out_norm_w, [NA_W, NA_W + S5_WIDTH, NA_W + S5_WIDTH + GQA_W])
    merged = jnp.concatenate([rms_norm(o_a, g_a), rms_norm(o_b, g_b), rms_norm(o_c, g_c),
                              rms_norm(o_d, g_d) * jax.nn.silu(gd)], axis=-1)
    return merged @ w_out


def memory_cross_attention(h, mem, norm_mem_w, w_q, w_kv, w_o):
    B, S, _ = h.shape
    M = mem.shape[1]
    mn = rms_norm(mem, norm_mem_w)
    q = (h @ w_q).reshape(B, S, XA_HEADS, XA_HEAD_DIM)
    k, v = jnp.split(mn @ w_kv, 2, axis=-1)
    k = k.reshape(B, M, XA_HEADS, XA_HEAD_DIM)
    v = v.reshape(B, M, XA_HEADS, XA_HEAD_DIM)
    s = jnp.einsum('bshd,bmhd->bhsm', q, k).astype(jnp.float32) / math.sqrt(XA_HEAD_DIM)
    p = jax.nn.softmax(s, axis=-1).astype(v.dtype)
    o = jnp.einsum('bhsm,bmhd->bshd', p, v).reshape(B, S, XA_W)
    return o @ w_o


def conv_glu_ffn(h, w_up, conv_w, conv_b, w_down):
    S = h.shape[1]
    a, g = jnp.split(h @ w_up, 2, axis=-1)
    pad = CONV_W // 2
    gp = jnp.pad(g, ((0, 0), (pad, pad), (0, 0)))
    gc = conv_b + gp[:, 0:S] * conv_w[0]
    for j in range(1, CONV_W):
        gc = gc + gp[:, j:j + S] * conv_w[j]
    return (jax.nn.silu(gc) * a) @ w_down


def encode(x, mem, norm_mix_w, w_in, na_rpb, s5_lambda_re, s5_lambda_im, s5_log_dt, s5_b_re, s5_b_im,
           s5_c_re, s5_c_im, s5_d, s5_glu_w, s5_glu_b, gqa_q_norm_w, gqa_k_norm_w, hgrn_lower_bound,
           mix_out_norm_w, w_out, norm_xattn_w, norm_mem_w, xattn_w_q, xattn_w_kv, xattn_w_o,
           norm_ffn_w, ffn_w_up, ffn_conv_w, ffn_conv_b, ffn_w_down, final_norm_w):
    lb_all = hgrn2_lower_bounds(hgrn_lower_bound)
    for l in range(DEPTH):
        x = x + token_mixer(rms_norm(x, norm_mix_w[l]), w_in[l], na_rpb[l], s5_lambda_re[l], s5_lambda_im[l],
                            s5_log_dt[l], s5_b_re[l], s5_b_im[l], s5_c_re[l], s5_c_im[l], s5_d[l],
                            s5_glu_w[l], s5_glu_b[l], gqa_q_norm_w[l], gqa_k_norm_w[l], lb_all[l],
                            mix_out_norm_w[l], w_out[l])
        x = x + memory_cross_attention(rms_norm(x, norm_xattn_w[l]), mem, norm_mem_w[l],
                                       xattn_w_q[l], xattn_w_kv[l], xattn_w_o[l])
        x = x + conv_glu_ffn(rms_norm(x, norm_ffn_w[l]), ffn_w_up[l], ffn_conv_w[l], ffn_conv_b[l], ffn_w_down[l])
    return rms_norm(x, final_norm_w)


def setup_inputs(seed: int = 0) -> dict:
    key = jax.random.key(seed)
    ks = iter(jax.random.split(key, 48))
    f32 = jnp.float32

    def nrm(shape, scale):
        return jax.random.normal(next(ks), shape, f32) * scale

    def gain(shape):
        return 1.0 + 0.05 * jax.random.normal(next(ks), shape, f32)

    L = DEPTH
    lam_im_base = math.pi * jnp.arange(S5_STATE, dtype=f32)
    return {
        "x_prompt": nrm((BATCH, SEQ, D_MODEL), 1.0),
        "x_sample": nrm((DEC_BATCH, DEC_SEQ, D_MODEL), 1.0),
        "mem_prompt": nrm((BATCH, MEM_TOKENS, D_MODEL), 1.0),
        "mem_sample": nrm((DEC_BATCH, MEM_TOKENS, D_MODEL), 1.0),
        "norm_mix_w": gain((L, D_MODEL)),
        "w_in": nrm((L, D_MODEL, IN_W), D_MODEL ** -0.5),
        "na_rpb": nrm((L, NA_HEADS, 2 * NA_WIN_ROWS - 1, 2 * NA_WIN_COLS - 1), 0.1),
        "s5_lambda_re": -0.5 + nrm((L, 2, S5_GROUPS, S5_STATE), 0.01),
        "s5_lambda_im": lam_im_base + nrm((L, 2, S5_GROUPS, S5_STATE), 0.01),
        "s5_log_dt": jax.random.uniform(next(ks), (L, 2, S5_GROUPS), f32,
                                        math.log(S5_DT_MIN), math.log(S5_DT_MAX)),
        "s5_b_re": nrm((L, 2, S5_GROUPS, S5_STATE, S5_GROUP), (2 * S5_GROUP) ** -0.5),
        "s5_b_im": nrm((L, 2, S5_GROUPS, S5_STATE, S5_GROUP), (2 * S5_GROUP) ** -0.5),
        "s5_c_re": nrm((L, 2, S5_GROUPS, S5_GROUP, S5_STATE), (2 * S5_STATE) ** -0.5),
        "s5_c_im": nrm((L, 2, S5_GROUPS, S5_GROUP, S5_STATE), (2 * S5_STATE) ** -0.5),
        "s5_d": nrm((L, S5_WIDTH), 1.0),
        "s5_glu_w": nrm((L, S5_WIDTH, S5_WIDTH), S5_WIDTH ** -0.5),
        "s5_glu_b": nrm((L, S5_WIDTH), 0.01),
        "gqa_q_norm_w": gain((L, HEAD_DIM)),
        "gqa_k_norm_w": gain((L, HEAD_DIM)),
        "hgrn_lower_bound": nrm((L, HGRN_KW), 0.5),
        "mix_out_norm_w": gain((L, MIX_W)),
        "w_out": nrm((L, MIX_W, D_MODEL), MIX_W ** -0.5),
        "norm_xattn_w": gain((L, D_MODEL)),
        "norm_mem_w": gain((L, D_MODEL)),
        "xattn_w_q": nrm((L, D_MODEL, XA_W), D_MODEL ** -0.5),
        "xattn_w_kv": nrm((L, D_MODEL, 2 * XA_W), D_MODEL ** -0.5),
        "xattn_w_o": nrm((L, XA_W, D_MODEL), XA_W ** -0.5),
        "norm_ffn_w": gain((L, D_MODEL)),
        "ffn_w_up": nrm((L, D_MODEL, 2 * D_FF), D_MODEL ** -0.5),
        "ffn_conv_w": nrm((L, CONV_W, D_FF), CONV_W ** -0.5),
        "ffn_conv_b": nrm((L, D_FF), 0.01),
        "ffn_w_down": nrm((L, D_FF, D_MODEL), D_FF ** -0.5),
        "final_norm_w": gain((D_MODEL,)),
    }


def reference(x_prompt, x_sample, mem_prompt, mem_sample, norm_mix_w, w_in, na_rpb, s5_lambda_re, s5_lambda_im,
              s5_log_dt, s5_b_re, s5_b_im, s5_c_re, s5_c_im, s5_d, s5_glu_w, s5_glu_b, gqa_q_norm_w,
              gqa_k_norm_w, hgrn_lower_bound, mix_out_norm_w, w_out, norm_xattn_w, norm_mem_w, xattn_w_q,
              xattn_w_kv, xattn_w_o, norm_ffn_w, ffn_w_up, ffn_conv_w, ffn_conv_b, ffn_w_down, final_norm_w):
    y_prompt = encode(x_prompt, mem_prompt, norm_mix_w, w_in, na_rpb, s5_lambda_re, s5_lambda_im, s5_log_dt,
                      s5_b_re, s5_b_im, s5_c_re, s5_c_im, s5_d, s5_glu_w, s5_glu_b, gqa_q_norm_w, gqa_k_norm_w,
                      hgrn_lower_bound, mix_out_norm_w, w_out, norm_xattn_w, norm_mem_w, xattn_w_q, xattn_w_kv,
                      xattn_w_o, norm_ffn_w, ffn_w_up, ffn_conv_w, ffn_conv_b, ffn_w_down, final_norm_w)
    y_sample = encode(x_sample, mem_sample, norm_mix_w, w_in, na_rpb, s5_lambda_re, s5_lambda_im, s5_log_dt,
                      s5_b_re, s5_b_im, s5_c_re, s5_c_im, s5_d, s5_glu_w, s5_glu_b, gqa_q_norm_w, gqa_k_norm_w,
                      hgrn_lower_bound, mix_out_norm_w, w_out, norm_xattn_w, norm_mem_w, xattn_w_q, xattn_w_kv,
                      xattn_w_o, norm_ffn_w, ffn_w_up, ffn_conv_w, ffn_conv_b, ffn_w_down, final_norm_w)
    return (y_prompt, y_sample)
```

```cpp
#include <hip/hip_runtime.h>
#include <hip/hip_cooperative_groups.h>
#include <hip/hip_bf16.h>
#include <cstdio>
#include <cstdint>
#include <cmath>
namespace cg = cooperative_groups;
namespace pg8 {
#define PG8_LAS __attribute__((address_space(3)))
typedef unsigned short bf16_t;
typedef short bf16x8 __attribute__((ext_vector_type(8)));
typedef float f32x4 __attribute__((ext_vector_type(4)));
typedef unsigned u32x4 __attribute__((ext_vector_type(4)));
constexpr int BM = 256, BK = 64, HALF = 128, HTB = HALF * BK * 2  , STAGE_BYTES = 8 * HTB, NXCD = 8, WGM = 8;

__host__ __device__ __forceinline__ int lds_byte(int r, int c) { const int st = (r >> 4) * 2 + (c >> 5), rr = r & 15, cc = c & 31, ob = rr * 64 + cc * 2; return st * 1024 + (ob ^ (((ob >> 9) & 1) << 5)); }
__host__ __device__ __forceinline__ void stage_rc(int b, int& R, int& C) { const int st = b / 1024, sb = b % 1024, swz = sb ^ (((sb >> 9) & 1) << 5); R = (st >> 1) * 16 + swz / 64; C = (st & 1) * 32 + (swz % 64) / 2; }
__host__ __device__ __forceinline__ int perm32(int rho) { const int n = rho >> 4, i = rho & 15; return 8 * (i >> 2) + 4 * n + (i & 3); }

struct Unit { int pm, pn; };
struct Gemm { const bf16_t* A; const bf16_t* Bt; int M, N, K; };

struct StaticOrder {
    int nM, nN, nwg, G, c;
    __host__ __device__ void init(int M, int N, int G_, int c_) { nM = M / BM; nN = N / BM; nwg = nM * nN; G = G_; c = c_; }
    __host__ __device__ bool next(int i, Unit& u) const {
        const long L = (long)i * G + c; if (L >= nwg) return false;
        int wgid = (int)L; { const int q = nwg / NXCD, r = nwg % NXCD, xcd = wgid % NXCD, off = wgid / NXCD; wgid = (xcd < r ? xcd * (q + 1) : r * (q + 1) + (xcd - r) * q) + off; }
        const int nig = WGM * nN, gid = wgid / nig, fm = gid * WGM, gsz = (nM - fm) < WGM ? (nM - fm) : WGM;
        u.pm = fm + ((wgid % nig) % gsz); u.pn = (wgid % nig) / gsz; return true;
    }
    __device__ __forceinline__ void a_ready(const Unit&) const {}
    __device__ __forceinline__ void done(const Unit&) const {}
};

__device__ __forceinline__ unsigned cvt_pk_bf16(float lo, float hi) { typedef float f2_t __attribute__((ext_vector_type(2))); typedef __bf16 b2_t __attribute__((ext_vector_type(2))); f2_t v = {lo, hi}; b2_t b = __builtin_convertvector(v, b2_t); return __builtin_bit_cast(unsigned, b); }
template <class Epi, class Sched, bool ALIGN_EPI, bool SP2, int KC, int LDA = KC>
__device__ __forceinline__ void gemm_phase(PG8_LAS unsigned char* lds, const Gemm g, const Sched& S, const Epi& E) {
    int tid_ = threadIdx.x; asm volatile("" : "+v"(tid_)); const int tid = tid_, wid = __builtin_amdgcn_readfirstlane(tid >> 6), lane = tid & 63, wr = wid >> 2, wc = wid & 3, fr = lane & 15, fq = lane >> 4;
    constexpr int K = KC, nt = K / BK;
    unsigned voffA[2], voffB[2];
#pragma unroll
    for (int i = 0; i < 2; ++i) { int R, C; stage_rc(tid * 16 + i * 8192, R, C); const int Rb = Epi::PERM ? ((R & ~31) + perm32(R & 31)) : R;
        voffA[i] = (unsigned)(R * LDA + C) * 2u; voffB[i] = (unsigned)(Rb * K + C) * 2u; }
    const size_t kstep = (size_t)(BK * 2);
    const size_t hstep = (size_t)HALF * K * 2;
    const size_t tstep = 2 * hstep; const size_t hstepA = (size_t)HALF * LDA * 2, tstepA = 2 * hstepA;
    const unsigned ldsw = (unsigned)wid * 1024u;
    const int aoff = lds_byte(wr * 64 + fr, fq * 8), boff = lds_byte(wc * 32 + fr, fq * 8);
#define PG8_SA(b, h) (((b) * 2 + (h)) * HTB)
#define PG8_SB(b, h) ((4 + (b) * 2 + (h)) * HTB)
#define PG8_STAGE(bufoff, gbase, voff) do { _Pragma("unroll") for (int _i = 0; _i < 2; ++_i) \
        __builtin_amdgcn_global_load_lds((const unsigned*)((const char*)(gbase) + (voff)[_i]), (PG8_LAS unsigned*)(lds + (bufoff) + ldsw + _i * 8192), 16, 0, 0); } while (0)
#define PG8_LDA(dst, b, h) do { _Pragma("unroll") for (int m = 0; m < 4; ++m) _Pragma("unroll") for (int k = 0; k < 2; ++k) dst[m][k] = *(const PG8_LAS bf16x8*)(lds + PG8_SA(b, h) + aoff + m * 2048 + k * 1024); } while (0)
#define PG8_LDB(dst, b, h) do { _Pragma("unroll") for (int n = 0; n < 2; ++n) _Pragma("unroll") for (int k = 0; k < 2; ++k) dst[n][k] = *(const PG8_LAS bf16x8*)(lds + PG8_SB(b, h) + boff + n * 2048 + k * 1024); } while (0)
#define PG8_MMA(ai, bj, At, Bt) do { __builtin_amdgcn_s_setprio(1); _Pragma("unroll") for (int m = 0; m < 4; ++m) _Pragma("unroll") for (int n = 0; n < 2; ++n) _Pragma("unroll") for (int k = 0; k < 2; ++k) \
        acc[ai][bj][m][n] = __builtin_amdgcn_mfma_f32_16x16x32_bf16(Bt[n][k], At[m][k], acc[ai][bj][m][n], 0, 0, 0); __builtin_amdgcn_s_setprio(0); } while (0)
#define PG8_WAIT_V(n) asm volatile("s_waitcnt vmcnt(" #n ")" ::: "memory")
#define PG8_WAIT_L(n) asm volatile("s_waitcnt lgkmcnt(" #n ")" ::: "memory")
#define PG8_BAR __builtin_amdgcn_s_barrier()
#define PG8_SCHED __builtin_amdgcn_sched_barrier(0)
    Unit cur, nxt; int ui = 0;
    if (!S.next(0, cur)) return;
    f32x4 acc[2][2][4][2];
#pragma unroll
    for (int a = 0; a < 2; ++a)
#pragma unroll
        for (int b = 0; b < 2; ++b)
#pragma unroll
            for (int m = 0; m < 4; ++m)
#pragma unroll
                for (int n = 0; n < 2; ++n) acc[a][b][m][n] = (f32x4){0.f, 0.f, 0.f, 0.f};
    bf16x8 At[4][2], B0[2][2], B1[2][2];
    const char* cA = (const char*)g.A + (size_t)cur.pm * tstepA; const char* cB = (const char*)g.Bt + (size_t)cur.pn * tstep;
    S.a_ready(cur);
    if constexpr (SP2) {
        PG8_STAGE(PG8_SB(0, 0), cB, voffB); PG8_STAGE(PG8_SB(0, 1), cB + hstep, voffB); PG8_STAGE(PG8_SA(0, 0), cA, voffA); PG8_STAGE(PG8_SA(0, 1), cA + hstepA, voffA);
        if (wr == 1) PG8_BAR;
        PG8_WAIT_V(2); PG8_BAR;
        PG8_STAGE(PG8_SB(1, 0), cB + kstep, voffB); PG8_STAGE(PG8_SA(1, 0), cA + kstep, voffA); PG8_STAGE(PG8_SB(1, 1), cB + hstep + kstep, voffB);
        PG8_WAIT_V(6); PG8_BAR;
    } else {
        PG8_STAGE(PG8_SB(0, 0), cB, voffB); PG8_STAGE(PG8_SA(0, 0), cA, voffA); PG8_STAGE(PG8_SB(0, 1), cB + hstep, voffB); PG8_STAGE(PG8_SA(0, 1), cA + hstepA, voffA);
        if (wr == 1) PG8_BAR;
        PG8_WAIT_V(4); PG8_BAR;
        PG8_STAGE(PG8_SB(1, 0), cB + kstep, voffB); PG8_STAGE(PG8_SA(1, 0), cA + kstep, voffA); PG8_STAGE(PG8_SB(1, 1), cB + hstep + kstep, voffB);
        PG8_WAIT_V(6); PG8_BAR;
    }
    for (;;) {
        const bool has_next = S.next(ui + 1, nxt);
        const char* nA = has_next ? (const char*)g.A + (size_t)nxt.pm * tstepA : cA; const char* nB = has_next ? (const char*)g.Bt + (size_t)nxt.pn * tstep : cB;
#pragma nounroll
        for (int t = 0; t < nt; t += 2) {
            const bool last = (t == nt - 2);
            const char* a1 = cA + (size_t)(t + 1) * kstep;
            const char* a2 = last ? nA : cA + (size_t)(t + 2) * kstep; const char* b2 = last ? nB : cB + (size_t)(t + 2) * kstep;
            const char* a3 = a2 + kstep; const char* b3 = b2 + kstep;
            if (last && has_next) S.a_ready(nxt);
            if constexpr (SP2) {
            PG8_LDB(B0, 0, 0); PG8_LDB(B1, 0, 1); PG8_SCHED; PG8_LDA(At, 0, 0); PG8_STAGE(PG8_SA(1, 1), a1 + hstepA, voffA);
            PG8_WAIT_V(8); PG8_WAIT_L(0); PG8_BAR; PG8_MMA(0, 0, At, B0); PG8_MMA(0, 1, At, B1); PG8_BAR; PG8_SCHED;
            PG8_LDA(At, 0, 1); PG8_STAGE(PG8_SB(0, 0), b2, voffB); PG8_STAGE(PG8_SB(0, 1), b2 + hstep, voffB); PG8_STAGE(PG8_SA(0, 0), a2, voffA);
            PG8_WAIT_V(8); PG8_WAIT_L(0); PG8_BAR; PG8_MMA(1, 0, At, B0); PG8_MMA(1, 1, At, B1); PG8_BAR; PG8_SCHED;
            PG8_LDB(B0, 1, 0); PG8_LDB(B1, 1, 1); PG8_SCHED; PG8_LDA(At, 1, 0); PG8_STAGE(PG8_SA(0, 1), a2 + hstepA, voffA);
            PG8_WAIT_V(8); PG8_WAIT_L(0); PG8_BAR; PG8_MMA(0, 0, At, B0); PG8_MMA(0, 1, At, B1); PG8_BAR; PG8_SCHED;
            PG8_LDA(At, 1, 1); PG8_STAGE(PG8_SB(1, 0), b3, voffB); PG8_STAGE(PG8_SB(1, 1), b3 + hstep, voffB); PG8_STAGE(PG8_SA(1, 0), a3, voffA);
            PG8_WAIT_V(8); PG8_WAIT_L(0); PG8_BAR; PG8_MMA(1, 0, At, B0); PG8_MMA(1, 1, At, B1); PG8_BAR; PG8_SCHED;
            } else {
            PG8_LDB(B0, 0, 0); PG8_SCHED; PG8_LDA(At, 0, 0); PG8_STAGE(PG8_SA(1, 1), a1 + hstepA, voffA);
            PG8_WAIT_L(8); PG8_BAR; PG8_WAIT_L(0); PG8_MMA(0, 0, At, B0); PG8_BAR; PG8_SCHED;
            PG8_LDB(B1, 0, 1); PG8_STAGE(PG8_SB(0, 0), b2, voffB);
            PG8_BAR; PG8_WAIT_L(0); PG8_MMA(0, 1, At, B1); PG8_BAR;
            PG8_LDA(At, 0, 1); PG8_STAGE(PG8_SA(0, 0), a2, voffA);
            PG8_BAR; PG8_WAIT_L(0); PG8_MMA(1, 0, At, B0); PG8_BAR; PG8_SCHED;
            PG8_STAGE(PG8_SB(0, 1), b2 + hstep, voffB);
            PG8_WAIT_V(6); PG8_BAR; PG8_MMA(1, 1, At, B1); PG8_BAR;
            PG8_LDB(B0, 1, 0); PG8_SCHED; PG8_LDA(At, 1, 0); PG8_STAGE(PG8_SA(0, 1), a2 + hstepA, voffA);
            PG8_WAIT_L(8); PG8_BAR; PG8_WAIT_L(0); PG8_MMA(0, 0, At, B0); PG8_BAR; PG8_SCHED;
            PG8_LDB(B1, 1, 1); PG8_STAGE(PG8_SB(1, 0), b3, voffB);
            PG8_BAR; PG8_WAIT_L(0); PG8_MMA(0, 1, At, B1); PG8_BAR;
            PG8_LDA(At, 1, 1); PG8_STAGE(PG8_SA(1, 0), a3, voffA);
            PG8_BAR; PG8_WAIT_L(0); PG8_MMA(1, 0, At, B0); PG8_BAR; PG8_SCHED;
            PG8_STAGE(PG8_SB(1, 1), b3 + hstep, voffB);
            PG8_WAIT_V(6); PG8_BAR; PG8_MMA(1, 1, At, B1); PG8_BAR;
            }
        }
        if constexpr (ALIGN_EPI) { if (wr == 0) PG8_BAR; }
        if constexpr (!Epi::AFTER_DRAIN) { E(acc, cur, wr, wc, fr, fq); S.done(cur); }
        if (!has_next) break;
#pragma unroll
        for (int a = 0; a < 2; ++a)
#pragma unroll
            for (int b = 0; b < 2; ++b)
#pragma unroll
                for (int m = 0; m < 4; ++m)
#pragma unroll
                    for (int n = 0; n < 2; ++n) acc[a][b][m][n] = (f32x4){0.f, 0.f, 0.f, 0.f};
        cur = nxt; cA = nA; cB = nB; ++ui;
        if constexpr (ALIGN_EPI) { if (wr == 1) PG8_BAR; }
    }
    PG8_WAIT_V(0);
    if constexpr (!ALIGN_EPI) { if (wr == 0) PG8_BAR; }
    PG8_BAR;
    if constexpr (Epi::AFTER_DRAIN) { E.fused(acc, cur, wr, wc, fr, fq, lds, wid, lane); S.done(cur); }
#undef PG8_SA
#undef PG8_SB
#undef PG8_STAGE
#undef PG8_LDA
#undef PG8_LDB
#undef PG8_MMA
#undef PG8_WAIT_V
#undef PG8_WAIT_L
#undef PG8_BAR
#undef PG8_SCHED
}
}
namespace attn_body {
using bf16=__hip_bfloat16;
using bf16x8=__attribute__((ext_vector_type(8)))short;
using s16x4=__attribute__((ext_vector_type(4)))short;
using f32x16=__attribute__((ext_vector_type(16)))float;
using u32x4=__attribute__((ext_vector_type(4)))unsigned;
constexpr int D=64;
constexpr int NW=8,QBLK=32,QB=QBLK*NW,KVBLK=64;
constexpr int KVP=2816,QP=2816,OP=2816;
__device__ __forceinline__ int crow(int r,int hi){return (r&3)+8*(r>>2)+4*hi;}
#define SBAR() __builtin_amdgcn_sched_barrier(0)
constexpr int NSLOT=3, SLOTB=8192;
constexpr int LDS_K=0, LDS_V=NSLOT*SLOTB, LDS_WS=2*NSLOT*SLOTB, LDS_OST=LDS_WS+NW*64*4, LDS_BYTES=LDS_OST+NW*4096;
constexpr float C2=0.125f*1.4426950408889634f;
__device__ __forceinline__ void glds16(const void*gsrc,unsigned lds_dst){unsigned keep;
  asm volatile("s_mov_b32 %0, m0\n\ts_mov_b32 m0, %2\n\ts_nop 0\n\tglobal_load_lds_dwordx4 %1, off\n\ts_mov_b32 m0, %0":"=&s"(keep):"v"(gsrc),"s"(lds_dst):"memory");}
__device__ __forceinline__ float max3f(float a,float b,float c){float r;asm("v_max3_f32 %0, %1, %2, %3":"=v"(r):"v"(a),"v"(b),"v"(c));return r;}
__device__ __forceinline__ float max2f(float a,float b){float r;asm("v_max_f32_e32 %0, %1, %2":"=v"(r):"v"(a),"v"(b));return r;}
__device__ __forceinline__ float fadd_s(float a,float b){float r;asm("v_add_f32_e32 %0, %1, %2":"=v"(r):"v"(a),"v"(b));return r;}
__device__ __forceinline__ float fsub_s(float a,float b){float r;asm("v_sub_f32_e32 %0, %1, %2":"=v"(r):"v"(a),"v"(b));return r;}
typedef float f32x2_t __attribute__((ext_vector_type(2))); typedef __bf16 bf16x2_t __attribute__((ext_vector_type(2)));
__device__ __forceinline__ unsigned cvtpk_s(float lo,float hi){f32x2_t v={lo,hi};bf16x2_t b=__builtin_convertvector(v,bf16x2_t);return __builtin_bit_cast(unsigned,b);}
#define WAIT_BAR(N) asm volatile("s_waitcnt vmcnt(" #N ") lgkmcnt(0)\n\ts_barrier":::"memory")

__device__ __forceinline__ void qkt(f32x16&p0,f32x16&p1,const char*Kslot,const bf16x8*qr,const f32x16&negm,int r32,int hi){
  const char*kb=Kslot+hi*1024+r32*16;
  #pragma unroll
  for(int d0=0;d0<4;++d0){
    const bf16x8 b0=*reinterpret_cast<const bf16x8*>(kb+d0*2048);
    const bf16x8 b1=*reinterpret_cast<const bf16x8*>(kb+d0*2048+512);
    if(d0==0){p0=__builtin_amdgcn_mfma_f32_32x32x16_bf16(b0,qr[0],negm,0,0,0);p1=__builtin_amdgcn_mfma_f32_32x32x16_bf16(b1,qr[0],negm,0,0,0);}
    else{p0=__builtin_amdgcn_mfma_f32_32x32x16_bf16(b0,qr[d0],p0,0,0,0);p1=__builtin_amdgcn_mfma_f32_32x32x16_bf16(b1,qr[d0],p1,0,0,0);}}
}
typedef __attribute__((address_space(3))) const char* lds_cptr;
typedef short v4i16_t __attribute__((ext_vector_type(4)));
__device__ __forceinline__ void kload8(bf16x8*kf,lds_cptr kp){
  kf[0]=*(const __attribute__((address_space(3))) bf16x8*)(kp);      kf[1]=*(const __attribute__((address_space(3))) bf16x8*)(kp+512);
  kf[2]=*(const __attribute__((address_space(3))) bf16x8*)(kp+2048); kf[3]=*(const __attribute__((address_space(3))) bf16x8*)(kp+2560);
  kf[4]=*(const __attribute__((address_space(3))) bf16x8*)(kp+4096); kf[5]=*(const __attribute__((address_space(3))) bf16x8*)(kp+4608);
  kf[6]=*(const __attribute__((address_space(3))) bf16x8*)(kp+6144); kf[7]=*(const __attribute__((address_space(3))) bf16x8*)(kp+6656);
}
__device__ __forceinline__ void kload2(bf16x8*kf,lds_cptr kp,int j){ kf[2*j]=*(const __attribute__((address_space(3))) bf16x8*)(kp+j*2048); kf[2*j+1]=*(const __attribute__((address_space(3))) bf16x8*)(kp+j*2048+512); }
__device__ __forceinline__ s16x4 vtr(lds_cptr p){ return __builtin_bit_cast(s16x4,__builtin_amdgcn_ds_read_tr16_b64_v4i16((__attribute__((address_space(3))) v4i16_t*)p)); }
__device__ __forceinline__ float rowmax(const f32x16&p0,const f32x16&p1){
  float a=max3f(p0[0],p0[1],p1[0]),b=max3f(p0[2],p0[3],p1[1]);a=max3f(a,p1[2],p1[3]);
  #pragma unroll
  for(int r=4;r<16;r+=4){a=max3f(a,p0[r],p0[r+1]);b=max3f(b,p0[r+2],p0[r+3]);a=max3f(a,p1[r],p1[r+1]);b=max3f(b,p1[r+2],p1[r+3]);}
  const float m=max2f(a,b);
  auto rr=__builtin_amdgcn_permlane32_swap(__float_as_uint(m),__float_as_uint(m),false,false);
  return max2f(__uint_as_float(rr[0]),__uint_as_float(rr[1]));
}
__device__ __forceinline__ void pv(f32x16*o,int vb,bf16x8 pa0,bf16x8 pa1,bf16x8 pa2,bf16x8 pa3){
  #pragma unroll
  for(int d0=0;d0<2;++d0){s16x4 lo[4],hi[4];
    #pragma unroll
    for(int ks=0;ks<4;++ks){
      asm volatile("ds_read_b64_tr_b16 %0,%1 offset:%c2":"=&v"(lo[ks]):"v"(vb),"i"(d0*4096+ks*1024):"memory");
      asm volatile("ds_read_b64_tr_b16 %0,%1 offset:%c2":"=&v"(hi[ks]):"v"(vb),"i"(d0*4096+ks*1024+512):"memory");}
    asm volatile("s_waitcnt lgkmcnt(0)":::"memory");SBAR();
    #define PK(k) (bf16x8){lo[k][0],lo[k][1],lo[k][2],lo[k][3],hi[k][0],hi[k][1],hi[k][2],hi[k][3]}
    o[d0]=__builtin_amdgcn_mfma_f32_32x32x16_bf16(pa0,PK(0),o[d0],0,0,0);
    o[d0]=__builtin_amdgcn_mfma_f32_32x32x16_bf16(pa1,PK(1),o[d0],0,0,0);
    o[d0]=__builtin_amdgcn_mfma_f32_32x32x16_bf16(pa2,PK(2),o[d0],0,0,0);
    o[d0]=__builtin_amdgcn_mfma_f32_32x32x16_bf16(pa3,PK(3),o[d0],0,0,0);
    #undef PK
  }
}
#ifndef ATTN_STORE16
#define ATTN_STORE16(p,v) (*(u32x4*)(p)=(v))
#endif
template<int THRL, bool STORE = true> __device__ __forceinline__ void attn_unit(const int NT,const bf16*Qw,const bf16*__restrict__ Kh,const bf16*__restrict__ Vh,bf16*Ow,char*shm){
  int tid_=threadIdx.x; asm volatile("":"+v"(tid_)); const int tid=tid_,lane=tid&63,r32=lane&31,hi=lane>>5; const int wid=__builtin_amdgcn_readfirstlane(tid>>6);
  const unsigned lds0=(unsigned)(uintptr_t)shm;
  float*wsf=(float*)(shm+LDS_WS)+wid*64;
  const bf16*ksrc=Kh+(long)lane*KVP+wid*8;
  const bf16*vsrc=Vh+(long)(16*(wid&3)+(lane>>2))*KVP+(wid>>2)*32+(lane&3)*8;
  const unsigned kdst=lds0+LDS_K+wid*1024, vdst=lds0+LDS_V+wid*1024;
  #define DMA_K(t,slot) glds16(ksrc+(long)(t)*KVBLK*KVP,(unsigned)__builtin_amdgcn_readfirstlane(kdst+(slot)))
  #define DMA_V(t,slot) glds16(vsrc+(long)(t)*KVBLK*KVP,(unsigned)__builtin_amdgcn_readfirstlane(vdst+(slot)))
  const int vb0=(int)(lds0+LDS_V)+((lane>>4)&1)*32+(lane&3)*8+(4*hi+((lane&15)>>2))*64;
  const char*Kbase=shm+LDS_K; bf16x8 kf[8];
  const lds_cptr shm3=(lds_cptr)shm; const lds_cptr kp0=shm3+LDS_K+hi*1024+r32*16; const lds_cptr vp0=shm3+LDS_V+((lane>>4)&1)*32+(lane&3)*8+(4*hi+((lane&15)>>2))*64;

  DMA_K(0,0);DMA_V(0,0);DMA_K(1,SLOTB);
  bf16x8 qr[4];
  #pragma unroll
  for(int d0=0;d0<4;++d0)qr[d0]=*reinterpret_cast<const bf16x8*>(&Qw[(long)r32*QP+d0*16+hi*8]);
  float mhat=0.f,l_reg=0.f;f32x16 o[2];o[0]=f32x16{};o[1]=f32x16{};f32x16 negm=f32x16{};asm volatile("":"+v"(negm));
  const int qrel=wid*QBLK+r32;
  #define CMASK(P0,P1,t) do{}while(0)
  bool resc=false;
  #define START(P0,P1) do{ const float rm=rowmax(P0,P1); resc=false; \
    { const float dl=rm; mhat=fadd_s(mhat,dl); \
      _Pragma("unroll") for(int r=0;r<16;++r){P0[r]=fsub_s(P0[r],dl);P1[r]=fsub_s(P1[r],dl);} \
      _Pragma("unroll") for(int r=0;r<16;++r)negm[r]=-mhat; asm volatile("":"+v"(negm)); } \
    _Pragma("unroll") for(int r=0;r<16;++r)P0[r]=__builtin_amdgcn_exp2f(P0[r]); }while(0)
  #define RESC() do{ if(resc){ asm volatile("s_waitcnt lgkmcnt(0)":::"memory"); \
      _Pragma("unroll") for(int d_=0;d_<2;++d_) _Pragma("unroll") for(int r=0;r<16;++r)o[d_][r]*=wsf[crow(r,hi)]; } }while(0)
  f32x16 pA0,pA1,pB0,pB1;
  int sl_prev=0,sl_cur=0,sl_next=SLOTB;
  #define ROT() do{sl_prev=sl_cur;sl_cur=sl_next;sl_next=(sl_next==(NSLOT-1)*SLOTB)?0:sl_next+SLOTB;}while(0)
  DMA_K(2,2*SLOTB);
  WAIT_BAR(3);
  qkt(pA0,pA1,Kbase,qr,negm,r32,hi);asm volatile("s_nop 15\n\ts_nop 7":"+v"(pA0),"+v"(pA1));CMASK(pA0,pA1,0);
  START(pA0,pA1);
  _Pragma("unroll") for(int r=0;r<16;++r)pA1[r]=__builtin_amdgcn_exp2f(pA1[r]);
  WAIT_BAR(0);
  DMA_K(3,0);DMA_V(1,SLOTB);
  ROT();
  kload8(kf,kp0+sl_cur);
  WAIT_BAR(2);
  s16x4 vlo[8],vhi[8]; u32x4 pw0,pw1,pw2,pw3;
  #define PKW(P,B) cvtpk_s(P[B],P[B+1])
  #define PAF(k) __builtin_bit_cast(bf16x8,pw##k)
  #define VFR(i) (bf16x8){vlo[i][0],vlo[i][1],vlo[i][2],vlo[i][3],vhi[i][0],vhi[i][1],vhi[i][2],vhi[i][3]}
  #define PIN(x) asm volatile("":"+v"(x))
  #define MX3(a,b,c) __builtin_fmaxf(__builtin_fmaxf((a),(b)),(c))
  #define GAPA(MF,A0,A1,A2,A3,W0,W1,PW) do{ MF; sacc+=A0; sacc+=A1; sacc+=A2; sacc+=A3; PIN(sacc); W0; W1; PIN(PW); SBAR(); }while(0)
  #define EX(v) __builtin_amdgcn_exp2f(v)
  #define GAPB(MF,X,B) do{ MF; X[B]=EX(X[B]); X[B+1]=EX(X[B+1]); X[B+2]=EX(X[B+2]); X[B+3]=EX(X[B+3]); PIN(X); SBAR(); }while(0)
  #define VRD(i) do{ vlo[i]=vtr(vp_+(((i)>>2)*4096+((i)&3)*1024)); vhi[i]=vtr(vp_+(((i)>>2)*4096+((i)&3)*1024+512)); }while(0)
  #define KRD(G,j) do{ if(G){ kload2(kf,kp0+sl_next,j); SBAR(); } }while(0)
  #define STEP(C0,C1,P0,P1,t,GK,GV,GL) do{ SBAR(); \
    const lds_cptr vp_=vp0+sl_prev; \
    VRD(0); SBAR(); float sacc=(P0[0]+P0[1]); \
    GAPA(C0=__builtin_amdgcn_mfma_f32_32x32x16_bf16(kf[0],qr[0],negm,0,0,0), P0[2],P0[3],P0[4],P0[5],     pw0[0]=PKW(P0,0), pw0[1]=PKW(P0,2), pw0); \
    VRD(4); SBAR(); GAPA(C1=__builtin_amdgcn_mfma_f32_32x32x16_bf16(kf[1],qr[0],negm,0,0,0), P0[6],P0[7],P0[8],P0[9],     pw0[2]=PKW(P0,4), pw0[3]=PKW(P0,6), pw0); \
    VRD(1); SBAR(); GAPA(C0=__builtin_amdgcn_mfma_f32_32x32x16_bf16(kf[2],qr[1],C0,0,0,0),   P0[10],P0[11],P0[12],P0[13], pw1[0]=PKW(P0,8), pw1[1]=PKW(P0,10), pw1); \
    VRD(5); SBAR(); GAPA(C1=__builtin_amdgcn_mfma_f32_32x32x16_bf16(kf[3],qr[1],C1,0,0,0),   P0[14],P0[15],P1[0],P1[1],   pw1[2]=PKW(P0,12),pw1[3]=PKW(P0,14), pw1); \
    VRD(2); SBAR(); GAPA(C0=__builtin_amdgcn_mfma_f32_32x32x16_bf16(kf[4],qr[2],C0,0,0,0),   P1[2],P1[3],P1[4],P1[5],     pw2[0]=PKW(P1,0), pw2[1]=PKW(P1,2), pw2); \
    VRD(6); SBAR(); GAPA(C1=__builtin_amdgcn_mfma_f32_32x32x16_bf16(kf[5],qr[2],C1,0,0,0),   P1[6],P1[7],P1[8],P1[9],     pw2[2]=PKW(P1,4), pw2[3]=PKW(P1,6), pw2); \
    VRD(3); SBAR(); GAPA(C0=__builtin_amdgcn_mfma_f32_32x32x16_bf16(kf[6],qr[3],C0,0,0,0),   P1[10],P1[11],P1[12],P1[13], pw3[0]=PKW(P1,8), pw3[1]=PKW(P1,10), pw3); \
    VRD(7); SBAR(); GAPA(C1=__builtin_amdgcn_mfma_f32_32x32x16_bf16(kf[7],qr[3],C1,0,0,0),   P1[14],P1[15],0.f,0.f,       pw3[2]=PKW(P1,12),pw3[3]=PKW(P1,14), pw3); \
    l_reg+=sacc; \
    if(GK){DMA_K((t)+3,sl_cur);} if(GV){DMA_V((t)+1,sl_next);} \
    CMASK(C0,C1,t); \
    { float a=MX3(C0[0],C0[1],C1[0]),b=MX3(C0[2],C0[3],C1[1]); a=MX3(a,C1[2],C1[3]); \
      _Pragma("unroll") for(int r=4;r<16;r+=4){a=MX3(a,C0[r],C0[r+1]);b=MX3(b,C0[r+2],C0[r+3]);a=MX3(a,C1[r],C1[r+1]);b=MX3(b,C1[r+2],C1[r+3]);} \
      float rm=__builtin_fmaxf(a,b); { auto rr=__builtin_amdgcn_permlane32_swap(__float_as_uint(rm),__float_as_uint(rm),false,false); rm=__builtin_fmaxf(__uint_as_float(rr[0]),__uint_as_float(rr[1])); } \
      resc=false; \
      if(__builtin_expect(__any(rm>(float)THRL),0)){ const float dl=__builtin_fmaxf(rm,0.f); mhat+=dl; \
        _Pragma("unroll") for(int r=0;r<16;++r){C0[r]-=dl;C1[r]-=dl;} \
        _Pragma("unroll") for(int r=0;r<16;++r)negm[r]=-mhat; asm volatile("":"+v"(negm)); \
        const float f=__builtin_amdgcn_exp2f(-dl); l_reg*=f; if(hi==0)wsf[r32]=f; resc=true; } } \
    SBAR(); \
    GAPB(o[0]=__builtin_amdgcn_mfma_f32_32x32x16_bf16(PAF(0),VFR(0),o[0],0,0,0), C0,0); \
    GAPB(o[1]=__builtin_amdgcn_mfma_f32_32x32x16_bf16(PAF(0),VFR(4),o[1],0,0,0), C0,4); \
    KRD(GL,0); GAPB(o[0]=__builtin_amdgcn_mfma_f32_32x32x16_bf16(PAF(1),VFR(1),o[0],0,0,0), C0,8); \
    KRD(GL,1); GAPB(o[1]=__builtin_amdgcn_mfma_f32_32x32x16_bf16(PAF(1),VFR(5),o[1],0,0,0), C0,12); \
    KRD(GL,2); GAPB(o[0]=__builtin_amdgcn_mfma_f32_32x32x16_bf16(PAF(2),VFR(2),o[0],0,0,0), C1,0); \
    KRD(GL,3); GAPB(o[1]=__builtin_amdgcn_mfma_f32_32x32x16_bf16(PAF(2),VFR(6),o[1],0,0,0), C1,4); \
    GAPB(o[0]=__builtin_amdgcn_mfma_f32_32x32x16_bf16(PAF(3),VFR(3),o[0],0,0,0), C1,8); \
    GAPB(o[1]=__builtin_amdgcn_mfma_f32_32x32x16_bf16(PAF(3),VFR(7),o[1],0,0,0), C1,12); \
    }while(0)
  int t=1;
  #undef CMASK
  #define CMASK(P0,P1,t) do{}while(0)
  for(;t+5<NT;t+=2){
    STEP(pB0,pB1,pA0,pA1,t,true,true,true);     WAIT_BAR(2); RESC(); ROT();
    STEP(pA0,pA1,pB0,pB1,t+1,true,true,true);   WAIT_BAR(2); RESC(); ROT();
  }
  #undef CMASK
  #define CMASK(P0,P1,t) do{}while(0)
  #define ENDW(tt) do{ if((tt)+3<NT){WAIT_BAR(2);} else if((tt)+2<NT){WAIT_BAR(1);} else {WAIT_BAR(0);} }while(0)
  for(;t+1<NT;t+=2){
    STEP(pB0,pB1,pA0,pA1,t,(t+3<NT),(t+1<NT),(t+1<NT));       ENDW(t);   RESC(); ROT();
    STEP(pA0,pA1,pB0,pB1,t+1,(t+4<NT),(t+2<NT),(t+2<NT));     ENDW(t+1); RESC(); ROT();
  }
  STEP(pB0,pB1,pA0,pA1,NT-1,false,false,false); RESC();
  { float sacc=pB0[0]+pB0[1]; _Pragma("unroll") for(int r=2;r<16;++r)sacc+=pB0[r]; _Pragma("unroll") for(int r=0;r<16;++r)sacc+=pB1[r]; l_reg+=sacc;
    pw0=(u32x4){PKW(pB0,0),PKW(pB0,2),PKW(pB0,4),PKW(pB0,6)};pw1=(u32x4){PKW(pB0,8),PKW(pB0,10),PKW(pB0,12),PKW(pB0,14)};pw2=(u32x4){PKW(pB1,0),PKW(pB1,2),PKW(pB1,4),PKW(pB1,6)};pw3=(u32x4){PKW(pB1,8),PKW(pB1,10),PKW(pB1,12),PKW(pB1,14)};
    SBAR(); pv(o,vb0+sl_cur,PAF(0),PAF(1),PAF(2),PAF(3)); }
  #undef PKW
  #undef PAF
  #undef VFR
  #undef PIN
  #undef MX3
  #undef GAPA
  #undef GAPB
  #undef EX
  #undef VRD
  #undef KRD
  #undef STEP
  #undef ENDW
  {auto rr=__builtin_amdgcn_permlane32_swap(__float_as_uint(l_reg),__float_as_uint(l_reg),false,false);l_reg=__uint_as_float(rr[0])+__uint_as_float(rr[1]);}
  if(hi==0)wsf[32+r32]=l_reg;asm volatile("s_waitcnt lgkmcnt(0)":::"memory");
  float rli[16];
  #pragma unroll
  for(int r=0;r<16;++r)rli[r]=__builtin_amdgcn_rcpf(wsf[32+crow(r,hi)]);

  { bf16*stg=(bf16*)(shm+LDS_OST)+wid*2048;
    #pragma unroll
    for(int r=0;r<16;++r){const int orow=crow(r,hi);
      #pragma unroll
      for(int d0=0;d0<2;++d0)stg[orow*64+d0*32+r32]=__float2bfloat16(o[d0][r]*rli[r]);}
    asm volatile("s_waitcnt lgkmcnt(0)":::"memory");
    #pragma unroll
    for(int i=0;i<4;++i){const int row=i*8+(lane>>3),ch=lane&7; const u32x4 v=*(const u32x4*)(stg+row*64+ch*8); if(STORE)ATTN_STORE16(Ow+(long)row*OP+ch*8,v);} }
  asm volatile("s_waitcnt lgkmcnt(0)\n\ts_barrier":::"memory");
  #undef DMA_K
  #undef DMA_V
  #undef CMASK
  #undef START
  #undef RESC
  #undef ROT
}
constexpr int ATTN_LDS_BYTES=LDS_BYTES;
#undef SBAR
#undef WAIT_BAR
}
#define DEVI __device__ __forceinline__
typedef unsigned short bf16_t;
typedef short bf16x8 __attribute__((ext_vector_type(8)));
typedef float f32x4 __attribute__((ext_vector_type(4)));
typedef unsigned u32x4 __attribute__((ext_vector_type(4)));
typedef unsigned u32x2 __attribute__((ext_vector_type(2)));
typedef short s16x4 __attribute__((ext_vector_type(4)));
#define LAS __attribute__((address_space(3)))

constexpr int T = 98304, TP = 65536, DM = 1024, INW = 2816, DFF = 2816, MEMROWS = 8704;
constexpr int NWAVES = 8;
constexpr float LOG2E = 1.4426950408889634f;
constexpr size_t MiB = 1u << 20;
constexpr size_t W_IN = 0, W_OUT = W_IN + (size_t)2816 * 1024, W_Q = W_OUT + (size_t)1024 * 1024, W_KV = W_Q + (size_t)256 * 1024, W_O = W_KV + (size_t)512 * 1024,
                 W_UP = W_O + (size_t)1024 * 256, W_DN = W_UP + (size_t)5632 * 1024, W_GLU = W_DN + (size_t)1024 * 2816, W_LAYER = W_GLU + (size_t)256 * 256;
constexpr size_t WS_W = 1 * MiB, WS_TAB = 54 * MiB, WS_XK = 55 * MiB, WS_XVT = 64 * MiB, WS_ACT1 = 75 * MiB, WS_BIG = 267 * MiB;
static_assert(WS_W + 2 * W_LAYER * 2 <= WS_TAB, "weights fit");
constexpr size_t TAB_S5A = 0, TAB_S5B = 64 * 1024, TAB_ROPE = 640 * 1024, TAB_LB = 704 * 1024;
constexpr size_t XK_LAYER = (size_t)MEMROWS * 256;
constexpr size_t WS_PROJ = WS_BIG, WS_VTA = WS_BIG + 528 * MiB, WS_HB = WS_VTA + 48 * MiB, WS_ODB = WS_HB + 48 * MiB, WS_S5F = WS_ODB + 48 * MiB,
                 WS_HF = WS_S5F + 12 * MiB, WS_HD = WS_HF + 24 * MiB, WS_SS = 977 * MiB, WS_END = WS_SS + 7 * MiB;
constexpr size_t WS_MN = WS_BIG;
constexpr size_t WS_XQ = WS_BIG, WS_XO = WS_BIG + 48 * MiB;
constexpr size_t WS_G = WS_BIG, WS_H = WS_BIG + 352 * MiB;
static_assert(WS_H + 352 * MiB <= WS_SS && WS_HD + 1 * MiB <= WS_SS && WS_END <= 1024 * MiB, "workspace map");
constexpr int LDS_BYTES = 147456;
constexpr int WLDS = 16384;

struct Args { const float* in[33]; float* out; unsigned char* ws; int grid, pad; };

DEVI float wsum(float v) {
#pragma unroll
    for (int o = 1; o < 64; o <<= 1) v += __shfl_xor(v, o);
    return v;
}
DEVI unsigned cvtpk(float lo, float hi) { return pg8::cvt_pk_bf16(lo, hi); }
DEVI float bflo(unsigned u) { return __uint_as_float(u << 16); }
DEVI float bfhi(unsigned u) { return __uint_as_float(u & 0xffff0000u); }
DEVI float bf1(bf16_t h) { return __uint_as_float((unsigned)h << 16); }
DEVI bf16_t tobf(float f) { return (bf16_t)(cvtpk(f, 0.f) & 0xffffu); }
DEVI void wave_sync() { asm volatile("s_waitcnt lgkmcnt(0)" ::: "memory"); __builtin_amdgcn_wave_barrier(); asm volatile("" ::: "memory"); }
DEVI float sigmoidf_(float x) { return __builtin_amdgcn_rcpf(1.0f + __expf(-x)); }
DEVI void seq_of(int tok, int& start, int& len) { if (tok < TP) { start = tok & ~2047; len = 2048; } else { start = TP + ((tok - TP) & ~16383); len = 16384; } }
DEVI int batch_of(int tok) { return tok < TP ? (tok >> 11) : 32 + ((tok - TP) >> 14); }

DEVI float row_rstd(const float* SS, size_t row) { const f32x4* p = (const f32x4*)(SS + row * 16); const f32x4 a0 = p[0], a1 = p[1], a2 = p[2], a3 = p[3];
    const float s = ((a0[0] + a0[1]) + (a0[2] + a0[3])) + ((a1[0] + a1[1]) + (a1[2] + a1[3])) + ((a2[0] + a2[1]) + (a2[2] + a2[3])) + ((a3[0] + a3[1]) + (a3[2] + a3[3]));
    return rsqrtf(s * (1.0f / 1024.0f) + 1e-6f); }
struct EpiStore {
    static constexpr bool PERM = true, AFTER_DRAIN = false;
    bf16_t* O; int ldc; int tpn; bf16_t* TB; int tcs, trb, tsh; const float* SS;
    DEVI void operator()(const pg8::f32x4 (&acc)[2][2][4][2], const pg8::Unit& u, int, int, int, int) const {
        int t_ = threadIdx.x; asm volatile("" : "+v"(t_)); const int fr = t_ & 15, fq = (t_ >> 4) & 3, wid_ = __builtin_amdgcn_readfirstlane(t_ >> 6), wr = wid_ >> 2, wc = wid_ & 3;
        const int row0 = u.pm * 256 + wr * 64 + fr, col0 = u.pn * 256 + wc * 32 + 8 * fq;
        if (u.pn == tpn) {
#pragma unroll
            for (int ai = 0; ai < 2; ++ai)
#pragma unroll
                for (int m = 0; m < 4; ++m) { const int row = row0 + ai * 128 + m * 16; bf16_t* tp = TB + (size_t)(row >> tsh) * trb + (row & ((1 << tsh) - 1)); const float rs = SS ? row_rstd(SS, row) : 1.f;
#pragma unroll
                    for (int bj = 0; bj < 2; ++bj) { const int tc = wc * 32 + 8 * fq + bj * 128;
#pragma unroll
                        for (int n = 0; n < 2; ++n)
#pragma unroll
                            for (int e = 0; e < 4; ++e) tp[(size_t)(tc + 4 * n + e) * tcs] = tobf(acc[ai][bj][m][n][e] * rs); } }
        } else {
#pragma unroll
            for (int ai = 0; ai < 2; ++ai)
#pragma unroll
                for (int m = 0; m < 4; ++m) { bf16_t* rowp = O + (size_t)(row0 + ai * 128 + m * 16) * ldc + col0; const float rs = SS ? row_rstd(SS, (size_t)(row0 + ai * 128 + m * 16)) : 1.f;
#pragma unroll
                    for (int bj = 0; bj < 2; ++bj) { const pg8::f32x4 v0 = acc[ai][bj][m][0] * rs, v1 = acc[ai][bj][m][1] * rs; u32x4 w;
                        w.x = cvtpk(v0[0], v0[1]); w.y = cvtpk(v0[2], v0[3]); w.z = cvtpk(v1[0], v1[1]); w.w = cvtpk(v1[2], v1[3]);
                        *(u32x4*)(rowp + bj * 128) = w; } }
        }
    }
};
struct EpiGlu {
    static constexpr bool PERM = true, AFTER_DRAIN = false;
    const bf16_t* HB; bf16_t* O; const float* bias;
    DEVI void operator()(const pg8::f32x4 (&acc)[2][2][4][2], const pg8::Unit& u, int, int, int, int) const {
        int t_ = threadIdx.x; asm volatile("" : "+v"(t_)); const int fr = t_ & 15, fq = (t_ >> 4) & 3, wid_ = __builtin_amdgcn_readfirstlane(t_ >> 6), wr = wid_ >> 2, wc = wid_ & 3;
        const int row0 = u.pm * 256 + wr * 64 + fr, col0 = wc * 32 + 8 * fq;
        f32x4 bb[2][2];
#pragma unroll
        for (int bj = 0; bj < 2; ++bj)
#pragma unroll
            for (int n = 0; n < 2; ++n) bb[bj][n] = *(const f32x4*)(bias + col0 + bj * 128 + 4 * n);
#pragma unroll
        for (int ai = 0; ai < 2; ++ai) {
            u32x4 hv[4][2];
#pragma unroll
            for (int m = 0; m < 4; ++m)
#pragma unroll
                for (int bj = 0; bj < 2; ++bj) hv[m][bj] = *(const u32x4*)(HB + (size_t)(row0 + ai * 128 + m * 16) * 256 + col0 + bj * 128);
            asm volatile("" ::: "memory");
#pragma unroll
            for (int m = 0; m < 4; ++m) { const size_t row = row0 + ai * 128 + m * 16;
#pragma unroll
                for (int bj = 0; bj < 2; ++bj) { const int col = col0 + bj * 128; u32x4 w;
#pragma unroll
                    for (int n = 0; n < 2; ++n) { const f32x4 b = bb[bj][n]; const pg8::f32x4 v = acc[ai][bj][m][n]; const unsigned h0 = hv[m][bj][2 * n], h1 = hv[m][bj][2 * n + 1];
                        const float s0 = __builtin_amdgcn_rcpf(1.f + __expf(-(v[0] + b[0]))), s1 = __builtin_amdgcn_rcpf(1.f + __expf(-(v[1] + b[1])));
                        const float s2 = __builtin_amdgcn_rcpf(1.f + __expf(-(v[2] + b[2]))), s3 = __builtin_amdgcn_rcpf(1.f + __expf(-(v[3] + b[3])));
                        w[2 * n] = cvtpk(bflo(h0) * s0, bfhi(h0) * s1); w[2 * n + 1] = cvtpk(bflo(h1) * s2, bfhi(h1) * s3); }
                    *(u32x4*)(O + row * INW + 768 + col) = w; } }
            asm volatile("" ::: "memory"); }
    }
};
struct EpiRes {
    static constexpr bool PERM = false, AFTER_DRAIN = false;
    float* X; bf16_t* XB; float* SS; const float* S0; const float* S1; int split;
    DEVI void operator()(const pg8::f32x4 (&acc)[2][2][4][2], const pg8::Unit& u, int, int, int, int) const {
        int t_ = threadIdx.x; asm volatile("" : "+v"(t_)); const int fr = t_ & 15, fq = (t_ >> 4) & 3, wid_ = __builtin_amdgcn_readfirstlane(t_ >> 6), wr = wid_ >> 2, wc = wid_ & 3;
        const int row0 = u.pm * 256 + wr * 64 + fr, col0 = u.pn * 256 + wc * 32 + 4 * fq;
#pragma unroll
        for (int ai = 0; ai < 2; ++ai)
#pragma unroll
            for (int mp = 0; mp < 2; ++mp) {
                f32x4 xin[2][2][2];
#pragma unroll
                for (int mm = 0; mm < 2; ++mm) { const size_t row = (size_t)(row0 + ai * 128 + (2 * mp + mm) * 16);
                    const float* srcp = ((int)row < split ? S0 + row * 1024 : S1 + (row - split) * 1024) + col0;
#pragma unroll
                    for (int bj = 0; bj < 2; ++bj)
#pragma unroll
                        for (int n = 0; n < 2; ++n) xin[mm][bj][n] = *(const f32x4*)(srcp + bj * 128 + n * 16); }
                asm volatile("" ::: "memory");
#pragma unroll
                for (int mm = 0; mm < 2; ++mm) { const int m = 2 * mp + mm; const size_t row = (size_t)(row0 + ai * 128 + m * 16); float* rowp = X + row * 1024 + col0; bf16_t* rowb = XB + row * 1024 + col0; float ssq = 0.f;
#pragma unroll
                    for (int bj = 0; bj < 2; ++bj)
#pragma unroll
                        for (int n = 0; n < 2; ++n) { f32x4 x = xin[mm][bj][n]; const pg8::f32x4 a = acc[ai][bj][m][n];
                            x[0] += a[0]; x[1] += a[1]; x[2] += a[2]; x[3] += a[3]; *(f32x4*)(rowp + bj * 128 + n * 16) = x; ssq += (x[0] * x[0] + x[1] * x[1]) + (x[2] * x[2] + x[3] * x[3]);
                            u32x2 w; w.x = cvtpk(x[0], x[1]); w.y = cvtpk(x[2], x[3]); *(u32x2*)(rowb + bj * 128 + n * 16) = w; }
                    ssq += __shfl_xor(ssq, 16); ssq += __shfl_xor(ssq, 32);
                    if (fq == 0) SS[row * 16 + u.pn * 4 + wc] = ssq; }
                asm volatile("" ::: "memory");
            }
    }
};
struct EpiConv {
    static constexpr bool PERM = true, AFTER_DRAIN = false;
    const bf16_t* G; bf16_t* H; const float* cw; const float* cb; int tok0; const float* SS;
    DEVI void operator()(const pg8::f32x4 (&acc)[2][2][4][2], const pg8::Unit& u, int, int, int, int) const {
        int t_ = threadIdx.x; asm volatile("" : "+v"(t_)); const int fr = t_ & 15, fq = (t_ >> 4) & 3, wid_ = __builtin_amdgcn_readfirstlane(t_ >> 6), wr = wid_ >> 2, wc = wid_ & 3;
        const int row0 = u.pm * 256 + wr * 64 + fr, col0 = u.pn * 256 + wc * 32 + 8 * fq;
#pragma unroll
        for (int bj = 0; bj < 2; ++bj) { const int col = col0 + bj * 128;
            float w0[8], w1[8], w2[8], b[8];
#pragma unroll
            for (int e = 0; e < 8; e += 4) { const f32x4 a0 = *(const f32x4*)(cw + col + e), a1 = *(const f32x4*)(cw + DFF + col + e), a2 = *(const f32x4*)(cw + 2 * DFF + col + e), bb = *(const f32x4*)(cb + col + e);
#pragma unroll
                for (int q = 0; q < 4; ++q) { w0[e + q] = a0[q]; w1[e + q] = a1[q]; w2[e + q] = a2[q]; b[e + q] = bb[q]; } }
#pragma unroll
            for (int ai = 0; ai < 2; ++ai)
#pragma unroll
                for (int m = 0; m < 4; ++m) { const int row = row0 + ai * 128 + m * 16; const int tok = tok0 + row; int ss, sl; seq_of(tok, ss, sl); const int pos = tok - ss; const float rs = row_rstd(SS, (size_t)row);
                    const bf16_t* gp = G + (size_t)row * DFF + col; const u32x4 z4 = {0u, 0u, 0u, 0u};
                    const u32x4 gm = *(const u32x4*)gp; const u32x4 gl = pos > 0 ? *(const u32x4*)(gp - DFF) : z4; const u32x4 gr = pos < sl - 1 ? *(const u32x4*)(gp + DFF) : z4;
                    float o[8];
#pragma unroll
                    for (int e = 0; e < 4; ++e) { const unsigned l2 = gl[e], m2 = gm[e], r2 = gr[e];
                        const float c0 = b[2 * e] + w0[2 * e] * bflo(l2) + w1[2 * e] * bflo(m2) + w2[2 * e] * bflo(r2);
                        const float c1 = b[2 * e + 1] + w0[2 * e + 1] * bfhi(l2) + w1[2 * e + 1] * bfhi(m2) + w2[2 * e + 1] * bfhi(r2);
                        o[2 * e] = c0 * sigmoidf_(c0) * rs * acc[ai][bj][m][e >> 1][(2 * e) & 3]; o[2 * e + 1] = c1 * sigmoidf_(c1) * rs * acc[ai][bj][m][e >> 1][(2 * e + 1) & 3]; }
                    u32x4 w; w.x = cvtpk(o[0], o[1]); w.y = cvtpk(o[2], o[3]); w.z = cvtpk(o[4], o[5]); w.w = cvtpk(o[6], o[7]);
                    *(u32x4*)(H + (size_t)row * DFF + col) = w; } }
    }
};
DEVI void transpose_item(const float* W, int K, int N, bf16_t* WT, float* scr, int item, int lane, const float* ksc = nullptr) {
    const int nblk = N / 32, kb = item / nblk, nb = item % nblk, k0 = 64 * kb, n0 = 32 * nb;
#pragma unroll 8
    for (int i = 0; i < 32; ++i) { const int kk = 2 * i + (lane >> 5); scr[kk * 33 + (lane & 31)] = W[(size_t)(k0 + kk) * N + n0 + (lane & 31)] * (ksc ? ksc[k0 + kk] : 1.0f); }
    wave_sync();
    const int c = lane & 7;
#pragma unroll
    for (int j = 0; j < 4; ++j) { const int n = (lane >> 3) + 8 * j; const float* s = scr + (8 * c) * 33 + n;
        u32x4 o; o.x = cvtpk(s[0 * 33], s[1 * 33]); o.y = cvtpk(s[2 * 33], s[3 * 33]); o.z = cvtpk(s[4 * 33], s[5 * 33]); o.w = cvtpk(s[6 * 33], s[7 * 33]);
        *(u32x4*)(WT + (size_t)(n0 + n) * K + k0 + 8 * c) = o; }
    wave_sync();
}
DEVI void norm_row(const float* xrow, const float* w, bf16_t* orow, float* copy, int lane) {
    const f32x4* xr = (const f32x4*)xrow + lane; f32x4 v[4]; float s = 0.f;
#pragma unroll
    for (int j = 0; j < 4; ++j) { v[j] = xr[64 * j]; s += (v[j][0] * v[j][0] + v[j][1] * v[j][1]) + (v[j][2] * v[j][2] + v[j][3] * v[j][3]); }
    if (copy) {
#pragma unroll
        for (int j = 0; j < 4; ++j) ((f32x4*)copy + lane)[64 * j] = v[j]; }
    const float r = rsqrtf(wsum(s) * (1.0f / 1024.0f) + 1e-6f);
    const f32x4* wr = (const f32x4*)w + lane;
#pragma unroll
    for (int j = 0; j < 4; ++j) { const f32x4 ww = wr[64 * j]; u32x2 o; o.x = cvtpk(v[j][0] * r * ww[0], v[j][1] * r * ww[1]); o.y = cvtpk(v[j][2] * r * ww[2], v[j][3] * r * ww[3]);
        ((u32x2*)orow + lane)[64 * j] = o; }
}
DEVI void copy_rows2(const float* xa, const float* xb_, bf16_t* oa, bf16_t* ob, float* ssa, float* ssb, int lane) {
    const f32x4* pa = (const f32x4*)xa + lane; const f32x4* pb = (const f32x4*)xb_ + lane; f32x4 v[4], u[4];
#pragma unroll
    for (int j = 0; j < 4; ++j) { v[j] = pa[64 * j]; u[j] = pb[64 * j]; }
    asm volatile("" ::: "memory");
    float s = 0.f, q = 0.f;
#pragma unroll
    for (int j = 0; j < 4; ++j) { s += (v[j][0] * v[j][0] + v[j][1] * v[j][1]) + (v[j][2] * v[j][2] + v[j][3] * v[j][3]); q += (u[j][0] * u[j][0] + u[j][1] * u[j][1]) + (u[j][2] * u[j][2] + u[j][3] * u[j][3]);
        u32x2 o; o.x = cvtpk(v[j][0], v[j][1]); o.y = cvtpk(v[j][2], v[j][3]); ((u32x2*)oa + lane)[64 * j] = o; u32x2 p; p.x = cvtpk(u[j][0], u[j][1]); p.y = cvtpk(u[j][2], u[j][3]); ((u32x2*)ob + lane)[64 * j] = p; }
    s = wsum(s); q = wsum(q);
    if (lane < 16) { ssa[lane] = lane == 0 ? s : 0.f; ssb[lane] = lane == 0 ? q : 0.f; }
}
DEVI void final_norm_rows2(float* xrow0, float* xrow1, const float* w, int lane) {
    f32x4* x0 = (f32x4*)xrow0 + lane; f32x4* x1 = (f32x4*)xrow1 + lane; f32x4 v[4], u[4];
#pragma unroll
    for (int j = 0; j < 4; ++j) { v[j] = x0[64 * j]; u[j] = x1[64 * j]; }
    asm volatile("" ::: "memory");
    float s = 0.f, q = 0.f;
#pragma unroll
    for (int j = 0; j < 4; ++j) { s += (v[j][0] * v[j][0] + v[j][1] * v[j][1]) + (v[j][2] * v[j][2] + v[j][3] * v[j][3]); q += (u[j][0] * u[j][0] + u[j][1] * u[j][1]) + (u[j][2] * u[j][2] + u[j][3] * u[j][3]); }
    const float r = rsqrtf(wsum(s) * (1.0f / 1024.0f) + 1e-6f), r2 = rsqrtf(wsum(q) * (1.0f / 1024.0f) + 1e-6f);
    const f32x4* wr = (const f32x4*)w + lane;
#pragma unroll
    for (int j = 0; j < 4; ++j) { const f32x4 ww = wr[64 * j]; f32x4 o, p; o[0] = v[j][0] * r * ww[0]; o[1] = v[j][1] * r * ww[1]; o[2] = v[j][2] * r * ww[2]; o[3] = v[j][3] * r * ww[3];
        p[0] = u[j][0] * r2 * ww[0]; p[1] = u[j][1] * r2 * ww[1]; p[2] = u[j][2] * r2 * ww[2]; p[3] = u[j][3] * r2 * ww[3]; x0[64 * j] = o; x1[64 * j] = p; }
}

template <class G, bool BATCH = true, bool STORE = true> DEVI void attn256(const bf16_t* qrow, const G& g, bf16_t* orow, float scale2, int lane) {
    const int fq = lane >> 4;
    const bf16x8 qb0 = *(const bf16x8*)(qrow + 8 * fq), qb1 = *(const bf16x8*)(qrow + 32 + 8 * fq);
    f32x4 st[16];
#pragma unroll
    for (int half = 0; half < 2; ++half) {
        bf16x8 ka[8][2];
#pragma unroll
        for (int i = 0; i < 8; ++i) { const bf16_t* kp = g.krow(8 * half + i); ka[i][0] = *(const bf16x8*)(kp + 8 * fq); ka[i][1] = *(const bf16x8*)(kp + 32 + 8 * fq); }
        asm volatile("" ::: "memory");
#pragma unroll
        for (int i = 0; i < 8; ++i) { f32x4 acc = {0.f, 0.f, 0.f, 0.f};
            acc = __builtin_amdgcn_mfma_f32_16x16x32_bf16(ka[i][0], qb0, acc, 0, 0, 0);
            acc = __builtin_amdgcn_mfma_f32_16x16x32_bf16(ka[i][1], qb1, acc, 0, 0, 0);
            st[8 * half + i] = acc; }
    }
    u32x2 vlo0[4][4], vhi0[4][4];
    if (BATCH) {
#pragma unroll
        for (int k4 = 0; k4 < 4; ++k4)
#pragma unroll
            for (int dt = 0; dt < 4; ++dt) { vlo0[k4][dt] = *(const u32x2*)g.vt(k4, dt, 0); vhi0[k4][dt] = *(const u32x2*)g.vt(k4, dt, 1); }
        asm volatile("" ::: "memory");
    }
    float mx = -INFINITY;
    {   f32x4 bz[16];
#pragma unroll
        for (int nt = 0; nt < 16; ++nt)
#pragma unroll
            for (int r = 0; r < 4; ++r) bz[nt][r] = g.bias2(nt, r);
        asm volatile("" ::: "memory");
#pragma unroll
        for (int nt = 0; nt < 16; ++nt)
#pragma unroll
            for (int r = 0; r < 4; ++r) { const float v = st[nt][r] * scale2 + bz[nt][r]; st[nt][r] = v; mx = fmaxf(mx, v); } }
    mx = fmaxf(mx, __shfl_xor(mx, 16)); mx = fmaxf(mx, __shfl_xor(mx, 32));
    float sum = 0.f;
#pragma unroll
    for (int nt = 0; nt < 16; ++nt)
#pragma unroll
        for (int r = 0; r < 4; ++r) { const float p = __builtin_amdgcn_exp2f(st[nt][r] - mx); st[nt][r] = p; sum += p; }
    sum += __shfl_xor(sum, 16); sum += __shfl_xor(sum, 32);
    const float inv = 1.0f / sum;
    f32x4 o[4];
#pragma unroll
    for (int dt = 0; dt < 4; ++dt) o[dt] = (f32x4){0.f, 0.f, 0.f, 0.f};
    if (BATCH)
#pragma unroll
    for (int half = 0; half < 2; ++half) {
        u32x2 vlo[4][4], vhi[4][4];
#pragma unroll
        for (int k4 = 0; k4 < 4; ++k4)
#pragma unroll
            for (int dt = 0; dt < 4; ++dt) { if (half == 0) { vlo[k4][dt] = vlo0[k4][dt]; vhi[k4][dt] = vhi0[k4][dt]; } else { vlo[k4][dt] = *(const u32x2*)g.vt(4 + k4, dt, 0); vhi[k4][dt] = *(const u32x2*)g.vt(4 + k4, dt, 1); } }
        asm volatile("" ::: "memory");
#pragma unroll
        for (int k4 = 0; k4 < 4; ++k4) { const int ks = 4 * half + k4;
            u32x4 pw; pw.x = cvtpk(st[2 * ks][0], st[2 * ks][1]); pw.y = cvtpk(st[2 * ks][2], st[2 * ks][3]); pw.z = cvtpk(st[2 * ks + 1][0], st[2 * ks + 1][1]); pw.w = cvtpk(st[2 * ks + 1][2], st[2 * ks + 1][3]);
            const bf16x8 pb = __builtin_bit_cast(bf16x8, pw);
#pragma unroll
            for (int dt = 0; dt < 4; ++dt) { u32x4 vw; vw.x = vlo[k4][dt].x; vw.y = vlo[k4][dt].y; vw.z = vhi[k4][dt].x; vw.w = vhi[k4][dt].y;
                o[dt] = __builtin_amdgcn_mfma_f32_16x16x32_bf16(__builtin_bit_cast(bf16x8, vw), pb, o[dt], 0, 0, 0); } }
    }
    if (!BATCH) {
#pragma unroll
        for (int ks = 0; ks < 8; ++ks) {
            u32x4 pw; pw.x = cvtpk(st[2 * ks][0], st[2 * ks][1]); pw.y = cvtpk(st[2 * ks][2], st[2 * ks][3]); pw.z = cvtpk(st[2 * ks + 1][0], st[2 * ks + 1][1]); pw.w = cvtpk(st[2 * ks + 1][2], st[2 * ks + 1][3]);
            const bf16x8 pb = __builtin_bit_cast(bf16x8, pw);
#pragma unroll
            for (int dt = 0; dt < 4; ++dt) { const u32x2 lo = *(const u32x2*)g.vt(ks, dt, 0), hi = *(const u32x2*)g.vt(ks, dt, 1); u32x4 vw; vw.x = lo.x; vw.y = lo.y; vw.z = hi.x; vw.w = hi.y;
                o[dt] = __builtin_amdgcn_mfma_f32_16x16x32_bf16(__builtin_bit_cast(bf16x8, vw), pb, o[dt], 0, 0, 0); } }
    }
#pragma unroll
    for (int dt = 0; dt < 4; ++dt) { u32x2 w; w.x = cvtpk(o[dt][0] * inv, o[dt][1] * inv); w.y = cvtpk(o[dt][2] * inv, o[dt][3] * inv); if (STORE || w.x == 0x12345678u) *(u32x2*)(orow + 16 * dt + 4 * fq) = w; }
}
struct NaGeom {
    const bf16_t* proj; const bf16_t* vta; const float* rpb; int seq_start, r, r0, qs, ks, h, fr, fq;
    DEVI const bf16_t* krow(int nt) const { const int i = nt >> 1, kc = (nt & 1) * 16 + fr; const size_t tok = (size_t)(seq_start + (r0 + i) * 64 + ks + kc); return proj + tok * INW + 256 + h * 64; }
    DEVI const bf16_t* vt(int kstep, int dt, int half) const { const int d = 16 * dt + fr; const size_t tok = (size_t)(seq_start + (r0 + kstep) * 64 + ks + 16 * half + 4 * fq); return vta + ((tok >> 6) * 256 + (size_t)(h * 64 + d)) * 64 + (tok & 63); }
    DEVI float bias2(int nt, int reg) const { const int i = nt >> 1, kcol = ks + (nt & 1) * 16 + 4 * fq + reg, qcol = qs + fr; const int c0 = min(max(qcol - 8, 0), 48);
        const bool in = (kcol >= c0) && (kcol < c0 + 16); const int dr = (r0 + i) - r + 7, dc = min(max(kcol - qcol, -15), 15) + 15;
        const float bv = rpb[(h * 15 + dr) * 31 + dc]; return in ? bv * LOG2E : -INFINITY; }
};
struct XaGeomL {
    const bf16_t* kl; const bf16_t* vtl; int fr, fq;
    DEVI const bf16_t* krow(int nt) const { return kl + (16 * nt + fr) * 72; }
    DEVI const bf16_t* vt(int kstep, int dt, int half) const { return vtl + (16 * dt + fr) * 264 + 32 * kstep + 16 * half + 4 * fq; }
    DEVI float bias2(int, int) const { return 0.f; }
};
struct XaGeom {
    const bf16_t* xk; const bf16_t* xvt; int b, h, fr, fq;
    DEVI const bf16_t* krow(int nt) const { return xk + (size_t)(b * 256 + 16 * nt + fr) * 256 + h * 64; }
    DEVI const bf16_t* vt(int kstep, int dt, int half) const { return xvt + (size_t)(b * 256 + h * 64 + 16 * dt + fr) * 256 + 32 * kstep + 16 * half + 4 * fq; }
    DEVI float bias2(int, int) const { return 0.f; }
};
DEVI void s5_load_b(const float* S5B, int pg, int lane, bf16x8 (&bB)[8]) {
    const int fr = lane & 15, fq = lane >> 4;
    f32x4 x[8], y[8];
#pragma unroll
    for (int nt = 0; nt < 8; ++nt) { const float* src = S5B + ((size_t)pg * 64 + 16 * (nt & 3) + fr) * 32 + (nt >> 2) * 16 + 8 * (fq & 1); x[nt] = *(const f32x4*)src; y[nt] = *(const f32x4*)(src + 4); }
    asm volatile("" ::: "memory");
#pragma unroll
    for (int nt = 0; nt < 8; ++nt) { u32x4 w = {0u, 0u, 0u, 0u};
        if (fq < 2) { w.x = cvtpk(x[nt][0], x[nt][1]); w.y = cvtpk(x[nt][2], x[nt][3]); w.z = cvtpk(y[nt][0], y[nt][1]); w.w = cvtpk(y[nt][2], y[nt][3]); }
        bB[nt] = __builtin_bit_cast(bf16x8, w); }
}
DEVI void s5_bu_block(const bf16_t* Ubf, bf16_t* BUX, const bf16x8 (&bB)[8], int lane) {
    const int fr = lane & 15, fq = lane >> 4;
    u32x4 aw = {0u, 0u, 0u, 0u}; if (fq < 2) aw = *(const u32x4*)(Ubf + fr * 16 + 8 * fq);
    const bf16x8 aU = __builtin_bit_cast(bf16x8, aw);
#pragma unroll
    for (int nt = 0; nt < 8; ++nt) { f32x4 d = {0.f, 0.f, 0.f, 0.f}; d = __builtin_amdgcn_mfma_f32_16x16x32_bf16(aU, bB[nt], d, 0, 0, 0);
#pragma unroll
        for (int r = 0; r < 4; ++r) BUX[(4 * fq + r) * 136 + 16 * nt + fr] = tobf(d[r]); }
}
DEVI void s5_pass1(const bf16_t* proj, const float* S5A, const float* S5B, float* S5F, int l, unsigned char* wl, int gw, int NGW, int lane) {
    bf16_t* Ubf = (bf16_t*)wl;
    bf16_t* BUX = (bf16_t*)(wl + 512);
    const int srow = lane >> 2, spc = lane & 3;
    for (int u = gw; u < 768 * 32; u += NGW) {
        const int dir = u & 1, g = (u >> 1) & 15, chunk = u >> 5; const size_t cs = (size_t)chunk * 128;
        const int pg = (l * 2 + dir) * 16 + g; const int p = pg * 64 + lane;
        const f32x4 a4 = *(const f32x4*)(S5A + (size_t)p * 4); const float ar = a4[0], ai = a4[1];
        bf16x8 bB[8]; s5_load_b(S5B, pg, lane, bB);
        float xr = 0.f, xi = 0.f;
        const bf16_t* ub = proj + 768 + g * 16 + spc * 4;
        u32x2 cur = *(const u32x2*)(ub + ((dir ? cs + 112 : cs) + srow) * INW);
        for (int blk = 0; blk < 8; ++blk) {
            u32x2 nxt = cur;
            if (blk < 7) { const size_t tb = dir ? cs + 112 - 16 * (blk + 1) : cs + 16 * (blk + 1); nxt = *(const u32x2*)(ub + (tb + srow) * INW); }
            *(u32x2*)(Ubf + srow * 16 + spc * 4) = cur;
            wave_sync();
            s5_bu_block(Ubf, BUX, bB, lane);
            wave_sync();
#pragma unroll
            for (int k = 0; k < 16; ++k) { const int row = dir ? 15 - k : k; const float bur = bf1(BUX[row * 136 + lane]), bui = bf1(BUX[row * 136 + 64 + lane]);
                const float nr = ar * xr - ai * xi + bur, ni = ar * xi + ai * xr + bui; xr = nr; xi = ni; }
            wave_sync();
            cur = nxt;
        }
        float* f = S5F + ((size_t)(chunk * 16 + g) * 2 + dir) * 128;
        f[lane] = xr; f[64 + lane] = xi;
    }
}
DEVI float gelu_tanh(float y) { const float z = 0.7978845608028654f * (y + 0.044715f * y * y * y); const float e = __expf(2.0f * z); const float th = 1.0f - 2.0f * __builtin_amdgcn_rcpf(1.0f + e); return 0.5f * y * (1.0f + th); }
DEVI void s5_pass2(const bf16_t* proj, const float* S5A, const float* S5B, const float* S5F, const float* cre, const float* cim, const float* dskip, bf16_t* HB,
                   int l, unsigned char* wl, int gw, int NGW, int lane) {
    bf16_t* Ubf = (bf16_t*)wl;
    bf16_t* BUX = (bf16_t*)(wl + 512);
    float* YL = (float*)(wl + 512 + 4352);
    const int srow = lane >> 2, spc = lane & 3, fr = lane & 15, fq = lane >> 4;
    for (int u = gw; u < 768 * 16; u += NGW) {
        const int g = u & 15, chunk = u >> 4; const int csi = chunk * 128; const size_t cs = (size_t)csi;
        int ss, sl; seq_of(csi, ss, sl); const int nch = sl >> 7, cj = (csi - ss) >> 7, cb0 = ss >> 7;
        const bf16_t* ub = proj + 768 + g * 16 + spc * 4;
        for (int dir = 0; dir < 2; ++dir) {
            const int pg = (l * 2 + dir) * 16 + g; const int p = pg * 64 + lane;
            const f32x4 a4 = *(const f32x4*)(S5A + (size_t)p * 4); const float ar = a4[0], ai = a4[1], pr = a4[2], pi = a4[3];
            bf16x8 bB[8]; s5_load_b(S5B, pg, lane, bB);
            bf16x8 Cb[4];
            { f32x4 cx[4], cy[4];
#pragma unroll
              for (int s = 0; s < 4; ++s) { const float* src = (s < 2 ? cre : cim) + ((size_t)pg * 16 + fr) * 64 + 32 * (s & 1) + 8 * fq; cx[s] = *(const f32x4*)src; cy[s] = *(const f32x4*)(src + 4); }
              asm volatile("" ::: "memory");
#pragma unroll
              for (int s = 0; s < 4; ++s) { const float sg = s < 2 ? 1.f : -1.f; const f32x4 x = cx[s], y = cy[s]; u32x4 w;
                w.x = cvtpk(sg * x[0], sg * x[1]); w.y = cvtpk(sg * x[2], sg * x[3]); w.z = cvtpk(sg * y[0], sg * y[1]); w.w = cvtpk(sg * y[2], sg * y[3]); Cb[s] = __builtin_bit_cast(bf16x8, w); } }
            float xr = 0.f, xi = 0.f;
            {
                const int n = dir == 0 ? cj : nch - 1 - cj; const int c0 = dir == 0 ? cb0 : cb0 + nch - 1; const int cstep = dir == 0 ? 1 : -1;
                for (int i0 = 0; i0 < n; i0 += 8) { float fr_[8], fi_[8];
#pragma unroll
                    for (int j = 0; j < 8; ++j) { const int i = min(i0 + j, n - 1); const float* f = S5F + ((size_t)((c0 + cstep * i) * 16 + g) * 2 + dir) * 128; fr_[j] = f[lane]; fi_[j] = f[64 + lane]; }
#pragma unroll
                    for (int j = 0; j < 8; ++j) if (i0 + j < n) { const float nr = pr * xr - pi * xi + fr_[j], ni = pr * xi + pi * xr + fi_[j]; xr = nr; xi = ni; } }
            }
            u32x2 cur = *(const u32x2*)(ub + ((dir ? cs + 112 : cs) + srow) * INW);
            for (int blk = 0; blk < 8; ++blk) {
                const int tl0 = dir ? 112 - 16 * blk : 16 * blk;
                u32x2 nxt = cur;
                if (blk < 7) { const size_t tb = dir ? cs + 112 - 16 * (blk + 1) : cs + 16 * (blk + 1); nxt = *(const u32x2*)(ub + (tb + srow) * INW); }
                *(u32x2*)(Ubf + srow * 16 + spc * 4) = cur;
                wave_sync();
                s5_bu_block(Ubf, BUX, bB, lane);
                wave_sync();
#pragma unroll
                for (int k = 0; k < 16; ++k) { const int row = dir ? 15 - k : k; const float bur = bf1(BUX[row * 136 + lane]), bui = bf1(BUX[row * 136 + 64 + lane]);
                    const float nr = ar * xr - ai * xi + bur, ni = ar * xi + ai * xr + bui; xr = nr; xi = ni;
                    BUX[row * 136 + lane] = tobf(xr); BUX[row * 136 + 64 + lane] = tobf(xi); }
                wave_sync();
                f32x4 acc = {0.f, 0.f, 0.f, 0.f};
#pragma unroll
                for (int s = 0; s < 4; ++s) { const bf16x8 a = *(const bf16x8*)(BUX + fr * 136 + 32 * s + 8 * fq); acc = __builtin_amdgcn_mfma_f32_16x16x32_bf16(a, Cb[s], acc, 0, 0, 0); }
#pragma unroll
                for (int r = 0; r < 4; ++r) { float* yp = YL + (tl0 + 4 * fq + r) * 17 + fr; if (dir == 0) *yp = acc[r]; else *yp += acc[r]; }
                wave_sync();
                cur = nxt;
            }
        }
        for (int i0 = 0; i0 < 32; i0 += 16) { bf16_t ur[16];
#pragma unroll
            for (int j = 0; j < 16; ++j) { const int idx = (i0 + j) * 64 + lane, t = idx >> 4, c = idx & 15; ur[j] = proj[(cs + t) * INW + 768 + g * 16 + c]; }
            asm volatile("" ::: "memory");
#pragma unroll
            for (int j = 0; j < 16; ++j) { const int idx = (i0 + j) * 64 + lane, t = idx >> 4, c = idx & 15;
                const float y = YL[t * 17 + c] + dskip[g * 16 + c] * bf1(ur[j]); HB[(cs + t) * 256 + g * 16 + c] = tobf(gelu_tanh(y)); } }
        wave_sync();
    }
}

template <int PASS> DEVI void hgrn_pass(const bf16_t* proj, const float* LB, float* HF, float* HD, bf16_t* OF, LAS unsigned char* wll, int l, unsigned char* wl, int gw, int NGW, int lane) {
    bf16_t* Qt = (bf16_t*)wl;
    bf16_t* Kt = (bf16_t*)(wl + 2304);
    bf16_t* Vt = (bf16_t*)(wl + 4608);
    bf16_t* K2t = (bf16_t*)(wl + 6656);
    float* EB = (float*)(wl + 8704);
    float* EC = (float*)(wl + 8960);
    const bf16_t* RZ = (const bf16_t*)(wl + 9216);
    const bf16_t* RV = (const bf16_t*)(wl + 11264);
    const bf16_t* RQ = (const bf16_t*)(wl + 13312);
    const int fr = lane & 15, fq = lane >> 4;
#define HG_DMA(tbv) do { _Pragma("unroll") for (int i_ = 0; i_ < 2; ++i_) { const int r_ = 8 * i_ + (lane >> 3); const size_t go_ = ((tbv) + (dir ? 15 - r_ : r_)) * INW + (lane & 7) * 8; \
        __builtin_amdgcn_global_load_lds((const unsigned*)(zb + go_), (LAS unsigned*)(wll + 9216 + i_ * 1024), 16, 0, 0); \
        __builtin_amdgcn_global_load_lds((const unsigned*)(vb + go_), (LAS unsigned*)(wll + 11264 + i_ * 1024), 16, 0, 0); \
        if (PASS == 2) __builtin_amdgcn_global_load_lds((const unsigned*)(qbp + go_), (LAS unsigned*)(wll + 13312 + i_ * 1024), 16, 0, 0); } \
        asm volatile("" ::: "memory"); } while (0)
    for (int u = gw; u < 192 * 8; u += NGW) {
        const int dir = u & 1, h = (u >> 1) & 3, chunk = u >> 3; const size_t cs = (size_t)chunk * 512;
        const float lb = LB[l * 256 + h * 64 + lane], oml = 1.f - lb;
        f32x4 S[4][4];
        float* hf = HF + (size_t)u * 4096;
        if (PASS == 2) {
#pragma unroll
            for (int mt = 0; mt < 4; ++mt)
#pragma unroll
                for (int nt = 0; nt < 4; ++nt)
#pragma unroll
                    for (int r = 0; r < 4; ++r) S[mt][nt][r] = hf[(16 * mt + 4 * fq + r) * 64 + 16 * nt + fr];
        } else {
#pragma unroll
            for (int mt = 0; mt < 4; ++mt)
#pragma unroll
                for (int nt = 0; nt < 4; ++nt) S[mt][nt] = (f32x4){0.f, 0.f, 0.f, 0.f};
        }
        float bsum = 0.f;
        const bf16_t* zb = proj + (dir ? 2048 : 1792) + h * 64;
        const bf16_t* vb = proj + 2304 + h * 64;
        const bf16_t* qbp = proj + 1536 + h * 64;
        size_t tb = dir ? cs + 496 : cs;
        asm volatile("s_waitcnt vmcnt(0)" ::: "memory");
        HG_DMA(tb);
        asm volatile("s_waitcnt vmcnt(0)" ::: "memory");
        for (int blk = 0; blk < 32; ++blk) {
            if (blk > 0) { if (PASS == 2) asm volatile("s_waitcnt vmcnt(16)" ::: "memory"); else asm volatile("s_waitcnt vmcnt(0)" ::: "memory"); }
            wave_sync();
            float bs[16]; unsigned omp[8]; float c = 0.f, Bt = 0.f;
            { float b = 0.f;
#pragma unroll
              for (int s = 0; s < 16; ++s) { const float e = __expf(fminf(fmaxf(bf1(RZ[s * 64 + lane]), -20.f), 20.f)); const float o_ = oml * __builtin_amdgcn_rcpf(1.f + e);
                  if (s & 1) omp[s >> 1] |= (unsigned)tobf(o_) << 16; else omp[s >> 1] = (unsigned)tobf(o_);
                  b += __logf(1.f - o_); bs[s] = b; }
              c = bs[7]; Bt = b; }
            bsum += Bt;
            { u32x4 va, vbw; unsigned vw[8];
#pragma unroll
              for (int s = 0; s < 16; s += 2) vw[s >> 1] = (unsigned)RV[s * 64 + lane] | ((unsigned)RV[(s + 1) * 64 + lane] << 16);
              va.x = vw[0]; va.y = vw[1]; va.z = vw[2]; va.w = vw[3]; vbw.x = vw[4]; vbw.y = vw[5]; vbw.z = vw[6]; vbw.w = vw[7];
              *(u32x4*)(Vt + lane * 16) = va; *(u32x4*)(Vt + lane * 16 + 8) = vbw; }
            { u32x4 k2a, k2b; unsigned k2w[8];
#pragma unroll
              for (int s = 0; s < 16; s += 2) {
                  const float om0 = bflo(omp[s >> 1]), om1 = bfhi(omp[s >> 1]), b0 = bs[s], b1 = bs[s + 1];
                  const float k2_0 = om0 * __expf(Bt - b0), k2_1 = om1 * __expf(Bt - b1); k2w[s >> 1] = cvtpk(k2_0, k2_1);
                  Kt[s * 72 + lane] = tobf(om0 * __expf(c - b0)); Kt[(s + 1) * 72 + lane] = tobf(om1 * __expf(c - b1));
                  if (PASS == 2) { Qt[s * 72 + lane] = tobf(bf1(RQ[s * 64 + lane]) * __expf(b0 - c)); Qt[(s + 1) * 72 + lane] = tobf(bf1(RQ[(s + 1) * 64 + lane]) * __expf(b1 - c)); } }
              k2a.x = k2w[0]; k2a.y = k2w[1]; k2a.z = k2w[2]; k2a.w = k2w[3]; k2b.x = k2w[4]; k2b.y = k2w[5]; k2b.z = k2w[6]; k2b.w = k2w[7];
              *(u32x4*)(K2t + lane * 16) = k2a; *(u32x4*)(K2t + lane * 16 + 8) = k2b;
              EB[lane] = __expf(Bt); EC[lane] = __expf(c); }
            wave_sync();
            const size_t tcur = tb;
            if (blk < 31) { tb = dir ? tb - 16 : tb + 16; HG_DMA(tb); }
            s16x4 vB[4];
#pragma unroll
            for (int nt = 0; nt < 4; ++nt) vB[nt] = *(const s16x4*)(Vt + (16 * nt + fr) * 16 + 4 * fq);
            if (PASS == 2) {
                f32x4 at = {0.f, 0.f, 0.f, 0.f};
#pragma unroll
                for (int ks = 0; ks < 2; ++ks) { const bf16x8 ka = *(const bf16x8*)(Kt + fr * 72 + 32 * ks + 8 * fq), qb = *(const bf16x8*)(Qt + fr * 72 + 32 * ks + 8 * fq);
                    at = __builtin_amdgcn_mfma_f32_16x16x32_bf16(ka, qb, at, 0, 0, 0); }
#pragma unroll
                for (int r = 0; r < 4; ++r) at[r] = (4 * fq + r <= fr) ? at[r] : 0.f;
                u32x2 aw; aw.x = cvtpk(at[0], at[1]); aw.y = cvtpk(at[2], at[3]); const s16x4 aP = __builtin_bit_cast(s16x4, aw);
                bf16x8 qP[2];
#pragma unroll
                for (int ks = 0; ks < 2; ++ks) { const u32x2 x = *(const u32x2*)(Qt + fr * 72 + 32 * ks + 4 * fq), y = *(const u32x2*)(Qt + fr * 72 + 32 * ks + 16 + 4 * fq); u32x4 w; w.x = x.x; w.y = x.y; w.z = y.x; w.w = y.y; qP[ks] = __builtin_bit_cast(bf16x8, w); }
                f32x4 ec[4];
#pragma unroll
                for (int mt = 0; mt < 4; ++mt) ec[mt] = *(const f32x4*)(EC + 16 * mt + 4 * fq);
#pragma unroll
                for (int nt = 0; nt < 4; ++nt) { f32x4 o = {0.f, 0.f, 0.f, 0.f};
#pragma unroll
                    for (int ks = 0; ks < 2; ++ks) { const f32x4 e0 = ec[2 * ks], e1 = ec[2 * ks + 1]; u32x4 w; w.x = cvtpk(S[2 * ks][nt][0] * e0[0], S[2 * ks][nt][1] * e0[1]); w.y = cvtpk(S[2 * ks][nt][2] * e0[2], S[2 * ks][nt][3] * e0[3]);
                        w.z = cvtpk(S[2 * ks + 1][nt][0] * e1[0], S[2 * ks + 1][nt][1] * e1[1]); w.w = cvtpk(S[2 * ks + 1][nt][2] * e1[2], S[2 * ks + 1][nt][3] * e1[3]);
                        o = __builtin_amdgcn_mfma_f32_16x16x32_bf16(qP[ks], __builtin_bit_cast(bf16x8, w), o, 0, 0, 0); }
                    o = __builtin_amdgcn_mfma_f32_16x16x16bf16_1k(aP, vB[nt], o, 0, 0, 0);
#pragma unroll
                    for (int r = 0; r < 4; ++r) { const int t = 4 * fq + r; const int tl = dir ? 15 - t : t;
                        (OF + tcur * INW + (dir ? 2048 : 1792) + h * 64 + 16 * nt)[tl * INW + fr] = tobf(o[r]); } }
            }
#pragma unroll
            for (int mt = 0; mt < 4; ++mt) { const s16x4 k2A = *(const s16x4*)(K2t + (16 * mt + fr) * 16 + 4 * fq);
                const f32x4 eb = *(const f32x4*)(EB + 16 * mt + 4 * fq);
#pragma unroll
                for (int nt = 0; nt < 4; ++nt) { f32x4 cin; cin[0] = S[mt][nt][0] * eb[0]; cin[1] = S[mt][nt][1] * eb[1]; cin[2] = S[mt][nt][2] * eb[2]; cin[3] = S[mt][nt][3] * eb[3];
                    S[mt][nt] = __builtin_amdgcn_mfma_f32_16x16x16bf16_1k(k2A, vB[nt], cin, 0, 0, 0); } }
        }
        if (PASS == 1) {
#pragma unroll
            for (int mt = 0; mt < 4; ++mt)
#pragma unroll
                for (int nt = 0; nt < 4; ++nt)
#pragma unroll
                    for (int r = 0; r < 4; ++r) hf[(16 * mt + 4 * fq + r) * 64 + 16 * nt + fr] = S[mt][nt][r];
            HD[(size_t)u * 64 + lane] = __expf(bsum);
        }
    }
#undef HG_DMA
}
DEVI void hgrn_chain(float* HF, const float* HD, int gw, int NGW, int lane) {
    for (int w = gw; w < 34 * 8 * 4; w += NGW) {
        const int slab = w & 3, dir = (w >> 2) & 1, h = (w >> 3) & 3, sq = w >> 5;
        const int cb0 = sq < 32 ? sq * 4 : 128 + (sq - 32) * 32, nch = sq < 32 ? 4 : 32;
        float C[16], F[16], Dd[16];
#pragma unroll
        for (int k = 0; k < 16; ++k) C[k] = 0.f;
        { const int ci = dir ? nch - 1 : 0; const size_t uidx = ((size_t)(cb0 + ci) * 4 + h) * 2 + dir; const float* hf = HF + uidx * 4096 + (size_t)slab * 16 * 64 + lane; const float* hd = HD + uidx * 64 + slab * 16;
#pragma unroll
          for (int k = 0; k < 16; ++k) { F[k] = hf[k * 64]; Dd[k] = hd[k]; } }
        for (int i = 0; i < nch; ++i) { const int ci = dir ? nch - 1 - i : i; const size_t uidx = ((size_t)(cb0 + ci) * 4 + h) * 2 + dir;
            float* hf = HF + uidx * 4096 + (size_t)slab * 16 * 64 + lane;
            float Fn[16], Dn[16];
            { const int i2 = min(i + 1, nch - 1); const int ci2 = dir ? nch - 1 - i2 : i2; const size_t u2 = ((size_t)(cb0 + ci2) * 4 + h) * 2 + dir; const float* hf2 = HF + u2 * 4096 + (size_t)slab * 16 * 64 + lane; const float* hd2 = HD + u2 * 64 + slab * 16;
#pragma unroll
              for (int k = 0; k < 16; ++k) { Fn[k] = hf2[k * 64]; Dn[k] = hd2[k]; } }
#pragma unroll
            for (int k = 0; k < 16; ++k) { hf[k * 64] = C[k]; C[k] = Dd[k] * C[k] + F[k]; }
#pragma unroll
            for (int k = 0; k < 16; ++k) { F[k] = Fn[k]; Dd[k] = Dn[k]; } }
    }
}

DEVI void qk_finish(bf16_t* base, unsigned a, unsigned b, const f32x4 cs4, const f32x4 nw, float sc, int i) {
    float x0 = bflo(a), x1 = bfhi(a), y0 = bflo(b), y1 = bfhi(b);
    float s = x0 * x0 + x1 * x1 + y0 * y0 + y1 * y1;
    s += __shfl_xor(s, 1); s += __shfl_xor(s, 2); s += __shfl_xor(s, 4); s += __shfl_xor(s, 8);
    const float r = rsqrtf(s * (1.0f / 64.0f) + 1e-6f);
    x0 *= r * nw[0]; x1 *= r * nw[1]; y0 *= r * nw[2]; y1 *= r * nw[3];
    const float o0 = (x0 * cs4[0] - y0 * cs4[1]) * sc, o1 = (x1 * cs4[2] - y1 * cs4[3]) * sc, p0 = (y0 * cs4[0] + x0 * cs4[1]) * sc, p1 = (y1 * cs4[2] + x1 * cs4[3]) * sc;
    *(unsigned*)(base + 2 * i) = cvtpk(o0, o1); *(unsigned*)(base + 32 + 2 * i) = cvtpk(p0, p1);
}
DEVI void qk_prep(bf16_t* proj, const float* qw, const float* kw, const float* rope, int gw, int NGW, int lane) {
    const int i = lane & 15;
    const f32x4 qn = {qw[2 * i], qw[2 * i + 1], qw[32 + 2 * i], qw[33 + 2 * i]}, kn = {kw[2 * i], kw[2 * i + 1], kw[32 + 2 * i], kw[33 + 2 * i]};
    for (int tok0 = gw; tok0 < T; tok0 += 4 * NGW) {
        unsigned qa[4], qb[4], ka[4], kb[4]; f32x4 cs[4];
#pragma unroll
        for (int j = 0; j < 4; ++j) { const int tok = min(tok0 + j * NGW, T - 1);
            int ss, sl; seq_of(tok, ss, sl); const int pos = tok - ss, pr = pos >> 6, pc = pos & 63; const int pp = (2 * i < 16) ? pr : pc, fi = (2 * i) & 15;
            cs[j] = *(const f32x4*)(rope + ((size_t)pp * 16 + fi) * 2);
            const bf16_t* bq = proj + (size_t)tok * INW + 1024 + (lane >> 4) * 64; const bf16_t* bk = proj + (size_t)tok * INW + 1280 + ((lane >> 4) & 1) * 64;
            qa[j] = *(const unsigned*)(bq + 2 * i); qb[j] = *(const unsigned*)(bq + 32 + 2 * i); ka[j] = *(const unsigned*)(bk + 2 * i); kb[j] = *(const unsigned*)(bk + 32 + 2 * i); }
        asm volatile("" ::: "memory");
#pragma unroll
        for (int j = 0; j < 4; ++j) { const int tok = tok0 + j * NGW; if (tok < T) {
            qk_finish(proj + (size_t)tok * INW + 1024 + (lane >> 4) * 64, qa[j], qb[j], cs[j], qn, 0.125f * LOG2E, i);
            if (lane < 32) qk_finish(proj + (size_t)tok * INW + 1280 + (lane >> 4) * 64, ka[j], kb[j], cs[j], kn, 1.0f, i); } }
    }
}
DEVI void merge_row_finish(bf16_t* row, const u32x2 (&in)[6], const f32x4 (&w)[4]) {
#pragma unroll
    for (int gi = 0; gi < 4; ++gi) {
        const u32x2 a = in[gi]; float v0 = bflo(a.x), v1 = bfhi(a.x), v2 = bflo(a.y), v3 = bfhi(a.y);
        if (gi == 3) { const u32x2 b = in[4]; v0 += bflo(b.x); v1 += bfhi(b.x); v2 += bflo(b.y); v3 += bfhi(b.y); }
        const float s = wsum(v0 * v0 + v1 * v1 + v2 * v2 + v3 * v3); const float r = rsqrtf(s * (1.0f / 256.0f) + 1e-6f);
        v0 *= r * w[gi][0]; v1 *= r * w[gi][1]; v2 *= r * w[gi][2]; v3 *= r * w[gi][3];
        if (gi == 3) { const u32x2 g = in[5]; const float g0 = bflo(g.x), g1 = bfhi(g.x), g2 = bflo(g.y), g3 = bfhi(g.y);
            v0 *= g0 * sigmoidf_(g0); v1 *= g1 * sigmoidf_(g1); v2 *= g2 * sigmoidf_(g2); v3 *= g3 * sigmoidf_(g3); }
        u32x2 o; o.x = cvtpk(v0, v1); o.y = cvtpk(v2, v3); *(u32x2*)(row + gi * 256) = o;
    }
}
DEVI void merge_norm(bf16_t* proj, const float* gw_, int gwv, int NGW, int lane) {
    f32x4 w[4];
#pragma unroll
    for (int gi = 0; gi < 4; ++gi) w[gi] = *(const f32x4*)(gw_ + gi * 256 + 4 * lane);
    for (int tok = gwv; tok < T; tok += 2 * NGW) {
        bf16_t* r0 = proj + (size_t)tok * INW + 4 * lane; const bool two = tok + NGW < T; bf16_t* r1 = proj + (size_t)(two ? tok + NGW : tok) * INW + 4 * lane;
        u32x2 a[6], b[6];
        a[0] = *(const u32x2*)(r0); a[1] = *(const u32x2*)(r0 + 768); a[2] = *(const u32x2*)(r0 + 1024); a[3] = *(const u32x2*)(r0 + 1792); a[4] = *(const u32x2*)(r0 + 2048); a[5] = *(const u32x2*)(r0 + 2560);
        b[0] = *(const u32x2*)(r1); b[1] = *(const u32x2*)(r1 + 768); b[2] = *(const u32x2*)(r1 + 1024); b[3] = *(const u32x2*)(r1 + 1792); b[4] = *(const u32x2*)(r1 + 2048); b[5] = *(const u32x2*)(r1 + 2560);
        asm volatile("" ::: "memory");
        merge_row_finish(r0, a, w);
        if (two) merge_row_finish(r1, b, w);
    }
}
#define XB_TMO      128
#define XB_XCNT(j)  (256  + 64 * (j))
#define XB_XSUB(j)  (1280 + 64 * (j))
#define XB_XGEN(j)  (2304 + 64 * (j))
#define XB_TOP      3328
#define XB_TOPGEN   3392
#define XCD_BAR_WORDS 3456
#define XB_SPIN_CAP (1u << 18)

__device__ __forceinline__ unsigned xb_ld(unsigned* p)              { return __hip_atomic_load(p, __ATOMIC_RELAXED, __HIP_MEMORY_SCOPE_AGENT); }
__device__ __forceinline__ unsigned xb_add(unsigned* p, unsigned v) { return __hip_atomic_fetch_add(p, v, __ATOMIC_RELAXED, __HIP_MEMORY_SCOPE_AGENT); }
__device__ __forceinline__ unsigned xb_xcc_id() { return (unsigned)__builtin_amdgcn_s_getreg((3 << 11) | 20) & 0xFu; }
#define XB_SPIN(cond, bar) do { unsigned _sp = 0; while (cond) { __builtin_amdgcn_s_sleep(1); \
    if ((++_sp & 255u) == 0u) { if (xb_ld(&(bar)[XB_TMO])) break; if (_sp > XB_SPIN_CAP) { atomicAdd(&(bar)[XB_TMO], 1u); break; } } } } while (0)

struct XcdBarrier {
    unsigned* bar; unsigned x;
    volatile LAS unsigned* st;
};

__device__ __forceinline__ XcdBarrier xcd_barrier_post(unsigned* bar, volatile LAS unsigned* st) {
    XcdBarrier b; b.bar = bar; b.x = xb_xcc_id(); b.st = st;
    if (threadIdx.x == 0) (void)xb_add(&bar[XB_XCNT(b.x)], 1u);
    return b;
}
__device__ __forceinline__ void xcd_barrier_complete(unsigned* bar, unsigned x, unsigned& nloc, unsigned& nx) {
    const unsigned G = gridDim.x * gridDim.y * gridDim.z;
    unsigned sum, cnt, mine, sp = 0u;
    for (;;) {
        sum = 0u; cnt = 0u; mine = 0u;
#pragma unroll
        for (unsigned j = 0; j < 16; ++j) { const unsigned c = xb_ld(&bar[XB_XCNT(j)]); sum += c; cnt += (c > 0u) ? 1u : 0u; mine = (j == x) ? c : mine; }
        if (sum == G) break;
        __builtin_amdgcn_s_sleep(1);
        if ((++sp & 255u) == 0u) { if (xb_ld(&bar[XB_TMO])) break; if (sp > XB_SPIN_CAP) { atomicAdd(&bar[XB_TMO], 1u); break; } }
    }
    nloc = mine > 0u ? mine : 1u; nx = cnt > 0u ? cnt : 1u;
}

__device__ __forceinline__ void xcd_barrier(const XcdBarrier& b) {
    asm volatile("s_waitcnt vmcnt(0)" ::: "memory");
    __syncthreads();
    if (threadIdx.x == 0) {
        unsigned* bar = b.bar;
        __builtin_amdgcn_s_waitcnt(0);
        unsigned nloc = b.st[0], nx = b.st[1];
        if (nloc == 0u) { xcd_barrier_complete(bar, b.x, nloc, nx); b.st[0] = nloc; b.st[1] = nx; }
        const unsigned old = xb_add(&bar[XB_XSUB(b.x)], 1u);
        const unsigned gen = old / nloc;
        if (old + 1u == (gen + 1u) * nloc) {
            __builtin_amdgcn_fence(__ATOMIC_RELEASE, "agent");
            asm volatile("s_waitcnt vmcnt(0)" ::: "memory");
            const unsigned og = xb_add(&bar[XB_TOP], 1u);
            const unsigned tg = og / nx;
            if (og + 1u == (tg + 1u) * nx) xb_add(&bar[XB_TOPGEN], 1u);
            else XB_SPIN(xb_ld(&bar[XB_TOPGEN]) == tg, bar);
            __builtin_amdgcn_fence(__ATOMIC_ACQUIRE, "agent");
            xb_add(&bar[XB_XGEN(b.x)], 1u);
            asm volatile("s_waitcnt vmcnt(0)" ::: "memory");
        } else {
            XB_SPIN(xb_ld(&bar[XB_XGEN(b.x)]) == gen, bar);
            __builtin_amdgcn_fence(__ATOMIC_ACQUIRE, "agent");
            asm volatile("s_waitcnt vmcnt(0)" ::: "memory");
        }
    }
    __syncthreads();
}
typedef const Args __attribute__((address_space(4)))* ArgsP;
DEVI ArgsP argsp() { ArgsP p = (ArgsP)__builtin_amdgcn_kernarg_segment_ptr(); asm volatile("" : "+s"(p)); return p; }
DEVI int wave_id() { int t = threadIdx.x; asm volatile("" : "+v"(t)); return __builtin_amdgcn_readfirstlane(t >> 6); }
DEVI int lane_id() { int t = threadIdx.x; asm volatile("" : "+v"(t)); return t & 63; }
#define AIN(k) (argsp()->in[k])
#define WSP(off) (argsp()->ws + (off))
#define Wt ((bf16_t*)WSP(WS_W))
#define S5A ((float*)WSP(WS_TAB + TAB_S5A))
#define S5B ((float*)WSP(WS_TAB + TAB_S5B))
#define ROPE ((float*)WSP(WS_TAB + TAB_ROPE))
#define LBT ((float*)WSP(WS_TAB + TAB_LB))
#define XK ((bf16_t*)WSP(WS_XK))
#define XVT ((bf16_t*)WSP(WS_XVT))
#define ACT1 ((bf16_t*)WSP(WS_ACT1))
#define PROJ ((bf16_t*)WSP(WS_PROJ))
#define VTA ((bf16_t*)WSP(WS_VTA))
#define HB ((bf16_t*)WSP(WS_HB))
#define ODB ((bf16_t*)WSP(WS_ODB))
#define S5F ((float*)WSP(WS_S5F))
#define HF ((float*)WSP(WS_HF))
#define HD ((float*)WSP(WS_HD))
#define MN ((bf16_t*)WSP(WS_MN))
#define XQ ((bf16_t*)WSP(WS_XQ))
#define XO ((bf16_t*)WSP(WS_XO))
#define GB ((bf16_t*)WSP(WS_G))
#define HH ((bf16_t*)WSP(WS_H))
#define SSQ ((float*)WSP(WS_SS))
#define X (argsp()->out)
#define GRIDN (argsp()->grid)
#define WCTX const int lane = lane_id(), wave = wave_id(), G = GRIDN, gw = (int)blockIdx.x * NWAVES + wave, NGW = G * NWAVES; unsigned char* wl = lds + wave * WLDS; (void)lane; (void)gw; (void)NGW; (void)wl
#define SYNC_CG() cg::this_grid().sync()
#define SYNC() do { XcdBarrier b_; b_.bar = (unsigned*)WSP(4096); b_.x = xb_xcc_id(); b_.st = (volatile LAS unsigned*)(lds + 131072); xcd_barrier(b_); } while (0)
#ifndef REP_GEMM
#define REP_GEMM 1
#endif
#ifndef REP_GQA
#define REP_GQA 1
#endif
#ifndef REP_XA
#define REP_XA 1
#endif
#ifndef REP_S5
#define REP_S5 1
#endif
#ifndef REP_HG
#define REP_HG 1
#endif
#ifndef REP_NA
#define REP_NA 1
#endif
#define GEMM_CALL(EPI, KC_, g_, S_, E_) pg8::gemm_phase<EPI, pg8::StaticOrder, true, true, KC_>((PG8_LAS unsigned char*)lds, g_, S_, E_)
#define GEMM_CALL_LDA(EPI, KC_, LDA_, g_, S_, E_) pg8::gemm_phase<EPI, pg8::StaticOrder, true, true, KC_, LDA_>((PG8_LAS unsigned char*)lds, g_, S_, E_)
#define WL_(l) (Wt + (size_t)(l) * W_LAYER)
__global__ void __launch_bounds__(NWAVES * 64, 2) fwd_mega(Args a_unused) {
    extern __shared__ __attribute__((aligned(16))) unsigned char lds[];
    if (threadIdx.x < 64) ((volatile LAS unsigned*)(lds + 131072))[threadIdx.x] = 0u;
    __syncthreads();
    (void)xcd_barrier_post((unsigned*)WSP(4096), (volatile LAS unsigned*)(lds + 131072));
    {
        WCTX; float* scr = (float*)wl;
        for (int l = 0; l < 2; ++l) {
            bf16_t* wl_ = WL_(l);
            constexpr int I0 = 16 * 88, I1 = I0 + 16 * 32, I2 = I1 + 16 * 8, I3 = I2 + 16 * 16, I4 = I3 + 4 * 32, I5 = I4 + 16 * 176, I6 = I5 + 44 * 32, I7 = I6 + 4 * 8;
            for (int it = gw; it < I7; it += NGW) {
                if (it < I0) transpose_item(AIN(5) + (size_t)l * 1024 * 2816, 1024, 2816, wl_ + W_IN, scr, it, lane, AIN(4) + l * 1024);
                else if (it < I1) transpose_item(AIN(21) + (size_t)l * 1024 * 1024, 1024, 1024, wl_ + W_OUT, scr, it - I0, lane);
                else if (it < I2) transpose_item(AIN(24) + (size_t)l * 1024 * 256, 1024, 256, wl_ + W_Q, scr, it - I1, lane, AIN(22) + l * 1024);
                else if (it < I3) transpose_item(AIN(25) + (size_t)l * 1024 * 512, 1024, 512, wl_ + W_KV, scr, it - I2, lane);
                else if (it < I4) transpose_item(AIN(26) + (size_t)l * 256 * 1024, 256, 1024, wl_ + W_O, scr, it - I3, lane);
                else if (it < I5) transpose_item(AIN(28) + (size_t)l * 1024 * 5632, 1024, 5632, wl_ + W_UP, scr, it - I4, lane, AIN(27) + l * 1024);
                else if (it < I6) transpose_item(AIN(31) + (size_t)l * 2816 * 1024, 2816, 1024, wl_ + W_DN, scr, it - I5, lane);
                else transpose_item(AIN(15) + (size_t)l * 256 * 256, 256, 256, wl_ + W_GLU, scr, it - I6, lane);
            }
        }
        const int gt = (int)blockIdx.x * (NWAVES * 64) + (int)threadIdx.x, NGT = G * NWAVES * 64;
        for (int idx = gt; idx < 4096; idx += NGT) {
            const int ldg = idx >> 6;
            const double lre = fmin((double)AIN(7)[idx], -1e-4), lim = (double)AIN(8)[idx], dt = exp((double)AIN(9)[ldg]);
            const double mag = exp(lre * dt), are = mag * cos(lim * dt), aim = mag * sin(lim * dt);
            const double mag2 = exp(lre * dt * 128.0), pre = mag2 * cos(lim * dt * 128.0), pim = mag2 * sin(lim * dt * 128.0);
            const double den = lre * lre + lim * lim, nre = are - 1.0, nim = aim;
            const double cr = (nre * lre + nim * lim) / den, ci = (nim * lre - nre * lim) / den;
            float* sa = S5A; float* sb = S5B;
            sa[idx * 4 + 0] = (float)are; sa[idx * 4 + 1] = (float)aim; sa[idx * 4 + 2] = (float)pre; sa[idx * 4 + 3] = (float)pim;
            for (int c = 0; c < 16; ++c) { const double br = (double)AIN(10)[(size_t)idx * 16 + c], bi = (double)AIN(11)[(size_t)idx * 16 + c];
                sb[(size_t)idx * 32 + c] = (float)(cr * br - ci * bi); sb[(size_t)idx * 32 + 16 + c] = (float)(cr * bi + ci * br); }
        }
        for (int idx = gt; idx < 4096; idx += NGT) {
            const int p = idx >> 4, f = idx & 15; const float inv = (float)exp(-(double)f * (log(10000.0) / 16.0)); const float ang = (float)p * inv;
            float* rp = ROPE; rp[idx * 2] = (float)cos((double)ang); rp[idx * 2 + 1] = (float)sin((double)ang);
        }
        for (int idx = gt; idx < 512; idx += NGT) {
            const int c = idx & 255; const float p0 = AIN(19)[c], p1 = AIN(19)[256 + c];
            LBT[idx] = idx < 256 ? 0.f : 1.0f / (1.0f + __expf(p1 - p0));
        }
        for (int r = gw; r < 2 * MEMROWS; r += NGW) {
            const int l = r / MEMROWS, row = r % MEMROWS;
            const float* src = row < 8192 ? AIN(2) + (size_t)row * 1024 : AIN(3) + (size_t)(row - 8192) * 1024;
            norm_row(src, AIN(23) + l * 1024, MN + (size_t)r * 1024, nullptr, lane);
        }
        for (int r = gw; r < T; r += 2 * NGW) {
            const int r2 = r + NGW < T ? r + NGW : r;
            const float* s0 = r < TP ? AIN(0) + (size_t)r * 1024 : AIN(1) + (size_t)(r - TP) * 1024; const float* s1 = r2 < TP ? AIN(0) + (size_t)r2 * 1024 : AIN(1) + (size_t)(r2 - TP) * 1024;
            copy_rows2(s0, s1, ACT1 + (size_t)r * 1024, ACT1 + (size_t)r2 * 1024, SSQ + (size_t)r * 16, SSQ + (size_t)r2 * 16, lane);
        }
    }
    SYNC_CG();
    for (int l = 0; l < 2; ++l) {
        pg8::Gemm g{MN + (size_t)l * MEMROWS * 1024, WL_(l) + W_KV, MEMROWS, 512, 1024}; pg8::StaticOrder S; S.init(MEMROWS, 512, GRIDN, (int)blockIdx.x);
        EpiStore E{XK + (size_t)l * XK_LAYER, 256, 1, XVT + (size_t)l * XK_LAYER, 256, 65536, 8, nullptr};
        GEMM_CALL(EpiStore, 1024, g, S, E);
    }
    SYNC();
    for (int l = 0; l < 2; ++l) {
        {
            pg8::Gemm g{ACT1, WL_(l) + W_IN, T, INW, 1024}; EpiStore E{PROJ, INW, 2, VTA, 64, 16384, 6, SSQ}; pg8::StaticOrder S; S.init(T, INW, GRIDN, (int)blockIdx.x);
            for (int rep = 0; rep < REP_GEMM; ++rep) GEMM_CALL(EpiStore, 1024, g, S, E);
        }
        SYNC();
        {
            WCTX;
            qk_prep(PROJ, AIN(17) + l * 64, AIN(18) + l * 64, ROPE, gw, NGW, lane);
            for (int rep = 0; rep < REP_S5; ++rep) s5_pass1(PROJ, S5A, S5B, S5F, l, wl, gw, NGW, lane);
            for (int rep = 0; rep < REP_HG; ++rep) hgrn_pass<1>(PROJ, LBT, HF, HD, nullptr, (LAS unsigned char*)lds + wave * WLDS, l, wl, gw, NGW, lane);
#if REP_NA > 1
#define ATTN_NA attn256<NaGeom, true, false>
            for (int w = gw; w < (T / 16) * 4; w += NGW) {
                const int h = w & 3, blk = w >> 2, tok0 = blk * 16; int ss, sl; seq_of(tok0, ss, sl);
                const int pos = tok0 - ss, r = pos >> 6, cb = (pos & 63) >> 4, rows = sl >> 6;
                NaGeom ng; ng.proj = PROJ; ng.vta = VTA; ng.rpb = AIN(6) + (size_t)l * 4 * 15 * 31; ng.seq_start = ss; ng.r = r; ng.r0 = min(max(r - 4, 0), rows - 8);
                ng.qs = cb * 16; ng.ks = min(max(cb * 16 - 8, 0), 32); ng.h = h; ng.fr = lane & 15; ng.fq = lane >> 4;
                const size_t qtok = (size_t)tok0 + (lane & 15);
                ATTN_NA(ng.proj + qtok * INW + h * 64, ng, PROJ + qtok * INW + h * 64, 0.125f * LOG2E, lane);
            }
#undef ATTN_NA
#endif
#define ATTN_NA attn256<NaGeom, true, true>
            for (int w = gw; w < (T / 16) * 4; w += NGW) {
                const int h = w & 3, blk = w >> 2, tok0 = blk * 16; int ss, sl; seq_of(tok0, ss, sl);
                const int pos = tok0 - ss, r = pos >> 6, cb = (pos & 63) >> 4, rows = sl >> 6;
                NaGeom ng; ng.proj = PROJ; ng.vta = VTA; ng.rpb = AIN(6) + (size_t)l * 4 * 15 * 31; ng.seq_start = ss; ng.r = r; ng.r0 = min(max(r - 4, 0), rows - 8);
                ng.qs = cb * 16; ng.ks = min(max(cb * 16 - 8, 0), 32); ng.h = h; ng.fr = lane & 15; ng.fq = lane >> 4;
                const size_t qtok = (size_t)tok0 + (lane & 15);
                ATTN_NA(ng.proj + qtok * INW + h * 64, ng, PROJ + qtok * INW + h * 64, 0.125f * LOG2E, lane);
            }
#undef ATTN_NA
        }
        SYNC();
        {
            {
                const int G = GRIDN, bx = (int)blockIdx.x, wave = wave_id();
                const int vcu = (G % 8 == 0) ? (bx % 8) * (G / 8) + bx / 8 : bx;
                const int nun = (G == 256) ? 6 : (1536 + G - 1) / G;
                for (int ui = 0; ui < nun; ++ui) {
                    int sq, hh, qb;
                    if (G == 256) {
                        if (ui < 2) { const int grp = vcu >> 6; sq = 32 + (grp >> 1); hh = (grp & 1) * 2 + ui; qb = vcu & 63; }
                        else { const int pg = vcu >> 2, uu = (vcu & 3) * 4 + (ui - 2); sq = pg >> 1; hh = (pg & 1) * 2 + (uu >> 3); qb = uu & 7; }
                    } else {
                        const int idx = ui * G + bx; if (idx >= 1536) break;
                        if (idx < 512) { sq = 32 + (idx >> 8); hh = (idx >> 6) & 3; qb = idx & 63; } else { const int j = idx - 512; sq = j >> 5; hh = (j >> 3) & 3; qb = j & 7; }
                    }
                    const int ss = sq < 32 ? sq * 2048 : TP + (sq - 32) * 16384, sl = sq < 32 ? 2048 : 16384;
                    const size_t qrow = (size_t)ss + qb * 256 + wave * 32;
                    const bf16_t* pj = PROJ;
#if REP_GQA > 1
                    attn_body::attn_unit<8, false>(sl / 64, (const attn_body::bf16*)(pj + qrow * INW + 1024 + hh * 64), (const attn_body::bf16*)(pj + (size_t)ss * INW + 1280 + (hh >> 1) * 64),
                                            (const attn_body::bf16*)(pj + (size_t)ss * INW + 1408 + (hh >> 1) * 64), (attn_body::bf16*)(PROJ + qrow * INW + 1024 + hh * 64), (char*)lds);
#endif
                    attn_body::attn_unit<8>(sl / 64, (const attn_body::bf16*)(pj + qrow * INW + 1024 + hh * 64), (const attn_body::bf16*)(pj + (size_t)ss * INW + 1280 + (hh >> 1) * 64),
                                            (const attn_body::bf16*)(pj + (size_t)ss * INW + 1408 + (hh >> 1) * 64), (attn_body::bf16*)(PROJ + qrow * INW + 1024 + hh * 64), (char*)lds);
                }
            }
            __syncthreads();
            WCTX;
            for (int rep = 0; rep < REP_S5; ++rep) s5_pass2(PROJ, S5A, S5B, S5F, AIN(12), AIN(13), AIN(14) + l * 256, HB, l, wl, gw, NGW, lane);
            hgrn_chain(HF, HD, gw, NGW, lane);
        }
        SYNC();
        {
            { const int G = GRIDN, bx = (int)blockIdx.x; const bool split = (G == 256);
              pg8::Gemm g{HB, WL_(l) + W_GLU, T, 256, 256}; pg8::StaticOrder S; S.init(T, 256, split ? 64 : G, split ? (bx >= 192 ? bx - 192 : 0x3fffffff) : bx); EpiGlu E{HB, PROJ, AIN(16) + l * 256}; GEMM_CALL(EpiGlu, 256, g, S, E); }
            __syncthreads();
            WCTX;
            for (int rep = 0; rep < REP_HG; ++rep) hgrn_pass<2>(PROJ, LBT, HF, HD, PROJ, (LAS unsigned char*)lds + wave * WLDS, l, wl, gw, NGW, lane);
        }
        SYNC();
        { WCTX; merge_norm(PROJ, AIN(20) + l * 1024, gw, NGW, lane); }
        SYNC();
        { pg8::Gemm g{PROJ, WL_(l) + W_OUT, T, 1024, 1024}; EpiRes E{X, ACT1, SSQ, l == 0 ? AIN(0) : (const float*)X, l == 0 ? AIN(1) : (const float*)X + (size_t)TP * 1024, TP}; pg8::StaticOrder S; S.init(T, 1024, GRIDN, (int)blockIdx.x); GEMM_CALL_LDA(EpiRes, 1024, 2816, g, S, E); }
        SYNC();
        { pg8::Gemm g{ACT1, WL_(l) + W_Q, T, 256, 1024}; EpiStore E{XQ, 256, -1, nullptr, 0, 0, 0, SSQ}; pg8::StaticOrder S; S.init(T, 256, GRIDN, (int)blockIdx.x); GEMM_CALL(EpiStore, 1024, g, S, E); }
        SYNC();
        {
            WCTX;
            for (int rep = 0; rep < REP_XA; ++rep)
            for (int uidx = (int)blockIdx.x; uidx < 192; uidx += G) {
                const int h = uidx & 3, seg = uidx >> 2, tokS = seg * 2048, b = batch_of(tokS); int tid = (int)threadIdx.x; asm volatile("" : "+v"(tid));
                bf16_t* Kl = (bf16_t*)lds; bf16_t* VTl = (bf16_t*)(lds + 36864);
                const bf16_t* xk = XK + (size_t)l * XK_LAYER + (size_t)b * 65536 + h * 64;
                const bf16_t* xv = XVT + (size_t)l * XK_LAYER + ((size_t)b * 256 + h * 64) * 256;
#pragma unroll
                for (int i = tid; i < 2048; i += 512) { const int key = i >> 3, ch = i & 7; *(u32x4*)(Kl + key * 72 + ch * 8) = *(const u32x4*)(xk + (size_t)key * 256 + ch * 8); }
#pragma unroll
                for (int i = tid; i < 2048; i += 512) { const int d = i >> 5, ch = i & 31; *(u32x4*)(VTl + d * 264 + ch * 8) = *(const u32x4*)(xv + (size_t)d * 256 + ch * 8); }
                __syncthreads();
                XaGeomL xg; xg.kl = Kl; xg.vtl = VTl; xg.fr = lane & 15; xg.fq = lane >> 4;
                for (int t = wave; t < 128; t += NWAVES) { const size_t qt = (size_t)tokS + t * 16 + (lane & 15);
                    attn256<XaGeomL, false>(XQ + qt * 256 + h * 64, xg, XO + qt * 256 + h * 64, 0.125f * LOG2E, lane); }
                __syncthreads();
            }
        }
        SYNC();
        { pg8::Gemm g{XO, WL_(l) + W_O, T, 1024, 256}; EpiRes E{X, ACT1, SSQ, X, X, 0x7fffffff}; pg8::StaticOrder S; S.init(T, 1024, GRIDN, (int)blockIdx.x); GEMM_CALL(EpiRes, 256, g, S, E); }
        SYNC();
        for (int chunk = 0; chunk < 2; ++chunk) {
            { const int c_row0 = chunk ? TP : 0, c_rows = chunk ? (T - TP) : TP;
              pg8::Gemm g{ACT1 + (size_t)c_row0 * 1024, WL_(l) + W_UP + (size_t)DFF * 1024, c_rows, DFF, 1024}; EpiStore E{GB, DFF, -1, nullptr, 0, 0, 0, SSQ + (size_t)c_row0 * 16}; pg8::StaticOrder S; S.init(c_rows, DFF, GRIDN, (int)blockIdx.x);
              for (int rep = 0; rep < REP_GEMM; ++rep) GEMM_CALL(EpiStore, 1024, g, S, E); }
            SYNC();
            { const int c_row0 = chunk ? TP : 0, c_rows = chunk ? (T - TP) : TP;
              pg8::Gemm g{ACT1 + (size_t)c_row0 * 1024, WL_(l) + W_UP, c_rows, DFF, 1024}; pg8::StaticOrder S; S.init(c_rows, DFF, GRIDN, (int)blockIdx.x);
              EpiConv E{GB, HH, AIN(29) + (size_t)l * 3 * DFF, AIN(30) + (size_t)l * DFF, c_row0, SSQ + (size_t)c_row0 * 16};
              for (int rep = 0; rep < REP_GEMM; ++rep) GEMM_CALL(EpiConv, 1024, g, S, E); }
            SYNC();
            { const int c_row0 = chunk ? TP : 0, c_rows = chunk ? (T - TP) : TP;
              pg8::Gemm g{HH, WL_(l) + W_DN, c_rows, 1024, DFF}; EpiRes E{X + (size_t)c_row0 * 1024, ACT1 + (size_t)c_row0 * 1024, SSQ + (size_t)c_row0 * 16, X + (size_t)c_row0 * 1024, X, 0x7fffffff}; pg8::StaticOrder S; S.init(c_rows, 1024, GRIDN, (int)blockIdx.x); GEMM_CALL(EpiRes, 2816, g, S, E); }
            SYNC();
        }
        if (l == 1) { WCTX; for (int r = gw; r < T; r += 2 * NGW) { const int r1 = r + NGW < T ? r + NGW : r; if (r1 != r) final_norm_rows2(X + (size_t)r * 1024, X + (size_t)r1 * 1024, AIN(32), lane); else final_norm_rows2(X + (size_t)r * 1024, X + (size_t)r * 1024, AIN(32), lane); } }
    }
}

extern "C" void kernel_launch(void* const* d_in, const int* in_sizes, int n_in, void* d_out, int out_size, void* d_ws, size_t ws_size, hipStream_t stream) {
    static int grid = 0;
    if (grid == 0) {
        if (n_in != 33 || out_size != T * DM || ws_size < WS_END) { fprintf(stderr, "kernel_launch: unexpected shapes (n_in %d out %d ws %zu, need %zu)\n", n_in, out_size, ws_size, (size_t)WS_END); grid = -1; return; }
        int dev = 0, cus = 0, per_cu = 0;
        hipGetDevice(&dev); hipDeviceGetAttribute(&cus, hipDeviceAttributeMultiprocessorCount, dev);
        if (hipFuncSetAttribute((const void*)fwd_mega, hipFuncAttributeMaxDynamicSharedMemorySize, LDS_BYTES) != hipSuccess) { fprintf(stderr, "kernel_launch: hipFuncSetAttribute failed\n"); grid = -1; return; }
        hipOccupancyMaxActiveBlocksPerMultiprocessor(&per_cu, (const void*)fwd_mega, NWAVES * 64, LDS_BYTES);
        (void)hipGetLastError();
        if (per_cu < 1) per_cu = 1;
        grid = cus * 1;
        fprintf(stderr, "kernel_launch: cus %d per_cu %d grid %d\n", cus, per_cu, grid);
    }
    if (grid < 0) return;
    if (hipMemsetAsync(d_ws, 0, 65536, stream) != hipSuccess) { fprintf(stderr, "kernel_launch: memset failed\n"); return; }
    Args a{};
    for (int i = 0; i < 33; ++i) a.in[i] = (const float*)d_in[i];
    a.out = (float*)d_out; a.ws = (unsigned char*)d_ws; a.grid = grid; a.pad = 0;
    void* args[] = {&a};
    hipError_t e = hipLaunchCooperativeKernel((const void*)fwd_mega, dim3(grid), dim3(NWAVES * 64), args, LDS_BYTES, stream);
    if (e != hipSuccess) fprintf(stderr, "kernel_launch: cooperative launch failed: %s (grid %d)\n", hipGetErrorString(e), grid);
}
```

```cpp
#include <hip/hip_runtime.h>
#include <hip/hip_cooperative_groups.h>
#include <hip/hip_bf16.h>
#include <cstdio>
#include <cstdint>
#include <cmath>
namespace cg = cooperative_groups;
namespace pg8 {
#define PG8_LAS __attribute__((address_space(3)))
typedef unsigned short bf16_t;
typedef short bf16x8 __attribute__((ext_vector_type(8)));
typedef float f32x4 __attribute__((ext_vector_type(4)));
typedef unsigned u32x4 __attribute__((ext_vector_type(4)));
constexpr int BM = 256, BK = 64, HALF = 128, HTB = HALF * BK * 2  , STAGE_BYTES = 8 * HTB, NXCD = 8, WGM = 8;

__host__ __device__ __forceinline__ int lds_byte(int r, int c) { const int st = (r >> 4) * 2 + (c >> 5), rr = r & 15, cc = c & 31, ob = rr * 64 + cc * 2; return st * 1024 + (ob ^ (((ob >> 9) & 1) << 5)); }
__host__ __device__ __forceinline__ void stage_rc(int b, int& R, int& C) { const int st = b / 1024, sb = b % 1024, swz = sb ^ (((sb >> 9) & 1) << 5); R = (st >> 1) * 16 + swz / 64; C = (st & 1) * 32 + (swz % 64) / 2; }
__host__ __device__ __forceinline__ int perm32(int rho) { const int n = rho >> 4, i = rho & 15; return 8 * (i >> 2) + 4 * n + (i & 3); }

struct Unit { int pm, pn; };
struct Gemm { const bf16_t* A; const bf16_t* Bt; int M, N, K; };

struct StaticOrder {
    int nM, nN, nwg, G, c;
    __host__ __device__ void init(int M, int N, int G_, int c_) { nM = M / BM; nN = N / BM; nwg = nM * nN; G = G_; c = c_; }
    __host__ __device__ bool next(int i, Unit& u) const {
        const long L = (long)i * G + c; if (L >= nwg) return false;
        int wgid = (int)L; { const int q = nwg / NXCD, r = nwg % NXCD, xcd = wgid % NXCD, off = wgid / NXCD; wgid = (xcd < r ? xcd * (q + 1) : r * (q + 1) + (xcd - r) * q) + off; }
        const int nig = WGM * nN, gid = wgid / nig, fm = gid * WGM, gsz = (nM - fm) < WGM ? (nM - fm) : WGM;
        u.pm = fm + ((wgid % nig) % gsz); u.pn = (wgid % nig) / gsz; return true;
    }
    __device__ __forceinline__ void a_ready(const Unit&) const {}
    __device__ __forceinline__ void done(const Unit&) const {}
};

__device__ __forceinline__ unsigned cvt_pk_bf16(float lo, float hi) { typedef float f2_t __attribute__((ext_vector_type(2))); typedef __bf16 b2_t __attribute__((ext_vector_type(2))); f2_t v = {lo, hi}; b2_t b = __builtin_convertvector(v, b2_t); return __builtin_bit_cast(unsigned, b); }
template <class Epi, class Sched, bool ALIGN_EPI, bool SP2, int KC, int LDA = KC>
__device__ __forceinline__ void gemm_phase(PG8_LAS unsigned char* lds, const Gemm g, const Sched& S, const Epi& E) {
    int tid_ = threadIdx.x; asm volatile("" : "+v"(tid_)); const int tid = tid_, wid = __builtin_amdgcn_readfirstlane(tid >> 6), lane = tid & 63, wr = wid >> 2, wc = wid & 3, fr = lane & 15, fq = lane >> 4;
    constexpr int K = KC, nt = K / BK;
    unsigned voffA[2], voffB[2];
#pragma unroll
    for (int i = 0; i < 2; ++i) { int R, C; stage_rc(tid * 16 + i * 8192, R, C); const int Rb = Epi::PERM ? ((R & ~31) + perm32(R & 31)) : R;
        voffA[i] = (unsigned)(R * LDA + C) * 2u; voffB[i] = (unsigned)(Rb * K + C) * 2u; }
    const size_t kstep = (size_t)(BK * 2);
    const size_t hstep = (size_t)HALF * K * 2;
    const size_t tstep = 2 * hstep; const size_t hstepA = (size_t)HALF * LDA * 2, tstepA = 2 * hstepA;
    const unsigned ldsw = (unsigned)wid * 1024u;
    const int aoff = lds_byte(wr * 64 + fr, fq * 8), boff = lds_byte(wc * 32 + fr, fq * 8);
#define PG8_SA(b, h) (((b) * 2 + (h)) * HTB)
#define PG8_SB(b, h) ((4 + (b) * 2 + (h)) * HTB)
#define PG8_STAGE(bufoff, gbase, voff) do { _Pragma("unroll") for (int _i = 0; _i < 2; ++_i) \
        __builtin_amdgcn_global_load_lds((const unsigned*)((const char*)(gbase) + (voff)[_i]), (PG8_LAS unsigned*)(lds + (bufoff) + ldsw + _i * 8192), 16, 0, 0); } while (0)
#define PG8_LDA(dst, b, h) do { _Pragma("unroll") for (int m = 0; m < 4; ++m) _Pragma("unroll") for (int k = 0; k < 2; ++k) dst[m][k] = *(const PG8_LAS bf16x8*)(lds + PG8_SA(b, h) + aoff + m * 2048 + k * 1024); } while (0)
#define PG8_LDB(dst, b, h) do { _Pragma("unroll") for (int n = 0; n < 2; ++n) _Pragma("unroll") for (int k = 0; k < 2; ++k) dst[n][k] = *(const PG8_LAS bf16x8*)(lds + PG8_SB(b, h) + boff + n * 2048 + k * 1024); } while (0)
#define PG8_MMA(ai, bj, At, Bt) do { __builtin_amdgcn_s_setprio(1); _Pragma("unroll") for (int m = 0; m < 4; ++m) _Pragma("unroll") for (int n = 0; n < 2; ++n) _Pragma("unroll") for (int k = 0; k < 2; ++k) \
        acc[ai][bj][m][n] = __builtin_amdgcn_mfma_f32_16x16x32_bf16(Bt[n][k], At[m][k], acc[ai][bj][m][n], 0, 0, 0); __builtin_amdgcn_s_setprio(0); } while (0)
#define PG8_WAIT_V(n) asm volatile("s_waitcnt vmcnt(" #n ")" ::: "memory")
#define PG8_WAIT_L(n) asm volatile("s_waitcnt lgkmcnt(" #n ")" ::: "memory")
#define PG8_BAR __builtin_amdgcn_s_barrier()
#define PG8_SCHED __builtin_amdgcn_sched_barrier(0)
    Unit cur, nxt; int ui = 0;
    if (!S.next(0, cur)) return;
    f32x4 acc[2][2][4][2];
#pragma unroll
    for (int a = 0; a < 2; ++a)
#pragma unroll
        for (int b = 0; b < 2; ++b)
#pragma unroll
            for (int m = 0; m < 4; ++m)
#pragma unroll
                for (int n = 0; n < 2; ++n) acc[a][b][m][n] = (f32x4){0.f, 0.f, 0.f, 0.f};
    bf16x8 At[4][2], B0[2][2], B1[2][2];
    const char* cA = (const char*)g.A + (size_t)cur.pm * tstepA; const char* cB = (const char*)g.Bt + (size_t)cur.pn * tstep;
    S.a_ready(cur);
    if constexpr (SP2) {
        PG8_STAGE(PG8_SB(0, 0), cB, voffB); PG8_STAGE(PG8_SB(0, 1), cB + hstep, voffB); PG8_STAGE(PG8_SA(0, 0), cA, voffA); PG8_STAGE(PG8_SA(0, 1), cA + hstepA, voffA);
        if (wr == 1) PG8_BAR;
        PG8_WAIT_V(2); PG8_BAR;
        PG8_STAGE(PG8_SB(1, 0), cB + kstep, voffB); PG8_STAGE(PG8_SA(1, 0), cA + kstep, voffA); PG8_STAGE(PG8_SB(1, 1), cB + hstep + kstep, voffB);
        PG8_WAIT_V(6); PG8_BAR;
    } else {
        PG8_STAGE(PG8_SB(0, 0), cB, voffB); PG8_STAGE(PG8_SA(0, 0), cA, voffA); PG8_STAGE(PG8_SB(0, 1), cB + hstep, voffB); PG8_STAGE(PG8_SA(0, 1), cA + hstepA, voffA);
        if (wr == 1) PG8_BAR;
        PG8_WAIT_V(4); PG8_BAR;
        PG8_STAGE(PG8_SB(1, 0), cB + kstep, voffB); PG8_STAGE(PG8_SA(1, 0), cA + kstep, voffA); PG8_STAGE(PG8_SB(1, 1), cB + hstep + kstep, voffB);
        PG8_WAIT_V(6); PG8_BAR;
    }
    for (;;) {
        const bool has_next = S.next(ui + 1, nxt);
        const char* nA = has_next ? (const char*)g.A + (size_t)nxt.pm * tstepA : cA; const char* nB = has_next ? (const char*)g.Bt + (size_t)nxt.pn * tstep : cB;
#pragma nounroll
        for (int t = 0; t < nt; t += 2) {
            const bool last = (t == nt - 2);
            const char* a1 = cA + (size_t)(t + 1) * kstep;
            const char* a2 = last ? nA : cA + (size_t)(t + 2) * kstep; const char* b2 = last ? nB : cB + (size_t)(t + 2) * kstep;
            const char* a3 = a2 + kstep; const char* b3 = b2 + kstep;
            if (last && has_next) S.a_ready(nxt);
            if constexpr (SP2) {
            PG8_LDB(B0, 0, 0); PG8_LDB(B1, 0, 1); PG8_SCHED; PG8_LDA(At, 0, 0); PG8_STAGE(PG8_SA(1, 1), a1 + hstepA, voffA);
            PG8_WAIT_V(8); PG8_WAIT_L(0); PG8_BAR; PG8_MMA(0, 0, At, B0); PG8_MMA(0, 1, At, B1); PG8_BAR; PG8_SCHED;
            PG8_LDA(At, 0, 1); PG8_STAGE(PG8_SB(0, 0), b2, voffB); PG8_STAGE(PG8_SB(0, 1), b2 + hstep, voffB); PG8_STAGE(PG8_SA(0, 0), a2, voffA);
            PG8_WAIT_V(8); PG8_WAIT_L(0); PG8_BAR; PG8_MMA(1, 0, At, B0); PG8_MMA(1, 1, At, B1); PG8_BAR; PG8_SCHED;
            PG8_LDB(B0, 1, 0); PG8_LDB(B1, 1, 1); PG8_SCHED; PG8_LDA(At, 1, 0); PG8_STAGE(PG8_SA(0, 1), a2 + hstepA, voffA);
            PG8_WAIT_V(8); PG8_WAIT_L(0); PG8_BAR; PG8_MMA(0, 0, At, B0); PG8_MMA(0, 1, At, B1); PG8_BAR; PG8_SCHED;
            PG8_LDA(At, 1, 1); PG8_STAGE(PG8_SB(1, 0), b3, voffB); PG8_STAGE(PG8_SB(1, 1), b3 + hstep, voffB); PG8_STAGE(PG8_SA(1, 0), a3, voffA);
            PG8_WAIT_V(8); PG8_WAIT_L(0); PG8_BAR; PG8_MMA(1, 0, At, B0); PG8_MMA(1, 1, At, B1); PG8_BAR; PG8_SCHED;
            } else {
            PG8_LDB(B0, 0, 0); PG8_SCHED; PG8_LDA(At, 0, 0); PG8_STAGE(PG8_SA(1, 1), a1 + hstepA, voffA);
            PG8_WAIT_L(8); PG8_BAR; PG8_WAIT_L(0); PG8_MMA(0, 0, At, B0); PG8_BAR; PG8_SCHED;
            PG8_LDB(B1, 0, 1); PG8_STAGE(PG8_SB(0, 0), b2, voffB);
            PG8_BAR; PG8_WAIT_L(0); PG8_MMA(0, 1, At, B1); PG8_BAR;
            PG8_LDA(At, 0, 1); PG8_STAGE(PG8_SA(0, 0), a2, voffA);
            PG8_BAR; PG8_WAIT_L(0); PG8_MMA(1, 0, At, B0); PG8_BAR; PG8_SCHED;
            PG8_STAGE(PG8_SB(0, 1), b2 + hstep, voffB);
            PG8_WAIT_V(6); PG8_BAR; PG8_MMA(1, 1, At, B1); PG8_BAR;
            PG8_LDB(B0, 1, 0); PG8_SCHED; PG8_LDA(At, 1, 0); PG8_STAGE(PG8_SA(0, 1), a2 + hstepA, voffA);
            PG8_WAIT_L(8); PG8_BAR; PG8_WAIT_L(0); PG8_MMA(0, 0, At, B0); PG8_BAR; PG8_SCHED;
            PG8_LDB(B1, 1, 1); PG8_STAGE(PG8_SB(1, 0), b3, voffB);
            PG8_BAR; PG8_WAIT_L(0); PG8_MMA(0, 1, At, B1); PG8_BAR;
            PG8_LDA(At, 1, 1); PG8_STAGE(PG8_SA(1, 0), a3, voffA);
            PG8_BAR; PG8_WAIT_L(0); PG8_MMA(1, 0, At, B0); PG8_BAR; PG8_SCHED;
            PG8_STAGE(PG8_SB(1, 1), b3 + hstep, voffB);
            PG8_WAIT_V(6); PG8_BAR; PG8_MMA(1, 1, At, B1); PG8_BAR;
            }
        }
        if constexpr (ALIGN_EPI) { if (wr == 0) PG8_BAR; }
        if constexpr (!Epi::AFTER_DRAIN) { E(acc, cur, wr, wc, fr, fq); S.done(cur); }
        if (!has_next) break;
#pragma unroll
        for (int a = 0; a < 2; ++a)
#pragma unroll
            for (int b = 0; b < 2; ++b)
#pragma unroll
                for (int m = 0; m < 4; ++m)
#pragma unroll
                    for (int n = 0; n < 2; ++n) acc[a][b][m][n] = (f32x4){0.f, 0.f, 0.f, 0.f};
        cur = nxt; cA = nA; cB = nB; ++ui;
        if constexpr (ALIGN_EPI) { if (wr == 1) PG8_BAR; }
    }
    PG8_WAIT_V(0);
    if constexpr (!ALIGN_EPI) { if (wr == 0) PG8_BAR; }
    PG8_BAR;
    if constexpr (Epi::AFTER_DRAIN) { E.fused(acc, cur, wr, wc, fr, fq, lds, wid, lane); S.done(cur); }
#undef PG8_SA
#undef PG8_SB
#undef PG8_STAGE
#undef PG8_LDA
#undef PG8_LDB
#undef PG8_MMA
#undef PG8_WAIT_V
#undef PG8_WAIT_L
#undef PG8_BAR
#undef PG8_SCHED
}
}
namespace attn_body {
using bf16=__hip_bfloat16;
using bf16x8=__attribute__((ext_vector_type(8)))short;
using s16x4=__attribute__((ext_vector_type(4)))short;
using f32x16=__attribute__((ext_vector_type(16)))float;
using u32x4=__attribute__((ext_vector_type(4)))unsigned;
constexpr int D=64;
constexpr int NW=8,QBLK=32,QB=QBLK*NW,KVBLK=64;
constexpr int KVP=2816,QP=2816,OP=2816;
__device__ __forceinline__ int crow(int r,int hi){return (r&3)+8*(r>>2)+4*hi;}
#define SBAR() __builtin_amdgcn_sched_barrier(0)
constexpr int NSLOT=3, SLOTB=8192;
constexpr int LDS_K=0, LDS_V=NSLOT*SLOTB, LDS_WS=2*NSLOT*SLOTB, LDS_OST=LDS_WS+NW*64*4, LDS_BYTES=LDS_OST+NW*4096;
constexpr float C2=0.125f*1.4426950408889634f;
__device__ __forceinline__ void glds16(const void*gsrc,unsigned lds_dst){unsigned keep;
  asm volatile("s_mov_b32 %0, m0\n\ts_mov_b32 m0, %2\n\ts_nop 0\n\tglobal_load_lds_dwordx4 %1, off\n\ts_mov_b32 m0, %0":"=&s"(keep):"v"(gsrc),"s"(lds_dst):"memory");}
__device__ __forceinline__ float max3f(float a,float b,float c){float r;asm("v_max3_f32 %0, %1, %2, %3":"=v"(r):"v"(a),"v"(b),"v"(c));return r;}
__device__ __forceinline__ float max2f(float a,float b){float r;asm("v_max_f32_e32 %0, %1, %2":"=v"(r):"v"(a),"v"(b));return r;}
__device__ __forceinline__ float fadd_s(float a,float b){float r;asm("v_add_f32_e32 %0, %1, %2":"=v"(r):"v"(a),"v"(b));return r;}
__device__ __forceinline__ float fsub_s(float a,float b){float r;asm("v_sub_f32_e32 %0, %1, %2":"=v"(r):"v"(a),"v"(b));return r;}
typedef float f32x2_t __attribute__((ext_vector_type(2))); typedef __bf16 bf16x2_t __attribute__((ext_vector_type(2)));
__device__ __forceinline__ unsigned cvtpk_s(float lo,float hi){f32x2_t v={lo,hi};bf16x2_t b=__builtin_convertvector(v,bf16x2_t);return __builtin_bit_cast(unsigned,b);}
#define WAIT_BAR(N) asm volatile("s_waitcnt vmcnt(" #N ") lgkmcnt(0)\n\ts_barrier":::"memory")

__device__ __forceinline__ void qkt(f32x16&p0,f32x16&p1,const char*Kslot,const bf16x8*qr,const f32x16&negm,int r32,int hi){
  const char*kb=Kslot+hi*1024+r32*16;
  #pragma unroll
  for(int d0=0;d0<4;++d0){
    const bf16x8 b0=*reinterpret_cast<const bf16x8*>(kb+d0*2048);
    const bf16x8 b1=*reinterpret_cast<const bf16x8*>(kb+d0*2048+512);
    if(d0==0){p0=__builtin_amdgcn_mfma_f32_32x32x16_bf16(b0,qr[0],negm,0,0,0);p1=__builtin_amdgcn_mfma_f32_32x32x16_bf16(b1,qr[0],negm,0,0,0);}
    else{p0=__builtin_amdgcn_mfma_f32_32x32x16_bf16(b0,qr[d0],p0,0,0,0);p1=__builtin_amdgcn_mfma_f32_32x32x16_bf16(b1,qr[d0],p1,0,0,0);}}
}
typedef __attribute__((address_space(3))) const char* lds_cptr;
typedef short v4i16_t __attribute__((ext_vector_type(4)));
__device__ __forceinline__ void kload8(bf16x8*kf,lds_cptr kp){
  kf[0]=*(const __attribute__((address_space(3))) bf16x8*)(kp);      kf[1]=*(const __attribute__((address_space(3))) bf16x8*)(kp+512);
  kf[2]=*(const __attribute__((address_space(3))) bf16x8*)(kp+2048); kf[3]=*(const __attribute__((address_space(3))) bf16x8*)(kp+2560);
  kf[4]=*(const __attribute__((address_space(3))) bf16x8*)(kp+4096); kf[5]=*(const __attribute__((address_space(3))) bf16x8*)(kp+4608);
  kf[6]=*(const __attribute__((address_space(3))) bf16x8*)(kp+6144); kf[7]=*(const __attribute__((address_space(3))) bf16x8*)(kp+6656);
}
__device__ __forceinline__ void kload2(bf16x8*kf,lds_cptr kp,int j){ kf[2*j]=*(const __attribute__((address_space(3))) bf16x8*)(kp+j*2048); kf[2*j+1]=*(const __attribute__((address_space(3))) bf16x8*)(kp+j*2048+512); }
__device__ __forceinline__ s16x4 vtr(lds_cptr p){ return __builtin_bit_cast(s16x4,__builtin_amdgcn_ds_read_tr16_b64_v4i16((__attribute__((address_space(3))) v4i16_t*)p)); }
__device__ __forceinline__ float rowmax(const f32x16&p0,const f32x16&p1){
  float a=max3f(p0[0],p0[1],p1[0]),b=max3f(p0[2],p0[3],p1[1]);a=max3f(a,p1[2],p1[3]);
  #pragma unroll
  for(int r=4;r<16;r+=4){a=max3f(a,p0[r],p0[r+1]);b=max3f(b,p0[r+2],p0[r+3]);a=max3f(a,p1[r],p1[r+1]);b=max3f(b,p1[r+2],p1[r+3]);}
  const float m=max2f(a,b);
  auto rr=__builtin_amdgcn_permlane32_swap(__float_as_uint(m),__float_as_uint(m),false,false);
  return max2f(__uint_as_float(rr[0]),__uint_as_float(rr[1]));
}
__device__ __forceinline__ void pv(f32x16*o,int vb,bf16x8 pa0,bf16x8 pa1,bf16x8 pa2,bf16x8 pa3){
  #pragma unroll
  for(int d0=0;d0<2;++d0){s16x4 lo[4],hi[4];
    #pragma unroll
    for(int ks=0;ks<4;++ks){
      asm volatile("ds_read_b64_tr_b16 %0,%1 offset:%c2":"=&v"(lo[ks]):"v"(vb),"i"(d0*4096+ks*1024):"memory");
      asm volatile("ds_read_b64_tr_b16 %0,%1 offset:%c2":"=&v"(hi[ks]):"v"(vb),"i"(d0*4096+ks*1024+512):"memory");}
    asm volatile("s_waitcnt lgkmcnt(0)":::"memory");SBAR();
    #define PK(k) (bf16x8){lo[k][0],lo[k][1],lo[k][2],lo[k][3],hi[k][0],hi[k][1],hi[k][2],hi[k][3]}
    o[d0]=__builtin_amdgcn_mfma_f32_32x32x16_bf16(pa0,PK(0),o[d0],0,0,0);
    o[d0]=__builtin_amdgcn_mfma_f32_32x32x16_bf16(pa1,PK(1),o[d0],0,0,0);
    o[d0]=__builtin_amdgcn_mfma_f32_32x32x16_bf16(pa2,PK(2),o[d0],0,0,0);
    o[d0]=__builtin_amdgcn_mfma_f32_32x32x16_bf16(pa3,PK(3),o[d0],0,0,0);
    #undef PK
  }
}
#ifndef ATTN_STORE16
#define ATTN_STORE16(p,v) (*(u32x4*)(p)=(v))
#endif
template<int THRL, bool STORE = true> __device__ __forceinline__ void attn_unit(const int NT,const bf16*Qw,const bf16*__restrict__ Kh,const bf16*__restrict__ Vh,bf16*Ow,char*shm){
  int tid_=threadIdx.x; asm volatile("":"+v"(tid_)); const int tid=tid_,lane=tid&63,r32=lane&31,hi=lane>>5; const int wid=__builtin_amdgcn_readfirstlane(tid>>6);
  const unsigned lds0=(unsigned)(uintptr_t)shm;
  float*wsf=(float*)(shm+LDS_WS)+wid*64;
  const bf16*ksrc=Kh+(long)lane*KVP+wid*8;
  const bf16*vsrc=Vh+(long)(16*(wid&3)+(lane>>2))*KVP+(wid>>2)*32+(lane&3)*8;
  const unsigned kdst=lds0+LDS_K+wid*1024, vdst=lds0+LDS_V+wid*1024;
  #define DMA_K(t,slot) glds16(ksrc+(long)(t)*KVBLK*KVP,(unsigned)__builtin_amdgcn_readfirstlane(kdst+(slot)))
  #define DMA_V(t,slot) glds16(vsrc+(long)(t)*KVBLK*KVP,(unsigned)__builtin_amdgcn_readfirstlane(vdst+(slot)))
  const int vb0=(int)(lds0+LDS_V)+((lane>>4)&1)*32+(lane&3)*8+(4*hi+((lane&15)>>2))*64;
  const char*Kbase=shm+LDS_K; bf16x8 kf[8];
  const lds_cptr shm3=(lds_cptr)shm; const lds_cptr kp0=shm3+LDS_K+hi*1024+r32*16; const lds_cptr vp0=shm3+LDS_V+((lane>>4)&1)*32+(lane&3)*8+(4*hi+((lane&15)>>2))*64;

  DMA_K(0,0);DMA_V(0,0);DMA_K(1,SLOTB);
  bf16x8 qr[4];
  #pragma unroll
  for(int d0=0;d0<4;++d0)qr[d0]=*reinterpret_cast<const bf16x8*>(&Qw[(long)r32*QP+d0*16+hi*8]);
  float mhat=0.f,l_reg=0.f;f32x16 o[2];o[0]=f32x16{};o[1]=f32x16{};f32x16 negm=f32x16{};asm volatile("":"+v"(negm));
  const int qrel=wid*QBLK+r32;
  #define CMASK(P0,P1,t) do{}while(0)
  bool resc=false;
  #define START(P0,P1) do{ const float rm=rowmax(P0,P1); resc=false; \
    { const float dl=rm; mhat=fadd_s(mhat,dl); \
      _Pragma("unroll") for(int r=0;r<16;++r){P0[r]=fsub_s(P0[r],dl);P1[r]=fsub_s(P1[r],dl);} \
      _Pragma("unroll") for(int r=0;r<16;++r)negm[r]=-mhat; asm volatile("":"+v"(negm)); } \
    _Pragma("unroll") for(int r=0;r<16;++r)P0[r]=__builtin_amdgcn_exp2f(P0[r]); }while(0)
  #define RESC() do{ if(resc){ asm volatile("s_waitcnt lgkmcnt(0)":::"memory"); \
      _Pragma("unroll") for(int d_=0;d_<2;++d_) _Pragma("unroll") for(int r=0;r<16;++r)o[d_][r]*=wsf[crow(r,hi)]; } }while(0)
  f32x16 pA0,pA1,pB0,pB1;
  int sl_prev=0,sl_cur=0,sl_next=SLOTB;
  #define ROT() do{sl_prev=sl_cur;sl_cur=sl_next;sl_next=(sl_next==(NSLOT-1)*SLOTB)?0:sl_next+SLOTB;}while(0)
  DMA_K(2,2*SLOTB);
  WAIT_BAR(3);
  qkt(pA0,pA1,Kbase,qr,negm,r32,hi);asm volatile("s_nop 15\n\ts_nop 7":"+v"(pA0),"+v"(pA1));CMASK(pA0,pA1,0);
  START(pA0,pA1);
  _Pragma("unroll") for(int r=0;r<16;++r)pA1[r]=__builtin_amdgcn_exp2f(pA1[r]);
  WAIT_BAR(0);
  DMA_K(3,0);DMA_V(1,SLOTB);
  ROT();
  kload8(kf,kp0+sl_cur);
  WAIT_BAR(2);
  s16x4 vlo[8],vhi[8]; u32x4 pw0,pw1,pw2,pw3;
  #define PKW(P,B) cvtpk_s(P[B],P[B+1])
  #define PAF(k) __builtin_bit_cast(bf16x8,pw##k)
  #define VFR(i) (bf16x8){vlo[i][0],vlo[i][1],vlo[i][2],vlo[i][3],vhi[i][0],vhi[i][1],vhi[i][2],vhi[i][3]}
  #define PIN(x) asm volatile("":"+v"(x))
  #define MX3(a,b,c) __builtin_fmaxf(__builtin_fmaxf((a),(b)),(c))
  #define GAPA(MF,A0,A1,A2,A3,W0,W1,PW) do{ MF; sacc+=A0; sacc+=A1; sacc+=A2; sacc+=A3; PIN(sacc); W0; W1; PIN(PW); SBAR(); }while(0)
  #define EX(v) __builtin_amdgcn_exp2f(v)
  #define GAPB(MF,X,B) do{ MF; X[B]=EX(X[B]); X[B+1]=EX(X[B+1]); X[B+2]=EX(X[B+2]); X[B+3]=EX(X[B+3]); PIN(X); SBAR(); }while(0)
  #define VRD(i) do{ vlo[i]=vtr(vp_+(((i)>>2)*4096+((i)&3)*1024)); vhi[i]=vtr(vp_+(((i)>>2)*4096+((i)&3)*1024+512)); }while(0)
  #define KRD(G,j) do{ if(G){ kload2(kf,kp0+sl_next,j); SBAR(); } }while(0)
  #define STEP(C0,C1,P0,P1,t,GK,GV,GL) do{ SBAR(); \
    const lds_cptr vp_=vp0+sl_prev; \
    VRD(0); SBAR(); float sacc=(P0[0]+P0[1]); \
    GAPA(C0=__builtin_amdgcn_mfma_f32_32x32x16_bf16(kf[0],qr[0],negm,0,0,0), P0[2],P0[3],P0[4],P0[5],     pw0[0]=PKW(P0,0), pw0[1]=PKW(P0,2), pw0); \
    VRD(4); SBAR(); GAPA(C1=__builtin_amdgcn_mfma_f32_32x32x16_bf16(kf[1],qr[0],negm,0,0,0), P0[6],P0[7],P0[8],P0[9],     pw0[2]=PKW(P0,4), pw0[3]=PKW(P0,6), pw0); \
    VRD(1); SBAR(); GAPA(C0=__builtin_amdgcn_mfma_f32_32x32x16_bf16(kf[2],qr[1],C0,0,0,0),   P0[10],P0[11],P0[12],P0[13], pw1[0]=PKW(P0,8), pw1[1]=PKW(P0,10), pw1); \
    VRD(5); SBAR(); GAPA(C1=__builtin_amdgcn_mfma_f32_32x32x16_bf16(kf[3],qr[1],C1,0,0,0),   P0[14],P0[15],P1[0],P1[1],   pw1[2]=PKW(P0,12),pw1[3]=PKW(P0,14), pw1); \
    VRD(2); SBAR(); GAPA(C0=__builtin_amdgcn_mfma_f32_32x32x16_bf16(kf[4],qr[2],C0,0,0,0),   P1[2],P1[3],P1[4],P1[5],     pw2[0]=PKW(P1,0), pw2[1]=PKW(P1,2), pw2); \
    VRD(6); SBAR(); GAPA(C1=__builtin_amdgcn_mfma_f32_32x32x16_bf16(kf[5],qr[2],C1,0,0,0),   P1[6],P1[7],P1[8],P1[9],     pw2[2]=PKW(P1,4), pw2[3]=PKW(P1,6), pw2); \
    VRD(3); SBAR(); GAPA(C0=__builtin_amdgcn_mfma_f32_32x32x16_bf16(kf[6],qr[3],C0,0,0,0),   P1[10],P1[11],P1[12],P1[13], pw3[0]=PKW(P1,8), pw3[1]=PKW(P1,10), pw3); \
    VRD(7); SBAR(); GAPA(C1=__builtin_amdgcn_mfma_f32_32x32x16_bf16(kf[7],qr[3],C1,0,0,0),   P1[14],P1[15],0.f,0.f,       pw3[2]=PKW(P1,12),pw3[3]=PKW(P1,14), pw3); \
    l_reg+=sacc; \
    if(GK){DMA_K((t)+3,sl_cur);} if(GV){DMA_V((t)+1,sl_next);} \
    CMASK(C0,C1,t); \
    { float a=MX3(C0[0],C0[1],C1[0]),b=MX3(C0[2],C0[3],C1[1]); a=MX3(a,C1[2],C1[3]); \
      _Pragma("unroll") for(int r=4;r<16;r+=4){a=MX3(a,C0[r],C0[r+1]);b=MX3(b,C0[r+2],C0[r+3]);a=MX3(a,C1[r],C1[r+1]);b=MX3(b,C1[r+2],C1[r+3]);} \
      float rm=__builtin_fmaxf(a,b); { auto rr=__builtin_amdgcn_permlane32_swap(__float_as_uint(rm),__float_as_uint(rm),false,false); rm=__builtin_fmaxf(__uint_as_float(rr[0]),__uint_as_float(rr[1])); } \
      resc=false; \
      if(__builtin_expect(__any(rm>(float)THRL),0)){ const float dl=__builtin_fmaxf(rm,0.f); mhat+=dl; \
        _Pragma("unroll") for(int r=0;r<16;++r){C0[r]-=dl;C1[r]-=dl;} \
        _Pragma("unroll") for(int r=0;r<16;++r)negm[r]=-mhat; asm volatile("":"+v"(negm)); \
        const float f=__builtin_amdgcn_exp2f(-dl); l_reg*=f; if(hi==0)wsf[r32]=f; resc=true; } } \
    SBAR(); \
    GAPB(o[0]=__builtin_amdgcn_mfma_f32_32x32x16_bf16(PAF(0),VFR(0),o[0],0,0,0), C0,0); \
    GAPB(o[1]=__builtin_amdgcn_mfma_f32_32x32x16_bf16(PAF(0),VFR(4),o[1],0,0,0), C0,4); \
    KRD(GL,0); GAPB(o[0]=__builtin_amdgcn_mfma_f32_32x32x16_bf16(PAF(1),VFR(1),o[0],0,0,0), C0,8); \
    KRD(GL,1); GAPB(o[1]=__builtin_amdgcn_mfma_f32_32x32x16_bf16(PAF(1),VFR(5),o[1],0,0,0), C0,12); \
    KRD(GL,2); GAPB(o[0]=__builtin_amdgcn_mfma_f32_32x32x16_bf16(PAF(2),VFR(2),o[0],0,0,0), C1,0); \
    KRD(GL,3); GAPB(o[1]=__builtin_amdgcn_mfma_f32_32x32x16_bf16(PAF(2),VFR(6),o[1],0,0,0), C1,4); \
    GAPB(o[0]=__builtin_amdgcn_mfma_f32_32x32x16_bf16(PAF(3),VFR(3),o[0],0,0,0), C1,8); \
    GAPB(o[1]=__builtin_amdgcn_mfma_f32_32x32x16_bf16(PAF(3),VFR(7),o[1],0,0,0), C1,12); \
    }while(0)
  int t=1;
  #undef CMASK
  #define CMASK(P0,P1,t) do{}while(0)
  for(;t+5<NT;t+=2){
    STEP(pB0,pB1,pA0,pA1,t,true,true,true);     WAIT_BAR(2); RESC(); ROT();
    STEP(pA0,pA1,pB0,pB1,t+1,true,true,true);   WAIT_BAR(2); RESC(); ROT();
  }
  #undef CMASK
  #define CMASK(P0,P1,t) do{}while(0)
  #define ENDW(tt) do{ if((tt)+3<NT){WAIT_BAR(2);} else if((tt)+2<NT){WAIT_BAR(1);} else {WAIT_BAR(0);} }while(0)
  for(;t+1<NT;t+=2){
    STEP(pB0,pB1,pA0,pA1,t,(t+3<NT),(t+1<NT),(t+1<NT));       ENDW(t);   RESC(); ROT();
    STEP(pA0,pA1,pB0,pB1,t+1,(t+4<NT),(t+2<NT),(t+2<NT));     ENDW(t+1); RESC(); ROT();
  }
  STEP(pB0,pB1,pA0,pA1,NT-1,false,false,false); RESC();
  { float sacc=pB0[0]+pB0[1]; _Pragma("unroll") for(int r=2;r<16;++r)sacc+=pB0[r]; _Pragma("unroll") for(int r=0;r<16;++r)sacc+=pB1[r]; l_reg+=sacc;
    pw0=(u32x4){PKW(pB0,0),PKW(pB0,2),PKW(pB0,4),PKW(pB0,6)};pw1=(u32x4){PKW(pB0,8),PKW(pB0,10),PKW(pB0,12),PKW(pB0,14)};pw2=(u32x4){PKW(pB1,0),PKW(pB1,2),PKW(pB1,4),PKW(pB1,6)};pw3=(u32x4){PKW(pB1,8),PKW(pB1,10),PKW(pB1,12),PKW(pB1,14)};
    SBAR(); pv(o,vb0+sl_cur,PAF(0),PAF(1),PAF(2),PAF(3)); }
  #undef PKW
  #undef PAF
  #undef VFR
  #undef PIN
  #undef MX3
  #undef GAPA
  #undef GAPB
  #undef EX
  #undef VRD
  #undef KRD
  #undef STEP
  #undef ENDW
  {auto rr=__builtin_amdgcn_permlane32_swap(__float_as_uint(l_reg),__float_as_uint(l_reg),false,false);l_reg=__uint_as_float(rr[0])+__uint_as_float(rr[1]);}
  if(hi==0)wsf[32+r32]=l_reg;asm volatile("s_waitcnt lgkmcnt(0)":::"memory");
  float rli[16];
  #pragma unroll
  for(int r=0;r<16;++r)rli[r]=__builtin_amdgcn_rcpf(wsf[32+crow(r,hi)]);

  { bf16*stg=(bf16*)(shm+LDS_OST)+wid*2048;
    #pragma unroll
    for(int r=0;r<16;++r){const int orow=crow(r,hi);
      #pragma unroll
      for(int d0=0;d0<2;++d0)stg[orow*64+d0*32+r32]=__float2bfloat16(o[d0][r]*rli[r]);}
    asm volatile("s_waitcnt lgkmcnt(0)":::"memory");
    #pragma unroll
    for(int i=0;i<4;++i){const int row=i*8+(lane>>3),ch=lane&7; const u32x4 v=*(const u32x4*)(stg+row*64+ch*8); if(STORE)ATTN_STORE16(Ow+(long)row*OP+ch*8,v);} }
  asm volatile("s_waitcnt lgkmcnt(0)\n\ts_barrier":::"memory");
  #undef DMA_K
  #undef DMA_V
  #undef CMASK
  #undef START
  #undef RESC
  #undef ROT
}
constexpr int ATTN_LDS_BYTES=LDS_BYTES;
#undef SBAR
#undef WAIT_BAR
}
#define DEVI __device__ __forceinline__
typedef unsigned short bf16_t;
typedef short bf16x8 __attribute__((ext_vector_type(8)));
typedef float f32x4 __attribute__((ext_vector_type(4)));
typedef unsigned u32x4 __attribute__((ext_vector_type(4)));
typedef unsigned u32x2 __attribute__((ext_vector_type(2)));
typedef short s16x4 __attribute__((ext_vector_type(4)));
#define LAS __attribute__((address_space(3)))

constexpr int T = 98304, TP = 65536, DM = 1024, INW = 2816, DFF = 2816, MEMROWS = 8704;
constexpr int NWAVES = 8;
constexpr float LOG2E = 1.4426950408889634f;
constexpr size_t MiB = 1u << 20;
constexpr size_t W_IN = 0, W_OUT = W_IN + (size_t)2816 * 1024, W_Q = W_OUT + (size_t)1024 * 1024, W_KV = W_Q + (size_t)256 * 1024, W_O = W_KV + (size_t)512 * 1024,
                 W_UP = W_O + (size_t)1024 * 256, W_DN = W_UP + (size_t)5632 * 1024, W_GLU = W_DN + (size_t)1024 * 2816, W_LAYER = W_GLU + (size_t)256 * 256;
constexpr size_t WS_W = 1 * MiB, WS_TAB = 54 * MiB, WS_XK = 55 * MiB, WS_XVT = 64 * MiB, WS_ACT1 = 75 * MiB, WS_BIG = 267 * MiB;
static_assert(WS_W + 2 * W_LAYER * 2 <= WS_TAB, "weights fit");
constexpr size_t TAB_S5A = 0, TAB_S5B = 64 * 1024, TAB_ROPE = 640 * 1024, TAB_LB = 704 * 1024;
constexpr size_t XK_LAYER = (size_t)MEMROWS * 256;
constexpr size_t WS_PROJ = WS_BIG, WS_VTA = WS_BIG + 528 * MiB, WS_HB = WS_VTA + 48 * MiB, WS_ODB = WS_HB + 48 * MiB, WS_S5F = WS_ODB + 48 * MiB,
                 WS_HF = WS_S5F + 12 * MiB, WS_HD = WS_HF + 24 * MiB, WS_SS = 977 * MiB, WS_END = WS_SS + 7 * MiB;
constexpr size_t WS_MN = WS_BIG;
constexpr size_t WS_XQ = WS_BIG, WS_XO = WS_BIG + 48 * MiB;
constexpr size_t WS_G = WS_BIG, WS_H = WS_BIG + 352 * MiB;
static_assert(WS_H + 352 * MiB <= WS_SS && WS_HD + 1 * MiB <= WS_SS && WS_END <= 1024 * MiB, "workspace map");
constexpr int LDS_BYTES = 147456;
constexpr int WLDS = 16384;

struct Args { const float* in[33]; float* out; unsigned char* ws; int grid, pad; };

DEVI float wsum(float v) {
#pragma unroll
    for (int o = 1; o < 64; o <<= 1) v += __shfl_xor(v, o);
    return v;
}
DEVI unsigned cvtpk(float lo, float hi) { return pg8::cvt_pk_bf16(lo, hi); }
DEVI float bflo(unsigned u) { return __uint_as_float(u << 16); }
DEVI float bfhi(unsigned u) { return __uint_as_float(u & 0xffff0000u); }
DEVI float bf1(bf16_t h) { return __uint_as_float((unsigned)h << 16); }
DEVI bf16_t tobf(float f) { return (bf16_t)(cvtpk(f, 0.f) & 0xffffu); }
DEVI void wave_sync() { asm volatile("s_waitcnt lgkmcnt(0)" ::: "memory"); __builtin_amdgcn_wave_barrier(); asm volatile("" ::: "memory"); }
DEVI float sigmoidf_(float x) { return __builtin_amdgcn_rcpf(1.0f + __expf(-x)); }
DEVI void seq_of(int tok, int& start, int& len) { if (tok < TP) { start = tok & ~2047; len = 2048; } else { start = TP + ((tok - TP) & ~16383); len = 16384; } }
DEVI int batch_of(int tok) { return tok < TP ? (tok >> 11) : 32 + ((tok - TP) >> 14); }

DEVI float row_rstd(const float* SS, size_t row) { const f32x4* p = (const f32x4*)(SS + row * 16); const f32x4 a0 = p[0], a1 = p[1], a2 = p[2], a3 = p[3];
    const float s = ((a0[0] + a0[1]) + (a0[2] + a0[3])) + ((a1[0] + a1[1]) + (a1[2] + a1[3])) + ((a2[0] + a2[1]) + (a2[2] + a2[3])) + ((a3[0] + a3[1]) + (a3[2] + a3[3]));
    return rsqrtf(s * (1.0f / 1024.0f) + 1e-6f); }
DEVI void rows_rstd8(const float* SS, int row0, int fq, float (&rs)[8]) {
    f32x4 p[8];
#pragma unroll
    for (int i = 0; i < 8; ++i) p[i] = *(const f32x4*)(SS + (size_t)(row0 + (i >> 2) * 128 + (i & 3) * 16) * 16 + 4 * fq);
    asm volatile("" ::: "memory");
#pragma unroll
    for (int i = 0; i < 8; ++i) { float s = (p[i][0] + p[i][1]) + (p[i][2] + p[i][3]); s += __shfl_xor(s, 16); s += __shfl_xor(s, 32); rs[i] = rsqrtf(s * (1.0f / 1024.0f) + 1e-6f); }
}
struct EpiStore {
    static constexpr bool PERM = true, AFTER_DRAIN = false;
    bf16_t* O; int ldc; int tpn; bf16_t* TB; int tcs, trb, tsh; const float* SS;
    DEVI void operator()(const pg8::f32x4 (&acc)[2][2][4][2], const pg8::Unit& u, int, int, int, int) const {
        int t_ = threadIdx.x; asm volatile("" : "+v"(t_)); const int fr = t_ & 15, fq = (t_ >> 4) & 3, wid_ = __builtin_amdgcn_readfirstlane(t_ >> 6), wr = wid_ >> 2, wc = wid_ & 3;
        const int row0 = u.pm * 256 + wr * 64 + fr, col0 = u.pn * 256 + wc * 32 + 8 * fq;
        float rsv[8];
        if (SS) rows_rstd8(SS, row0, fq, rsv); else {
#pragma unroll
            for (int i = 0; i < 8; ++i) rsv[i] = 1.f; }
        if (u.pn == tpn) {
#pragma unroll
            for (int ai = 0; ai < 2; ++ai)
#pragma unroll
                for (int m = 0; m < 4; ++m) { const int row = row0 + ai * 128 + m * 16; bf16_t* tp = TB + (size_t)(row >> tsh) * trb + (row & ((1 << tsh) - 1)); const float rs = rsv[ai * 4 + m];
#pragma unroll
                    for (int bj = 0; bj < 2; ++bj) { const int tc = wc * 32 + 8 * fq + bj * 128;
#pragma unroll
                        for (int n = 0; n < 2; ++n)
#pragma unroll
                            for (int e = 0; e < 4; ++e) tp[(size_t)(tc + 4 * n + e) * tcs] = tobf(acc[ai][bj][m][n][e] * rs); } }
        } else {
#pragma unroll
            for (int ai = 0; ai < 2; ++ai)
#pragma unroll
                for (int m = 0; m < 4; ++m) { bf16_t* rowp = O + (size_t)(row0 + ai * 128 + m * 16) * ldc + col0; const float rs = rsv[ai * 4 + m];
#pragma unroll
                    for (int bj = 0; bj < 2; ++bj) { const pg8::f32x4 v0 = acc[ai][bj][m][0] * rs, v1 = acc[ai][bj][m][1] * rs; u32x4 w;
                        w.x = cvtpk(v0[0], v0[1]); w.y = cvtpk(v0[2], v0[3]); w.z = cvtpk(v1[0], v1[1]); w.w = cvtpk(v1[2], v1[3]);
                        *(u32x4*)(rowp + bj * 128) = w; } }
        }
    }
};
struct EpiGlu {
    static constexpr bool PERM = true, AFTER_DRAIN = false;
    const bf16_t* HB; bf16_t* O; const float* bias;
    DEVI void operator()(const pg8::f32x4 (&acc)[2][2][4][2], const pg8::Unit& u, int, int, int, int) const {
        int t_ = threadIdx.x; asm volatile("" : "+v"(t_)); const int fr = t_ & 15, fq = (t_ >> 4) & 3, wid_ = __builtin_amdgcn_readfirstlane(t_ >> 6), wr = wid_ >> 2, wc = wid_ & 3;
        const int row0 = u.pm * 256 + wr * 64 + fr, col0 = wc * 32 + 8 * fq;
        f32x4 bb[2][2];
#pragma unroll
        for (int bj = 0; bj < 2; ++bj)
#pragma unroll
            for (int n = 0; n < 2; ++n) bb[bj][n] = *(const f32x4*)(bias + col0 + bj * 128 + 4 * n);
#pragma unroll
        for (int ai = 0; ai < 2; ++ai) {
            u32x4 hv[4][2];
#pragma unroll
            for (int m = 0; m < 4; ++m)
#pragma unroll
                for (int bj = 0; bj < 2; ++bj) hv[m][bj] = *(const u32x4*)(HB + (size_t)(row0 + ai * 128 + m * 16) * 256 + col0 + bj * 128);
            asm volatile("" ::: "memory");
#pragma unroll
            for (int m = 0; m < 4; ++m) { const size_t row = row0 + ai * 128 + m * 16;
#pragma unroll
                for (int bj = 0; bj < 2; ++bj) { const int col = col0 + bj * 128; u32x4 w;
#pragma unroll
                    for (int n = 0; n < 2; ++n) { const f32x4 b = bb[bj][n]; const pg8::f32x4 v = acc[ai][bj][m][n]; const unsigned h0 = hv[m][bj][2 * n], h1 = hv[m][bj][2 * n + 1];
                        const float s0 = __builtin_amdgcn_rcpf(1.f + __expf(-(v[0] + b[0]))), s1 = __builtin_amdgcn_rcpf(1.f + __expf(-(v[1] + b[1])));
                        const float s2 = __builtin_amdgcn_rcpf(1.f + __expf(-(v[2] + b[2]))), s3 = __builtin_amdgcn_rcpf(1.f + __expf(-(v[3] + b[3])));
                        w[2 * n] = cvtpk(bflo(h0) * s0, bfhi(h0) * s1); w[2 * n + 1] = cvtpk(bflo(h1) * s2, bfhi(h1) * s3); }
                    *(u32x4*)(O + row * INW + 768 + col) = w; } }
            asm volatile("" ::: "memory"); }
    }
};
struct EpiRes {
    static constexpr bool PERM = false, AFTER_DRAIN = false;
    float* X; bf16_t* XB; float* SS; const float* S0; const float* S1; int split;
    DEVI void operator()(const pg8::f32x4 (&acc)[2][2][4][2], const pg8::Unit& u, int, int, int, int) const {
        int t_ = threadIdx.x; asm volatile("" : "+v"(t_)); const int fr = t_ & 15, fq = (t_ >> 4) & 3, wid_ = __builtin_amdgcn_readfirstlane(t_ >> 6), wr = wid_ >> 2, wc = wid_ & 3;
        const int row0 = u.pm * 256 + wr * 64 + fr, col0 = u.pn * 256 + wc * 32 + 4 * fq;
#pragma unroll
        for (int ai = 0; ai < 2; ++ai)
#pragma unroll
            for (int mp = 0; mp < 2; ++mp) {
                f32x4 xin[2][2][2];
#pragma unroll
                for (int mm = 0; mm < 2; ++mm) { const size_t row = (size_t)(row0 + ai * 128 + (2 * mp + mm) * 16);
                    const float* srcp = ((int)row < split ? S0 + row * 1024 : S1 + (row - split) * 1024) + col0;
#pragma unroll
                    for (int bj = 0; bj < 2; ++bj)
#pragma unroll
                        for (int n = 0; n < 2; ++n) xin[mm][bj][n] = *(const f32x4*)(srcp + bj * 128 + n * 16); }
                asm volatile("" ::: "memory");
#pragma unroll
                for (int mm = 0; mm < 2; ++mm) { const int m = 2 * mp + mm; const size_t row = (size_t)(row0 + ai * 128 + m * 16); float* rowp = X + row * 1024 + col0; bf16_t* rowb = XB + row * 1024 + col0; float ssq = 0.f;
#pragma unroll
                    for (int bj = 0; bj < 2; ++bj)
#pragma unroll
                        for (int n = 0; n < 2; ++n) { f32x4 x = xin[mm][bj][n]; const pg8::f32x4 a = acc[ai][bj][m][n];
                            x[0] += a[0]; x[1] += a[1]; x[2] += a[2]; x[3] += a[3]; *(f32x4*)(rowp + bj * 128 + n * 16) = x; ssq += (x[0] * x[0] + x[1] * x[1]) + (x[2] * x[2] + x[3] * x[3]);
                            u32x2 w; w.x = cvtpk(x[0], x[1]); w.y = cvtpk(x[2], x[3]); *(u32x2*)(rowb + bj * 128 + n * 16) = w; }
                    ssq += __shfl_xor(ssq, 16); ssq += __shfl_xor(ssq, 32);
                    if (fq == 0) SS[row * 16 + u.pn * 4 + wc] = ssq; }
                asm volatile("" ::: "memory");
            }
    }
};
struct EpiConv {
    static constexpr bool PERM = true, AFTER_DRAIN = false;
    const bf16_t* G; bf16_t* H; const float* cw; const float* cb; int tok0; const float* SS;
    DEVI void operator()(const pg8::f32x4 (&acc)[2][2][4][2], const pg8::Unit& u, int, int, int, int) const {
        int t_ = threadIdx.x; asm volatile("" : "+v"(t_)); const int fr = t_ & 15, fq = (t_ >> 4) & 3, wid_ = __builtin_amdgcn_readfirstlane(t_ >> 6), wr = wid_ >> 2, wc = wid_ & 3;
        const int row0 = u.pm * 256 + wr * 64 + fr, col0 = u.pn * 256 + wc * 32 + 8 * fq;
        float rsv[8]; rows_rstd8(SS, row0, fq, rsv);
#pragma unroll
        for (int bj = 0; bj < 2; ++bj) { const int col = col0 + bj * 128;
            float w0[8], w1[8], w2[8], b[8];
#pragma unroll
            for (int e = 0; e < 8; e += 4) { const f32x4 a0 = *(const f32x4*)(cw + col + e), a1 = *(const f32x4*)(cw + DFF + col + e), a2 = *(const f32x4*)(cw + 2 * DFF + col + e), bb = *(const f32x4*)(cb + col + e);
#pragma unroll
                for (int q = 0; q < 4; ++q) { w0[e + q] = a0[q]; w1[e + q] = a1[q]; w2[e + q] = a2[q]; b[e + q] = bb[q]; } }
#pragma unroll
            for (int ai = 0; ai < 2; ++ai) {
#pragma unroll
              for (int mp = 0; mp < 2; ++mp) {
                u32x4 gl[4], gm[4], gr[4];
#pragma unroll
                for (int m = 2 * mp; m < 2 * mp + 2; ++m) { const int row = row0 + ai * 128 + m * 16; const int tok = tok0 + row; int ss, sl; seq_of(tok, ss, sl); const int pos = tok - ss;
                    const bf16_t* gp = G + (size_t)row * DFF + col; const u32x4 z4 = {0u, 0u, 0u, 0u};
                    gm[m] = *(const u32x4*)gp; gl[m] = pos > 0 ? *(const u32x4*)(gp - DFF) : z4; gr[m] = pos < sl - 1 ? *(const u32x4*)(gp + DFF) : z4; }
                asm volatile("" ::: "memory");
#pragma unroll
                for (int m = 2 * mp; m < 2 * mp + 2; ++m) { const int row = row0 + ai * 128 + m * 16; const float rs = rsv[ai * 4 + m];
                    float o[8];
#pragma unroll
                    for (int e = 0; e < 4; ++e) { const unsigned l2 = gl[m][e], m2 = gm[m][e], r2 = gr[m][e];
                        const float c0 = b[2 * e] + w0[2 * e] * bflo(l2) + w1[2 * e] * bflo(m2) + w2[2 * e] * bflo(r2);
                        const float c1 = b[2 * e + 1] + w0[2 * e + 1] * bfhi(l2) + w1[2 * e + 1] * bfhi(m2) + w2[2 * e + 1] * bfhi(r2);
                        o[2 * e] = c0 * sigmoidf_(c0) * rs * acc[ai][bj][m][e >> 1][(2 * e) & 3]; o[2 * e + 1] = c1 * sigmoidf_(c1) * rs * acc[ai][bj][m][e >> 1][(2 * e + 1) & 3]; }
                    u32x4 w; w.x = cvtpk(o[0], o[1]); w.y = cvtpk(o[2], o[3]); w.z = cvtpk(o[4], o[5]); w.w = cvtpk(o[6], o[7]);
                    *(u32x4*)(H + (size_t)row * DFF + col) = w; }
                asm volatile("" ::: "memory"); } } }
    }
};
DEVI void transpose_item(const float* W, int K, int N, bf16_t* WT, float* scr, int item, int lane, const float* ksc = nullptr) {
    const int nblk = N / 32, kb = item / nblk, nb = item % nblk, k0 = 64 * kb, n0 = 32 * nb;
#pragma unroll 8
    for (int i = 0; i < 32; ++i) { const int kk = 2 * i + (lane >> 5); scr[kk * 33 + (lane & 31)] = W[(size_t)(k0 + kk) * N + n0 + (lane & 31)] * (ksc ? ksc[k0 + kk] : 1.0f); }
    wave_sync();
    const int c = lane & 7;
#pragma unroll
    for (int j = 0; j < 4; ++j) { const int n = (lane >> 3) + 8 * j; const float* s = scr + (8 * c) * 33 + n;
        u32x4 o; o.x = cvtpk(s[0 * 33], s[1 * 33]); o.y = cvtpk(s[2 * 33], s[3 * 33]); o.z = cvtpk(s[4 * 33], s[5 * 33]); o.w = cvtpk(s[6 * 33], s[7 * 33]);
        *(u32x4*)(WT + (size_t)(n0 + n) * K + k0 + 8 * c) = o; }
    wave_sync();
}
DEVI void norm_row(const float* xrow, const float* w, bf16_t* orow, float* copy, int lane) {
    const f32x4* xr = (const f32x4*)xrow + lane; f32x4 v[4]; float s = 0.f;
#pragma unroll
    for (int j = 0; j < 4; ++j) { v[j] = xr[64 * j]; s += (v[j][0] * v[j][0] + v[j][1] * v[j][1]) + (v[j][2] * v[j][2] + v[j][3] * v[j][3]); }
    if (copy) {
#pragma unroll
        for (int j = 0; j < 4; ++j) ((f32x4*)copy + lane)[64 * j] = v[j]; }
    const float r = rsqrtf(wsum(s) * (1.0f / 1024.0f) + 1e-6f);
    const f32x4* wr = (const f32x4*)w + lane;
#pragma unroll
    for (int j = 0; j < 4; ++j) { const f32x4 ww = wr[64 * j]; u32x2 o; o.x = cvtpk(v[j][0] * r * ww[0], v[j][1] * r * ww[1]); o.y = cvtpk(v[j][2] * r * ww[2], v[j][3] * r * ww[3]);
        ((u32x2*)orow + lane)[64 * j] = o; }
}
DEVI void copy_rows2(const float* xa, const float* xb_, bf16_t* oa, bf16_t* ob, float* ssa, float* ssb, int lane) {
    const f32x4* pa = (const f32x4*)xa + lane; const f32x4* pb = (const f32x4*)xb_ + lane; f32x4 v[4], u[4];
#pragma unroll
    for (int j = 0; j < 4; ++j) { v[j] = pa[64 * j]; u[j] = pb[64 * j]; }
    asm volatile("" ::: "memory");
    float s = 0.f, q = 0.f;
#pragma unroll
    for (int j = 0; j < 4; ++j) { s += (v[j][0] * v[j][0] + v[j][1] * v[j][1]) + (v[j][2] * v[j][2] + v[j][3] * v[j][3]); q += (u[j][0] * u[j][0] + u[j][1] * u[j][1]) + (u[j][2] * u[j][2] + u[j][3] * u[j][3]);
        u32x2 o; o.x = cvtpk(v[j][0], v[j][1]); o.y = cvtpk(v[j][2], v[j][3]); ((u32x2*)oa + lane)[64 * j] = o; u32x2 p; p.x = cvtpk(u[j][0], u[j][1]); p.y = cvtpk(u[j][2], u[j][3]); ((u32x2*)ob + lane)[64 * j] = p; }
    s = wsum(s); q = wsum(q);
    if (lane < 16) { ssa[lane] = lane == 0 ? s : 0.f; ssb[lane] = lane == 0 ? q : 0.f; }
}
DEVI void final_norm_rows2(float* xrow0, float* xrow1, const float* w, int lane) {
    f32x4* x0 = (f32x4*)xrow0 + lane; f32x4* x1 = (f32x4*)xrow1 + lane; f32x4 v[4], u[4];
#pragma unroll
    for (int j = 0; j < 4; ++j) { v[j] = x0[64 * j]; u[j] = x1[64 * j]; }
    asm volatile("" ::: "memory");
    float s = 0.f, q = 0.f;
#pragma unroll
    for (int j = 0; j < 4; ++j) { s += (v[j][0] * v[j][0] + v[j][1] * v[j][1]) + (v[j][2] * v[j][2] + v[j][3] * v[j][3]); q += (u[j][0] * u[j][0] + u[j][1] * u[j][1]) + (u[j][2] * u[j][2] + u[j][3] * u[j][3]); }
    const float r = rsqrtf(wsum(s) * (1.0f / 1024.0f) + 1e-6f), r2 = rsqrtf(wsum(q) * (1.0f / 1024.0f) + 1e-6f);
    const f32x4* wr = (const f32x4*)w + lane;
#pragma unroll
    for (int j = 0; j < 4; ++j) { const f32x4 ww = wr[64 * j]; f32x4 o, p; o[0] = v[j][0] * r * ww[0]; o[1] = v[j][1] * r * ww[1]; o[2] = v[j][2] * r * ww[2]; o[3] = v[j][3] * r * ww[3];
        p[0] = u[j][0] * r2 * ww[0]; p[1] = u[j][1] * r2 * ww[1]; p[2] = u[j][2] * r2 * ww[2]; p[3] = u[j][3] * r2 * ww[3]; x0[64 * j] = o; x1[64 * j] = p; }
}

template <class G, bool BATCH = true, bool STORE = true> DEVI void attn256(const bf16_t* qrow, const G& g, bf16_t* orow, float scale2, int lane) {
    const int fq = lane >> 4;
    const bf16x8 qb0 = *(const bf16x8*)(qrow + 8 * fq), qb1 = *(const bf16x8*)(qrow + 32 + 8 * fq);
    f32x4 st[16];
#pragma unroll
    for (int half = 0; half < 2; ++half) {
        bf16x8 ka[8][2];
#pragma unroll
        for (int i = 0; i < 8; ++i) { const bf16_t* kp = g.krow(8 * half + i); ka[i][0] = *(const bf16x8*)(kp + 8 * fq); ka[i][1] = *(const bf16x8*)(kp + 32 + 8 * fq); }
        asm volatile("" ::: "memory");
#pragma unroll
        for (int i = 0; i < 8; ++i) { f32x4 acc = {0.f, 0.f, 0.f, 0.f};
            acc = __builtin_amdgcn_mfma_f32_16x16x32_bf16(ka[i][0], qb0, acc, 0, 0, 0);
            acc = __builtin_amdgcn_mfma_f32_16x16x32_bf16(ka[i][1], qb1, acc, 0, 0, 0);
            st[8 * half + i] = acc; }
    }
    u32x2 vlo0[4][4], vhi0[4][4];
    if (BATCH) {
#pragma unroll
        for (int k4 = 0; k4 < 4; ++k4)
#pragma unroll
            for (int dt = 0; dt < 4; ++dt) { vlo0[k4][dt] = *(const u32x2*)g.vt(k4, dt, 0); vhi0[k4][dt] = *(const u32x2*)g.vt(k4, dt, 1); }
        asm volatile("" ::: "memory");
    }
    float mx = -INFINITY;
    {   f32x4 bz[16];
#pragma unroll
        for (int nt = 0; nt < 16; ++nt)
#pragma unroll
            for (int r = 0; r < 4; ++r) bz[nt][r] = g.bias2(nt, r);
        asm volatile("" ::: "memory");
#pragma unroll
        for (int nt = 0; nt < 16; ++nt)
#pragma unroll
            for (int r = 0; r < 4; ++r) { const float v = st[nt][r] * scale2 + bz[nt][r]; st[nt][r] = v; mx = fmaxf(mx, v); } }
    mx = fmaxf(mx, __shfl_xor(mx, 16)); mx = fmaxf(mx, __shfl_xor(mx, 32));
    float sum = 0.f;
#pragma unroll
    for (int nt = 0; nt < 16; ++nt)
#pragma unroll
        for (int r = 0; r < 4; ++r) { const float p = __builtin_amdgcn_exp2f(st[nt][r] - mx); st[nt][r] = p; sum += p; }
    sum += __shfl_xor(sum, 16); sum += __shfl_xor(sum, 32);
    const float inv = 1.0f / sum;
    f32x4 o[4];
#pragma unroll
    for (int dt = 0; dt < 4; ++dt) o[dt] = (f32x4){0.f, 0.f, 0.f, 0.f};
    if (BATCH)
#pragma unroll
    for (int half = 0; half < 2; ++half) {
        u32x2 vlo[4][4], vhi[4][4];
#pragma unroll
        for (int k4 = 0; k4 < 4; ++k4)
#pragma unroll
            for (int dt = 0; dt < 4; ++dt) { if (half == 0) { vlo[k4][dt] = vlo0[k4][dt]; vhi[k4][dt] = vhi0[k4][dt]; } else { vlo[k4][dt] = *(const u32x2*)g.vt(4 + k4, dt, 0); vhi[k4][dt] = *(const u32x2*)g.vt(4 + k4, dt, 1); } }
        asm volatile("" ::: "memory");
#pragma unroll
        for (int k4 = 0; k4 < 4; ++k4) { const int ks = 4 * half + k4;
            u32x4 pw; pw.x = cvtpk(st[2 * ks][0], st[2 * ks][1]); pw.y = cvtpk(st[2 * ks][2], st[2 * ks][3]); pw.z = cvtpk(st[2 * ks + 1][0], st[2 * ks + 1][1]); pw.w = cvtpk(st[2 * ks + 1][2], st[2 * ks + 1][3]);
            const bf16x8 pb = __builtin_bit_cast(bf16x8, pw);
#pragma unroll
            for (int dt = 0; dt < 4; ++dt) { u32x4 vw; vw.x = vlo[k4][dt].x; vw.y = vlo[k4][dt].y; vw.z = vhi[k4][dt].x; vw.w = vhi[k4][dt].y;
                o[dt] = __builtin_amdgcn_mfma_f32_16x16x32_bf16(__builtin_bit_cast(bf16x8, vw), pb, o[dt], 0, 0, 0); } }
    }
    if (!BATCH) {
#pragma unroll
        for (int ks = 0; ks < 8; ++ks) {
            u32x4 pw; pw.x = cvtpk(st[2 * ks][0], st[2 * ks][1]); pw.y = cvtpk(st[2 * ks][2], st[2 * ks][3]); pw.z = cvtpk(st[2 * ks + 1][0], st[2 * ks + 1][1]); pw.w = cvtpk(st[2 * ks + 1][2], st[2 * ks + 1][3]);
            const bf16x8 pb = __builtin_bit_cast(bf16x8, pw);
#pragma unroll
            for (int dt = 0; dt < 4; ++dt) { const u32x2 lo = *(const u32x2*)g.vt(ks, dt, 0), hi = *(const u32x2*)g.vt(ks, dt, 1); u32x4 vw; vw.x = lo.x; vw.y = lo.y; vw.z = hi.x; vw.w = hi.y;
                o[dt] = __builtin_amdgcn_mfma_f32_16x16x32_bf16(__builtin_bit_cast(bf16x8, vw), pb, o[dt], 0, 0, 0); } }
    }
#pragma unroll
    for (int dt = 0; dt < 4; ++dt) { u32x2 w; w.x = cvtpk(o[dt][0] * inv, o[dt][1] * inv); w.y = cvtpk(o[dt][2] * inv, o[dt][3] * inv); if (STORE || w.x == 0x12345678u) *(u32x2*)(orow + 16 * dt + 4 * fq) = w; }
}
struct NaGeom {
    const bf16_t* proj; const bf16_t* vta; const float* rpb; int seq_start, r, r0, qs, ks, h, fr, fq;
    DEVI const bf16_t* krow(int nt) const { const int i = nt >> 1, kc = (nt & 1) * 16 + fr; const size_t tok = (size_t)(seq_start + (r0 + i) * 64 + ks + kc); return proj + tok * INW + 256 + h * 64; }
    DEVI const bf16_t* vt(int kstep, int dt, int half) const { const int d = 16 * dt + fr; const size_t tok = (size_t)(seq_start + (r0 + kstep) * 64 + ks + 16 * half + 4 * fq); return vta + ((tok >> 6) * 256 + (size_t)(h * 64 + d)) * 64 + (tok & 63); }
    DEVI float bias2(int nt, int reg) const { const int i = nt >> 1, kcol = ks + (nt & 1) * 16 + 4 * fq + reg, qcol = qs + fr; const int c0 = min(max(qcol - 8, 0), 48);
        const bool in = (kcol >= c0) && (kcol < c0 + 16); const int dr = (r0 + i) - r + 7, dc = min(max(kcol - qcol, -15), 15) + 15;
        const float bv = rpb[(h * 15 + dr) * 31 + dc]; return in ? bv * LOG2E : -INFINITY; }
};
struct XaGeomL {
    const bf16_t* kl; const bf16_t* vtl; int fr, fq;
    DEVI const bf16_t* krow(int nt) const { return kl + (16 * nt + fr) * 72; }
    DEVI const bf16_t* vt(int kstep, int dt, int half) const { return vtl + (16 * dt + fr) * 264 + 32 * kstep + 16 * half + 4 * fq; }
    DEVI float bias2(int, int) const { return 0.f; }
};
struct XaGeom {
    const bf16_t* xk; const bf16_t* xvt; int b, h, fr, fq;
    DEVI const bf16_t* krow(int nt) const { return xk + (size_t)(b * 256 + 16 * nt + fr) * 256 + h * 64; }
    DEVI const bf16_t* vt(int kstep, int dt, int half) const { return xvt + (size_t)(b * 256 + h * 64 + 16 * dt + fr) * 256 + 32 * kstep + 16 * half + 4 * fq; }
    DEVI float bias2(int, int) const { return 0.f; }
};
DEVI void s5_load_b(const float* S5B, int pg, int lane, bf16x8 (&bB)[8]) {
    const int fr = lane & 15, fq = lane >> 4;
    f32x4 x[8], y[8];
#pragma unroll
    for (int nt = 0; nt < 8; ++nt) { const float* src = S5B + ((size_t)pg * 64 + 16 * (nt & 3) + fr) * 32 + (nt >> 2) * 16 + 8 * (fq & 1); x[nt] = *(const f32x4*)src; y[nt] = *(const f32x4*)(src + 4); }
    asm volatile("" ::: "memory");
#pragma unroll
    for (int nt = 0; nt < 8; ++nt) { u32x4 w = {0u, 0u, 0u, 0u};
        if (fq < 2) { w.x = cvtpk(x[nt][0], x[nt][1]); w.y = cvtpk(x[nt][2], x[nt][3]); w.z = cvtpk(y[nt][0], y[nt][1]); w.w = cvtpk(y[nt][2], y[nt][3]); }
        bB[nt] = __builtin_bit_cast(bf16x8, w); }
}
DEVI void s5_bu_block(const bf16_t* Ubf, bf16_t* BUX, const bf16x8 (&bB)[8], int lane) {
    const int fr = lane & 15, fq = lane >> 4;
    u32x4 aw = {0u, 0u, 0u, 0u}; if (fq < 2) aw = *(const u32x4*)(Ubf + fr * 16 + 8 * fq);
    const bf16x8 aU = __builtin_bit_cast(bf16x8, aw);
#pragma unroll
    for (int nt = 0; nt < 8; ++nt) { f32x4 d = {0.f, 0.f, 0.f, 0.f}; d = __builtin_amdgcn_mfma_f32_16x16x32_bf16(aU, bB[nt], d, 0, 0, 0);
#pragma unroll
        for (int r = 0; r < 4; ++r) BUX[(4 * fq + r) * 136 + 16 * nt + fr] = tobf(d[r]); }
}
DEVI void s5_pass1(const bf16_t* proj, const float* S5A, const float* S5B, float* S5F, int l, unsigned char* wl, int gw, int NGW, int lane) {
    bf16_t* Ubf = (bf16_t*)wl;
    bf16_t* BUX = (bf16_t*)(wl + 512);
    const int srow = lane >> 2, spc = lane & 3;
    for (int u = gw; u < 768 * 32; u += NGW) {
        const int dir = u & 1, g = (u >> 1) & 15, chunk = u >> 5; const size_t cs = (size_t)chunk * 128;
        const int pg = (l * 2 + dir) * 16 + g; const int p = pg * 64 + lane;
        const f32x4 a4 = *(const f32x4*)(S5A + (size_t)p * 4); const float ar = a4[0], ai = a4[1];
        bf16x8 bB[8]; s5_load_b(S5B, pg, lane, bB);
        float xr = 0.f, xi = 0.f;
        const bf16_t* ub = proj + 768 + g * 16 + spc * 4;
        u32x2 cur = *(const u32x2*)(ub + ((dir ? cs + 112 : cs) + srow) * INW);
        for (int blk = 0; blk < 8; ++blk) {
            u32x2 nxt = cur;
            if (blk < 7) { const size_t tb = dir ? cs + 112 - 16 * (blk + 1) : cs + 16 * (blk + 1); nxt = *(const u32x2*)(ub + (tb + srow) * INW); }
            *(u32x2*)(Ubf + srow * 16 + spc * 4) = cur;
            wave_sync();
            s5_bu_block(Ubf, BUX, bB, lane);
            wave_sync();
#pragma unroll
            for (int k = 0; k < 16; ++k) { const int row = dir ? 15 - k : k; const float bur = bf1(BUX[row * 136 + lane]), bui = bf1(BUX[row * 136 + 64 + lane]);
                const float nr = ar * xr - ai * xi + bur, ni = ar * xi + ai * xr + bui; xr = nr; xi = ni; }
            wave_sync();
            cur = nxt;
        }
        float* f = S5F + ((size_t)(chunk * 16 + g) * 2 + dir) * 128;
        f[lane] = xr; f[64 + lane] = xi;
    }
}
DEVI float gelu_tanh(float y) { const float z = 0.7978845608028654f * (y + 0.044715f * y * y * y); const float e = __expf(2.0f * z); const float th = 1.0f - 2.0f * __builtin_amdgcn_rcpf(1.0f + e); return 0.5f * y * (1.0f + th); }
DEVI void s5_pass2(const bf16_t* proj, const float* S5A, const float* S5B, const float* S5F, const float* cre, const float* cim, const float* dskip, bf16_t* HB,
                   int l, unsigned char* wl, int gw, int NGW, int lane) {
    bf16_t* Ubf = (bf16_t*)wl;
    bf16_t* BUX = (bf16_t*)(wl + 512);
    float* YL = (float*)(wl + 512 + 4352);
    const int srow = lane >> 2, spc = lane & 3, fr = lane & 15, fq = lane >> 4;
    for (int u = gw; u < 768 * 16; u += NGW) {
        const int g = u & 15, chunk = u >> 4; const int csi = chunk * 128; const size_t cs = (size_t)csi;
        int ss, sl; seq_of(csi, ss, sl); const int nch = sl >> 7, cj = (csi - ss) >> 7, cb0 = ss >> 7;
        const bf16_t* ub = proj + 768 + g * 16 + spc * 4;
        for (int dir = 0; dir < 2; ++dir) {
            const int pg = (l * 2 + dir) * 16 + g; const int p = pg * 64 + lane;
            const f32x4 a4 = *(const f32x4*)(S5A + (size_t)p * 4); const float ar = a4[0], ai = a4[1], pr = a4[2], pi = a4[3];
            bf16x8 bB[8]; s5_load_b(S5B, pg, lane, bB);
            bf16x8 Cb[4];
            { f32x4 cx[4], cy[4];
#pragma unroll
              for (int s = 0; s < 4; ++s) { const float* src = (s < 2 ? cre : cim) + ((size_t)pg * 16 + fr) * 64 + 32 * (s & 1) + 8 * fq; cx[s] = *(const f32x4*)src; cy[s] = *(const f32x4*)(src + 4); }
              asm volatile("" ::: "memory");
#pragma unroll
              for (int s = 0; s < 4; ++s) { const float sg = s < 2 ? 1.f : -1.f; const f32x4 x = cx[s], y = cy[s]; u32x4 w;
                w.x = cvtpk(sg * x[0], sg * x[1]); w.y = cvtpk(sg * x[2], sg * x[3]); w.z = cvtpk(sg * y[0], sg * y[1]); w.w = cvtpk(sg * y[2], sg * y[3]); Cb[s] = __builtin_bit_cast(bf16x8, w); } }
            float xr = 0.f, xi = 0.f;
            {
                const int n = dir == 0 ? cj : nch - 1 - cj; const int c0 = dir == 0 ? cb0 : cb0 + nch - 1; const int cstep = dir == 0 ? 1 : -1;
                for (int i0 = 0; i0 < n; i0 += 8) { float fr_[8], fi_[8];
#pragma unroll
                    for (int j = 0; j < 8; ++j) { const int i = min(i0 + j, n - 1); const float* f = S5F + ((size_t)((c0 + cstep * i) * 16 + g) * 2 + dir) * 128; fr_[j] = f[lane]; fi_[j] = f[64 + lane]; }
#pragma unroll
                    for (int j = 0; j < 8; ++j) if (i0 + j < n) { const float nr = pr * xr - pi * xi + fr_[j], ni = pr * xi + pi * xr + fi_[j]; xr = nr; xi = ni; } }
            }
            u32x2 cur = *(const u32x2*)(ub + ((dir ? cs + 112 : cs) + srow) * INW);
            for (int blk = 0; blk < 8; ++blk) {
                const int tl0 = dir ? 112 - 16 * blk : 16 * blk;
                u32x2 nxt = cur;
                if (blk < 7) { const size_t tb = dir ? cs + 112 - 16 * (blk + 1) : cs + 16 * (blk + 1); nxt = *(const u32x2*)(ub + (tb + srow) * INW); }
                *(u32x2*)(Ubf + srow * 16 + spc * 4) = cur;
                wave_sync();
                s5_bu_block(Ubf, BUX, bB, lane);
                wave_sync();
#pragma unroll
                for (int k = 0; k < 16; ++k) { const int row = dir ? 15 - k : k; const float bur = bf1(BUX[row * 136 + lane]), bui = bf1(BUX[row * 136 + 64 + lane]);
                    const float nr = ar * xr - ai * xi + bur, ni = ar * xi + ai * xr + bui; xr = nr; xi = ni;
                    BUX[row * 136 + lane] = tobf(xr); BUX[row * 136 + 64 + lane] = tobf(xi); }
                wave_sync();
                f32x4 acc = {0.f, 0.f, 0.f, 0.f};
#pragma unroll
                for (int s = 0; s < 4; ++s) { const bf16x8 a = *(const bf16x8*)(BUX + fr * 136 + 32 * s + 8 * fq); acc = __builtin_amdgcn_mfma_f32_16x16x32_bf16(a, Cb[s], acc, 0, 0, 0); }
#pragma unroll
                for (int r = 0; r < 4; ++r) { float* yp = YL + (tl0 + 4 * fq + r) * 17 + fr; if (dir == 0) *yp = acc[r]; else *yp += acc[r]; }
                wave_sync();
                cur = nxt;
            }
        }
        for (int i0 = 0; i0 < 32; i0 += 16) { bf16_t ur[16];
#pragma unroll
            for (int j = 0; j < 16; ++j) { const int idx = (i0 + j) * 64 + lane, t = idx >> 4, c = idx & 15; ur[j] = proj[(cs + t) * INW + 768 + g * 16 + c]; }
            asm volatile("" ::: "memory");
#pragma unroll
            for (int j = 0; j < 16; ++j) { const int idx = (i0 + j) * 64 + lane, t = idx >> 4, c = idx & 15;
                const float y = YL[t * 17 + c] + dskip[g * 16 + c] * bf1(ur[j]); HB[(cs + t) * 256 + g * 16 + c] = tobf(gelu_tanh(y)); } }
        wave_sync();
    }
}

template <int PASS> DEVI void hgrn_pass(const bf16_t* proj, const float* LB, float* HF, float* HD, bf16_t* OF, LAS unsigned char* wll, int l, unsigned char* wl, int gw, int NGW, int lane) {
    bf16_t* Qt = (bf16_t*)wl;
    bf16_t* Kt = (bf16_t*)(wl + 2304);
    bf16_t* Vt = (bf16_t*)(wl + 4608);
    bf16_t* K2t = (bf16_t*)(wl + 6656);
    float* EB = (float*)(wl + 8704);
    float* EC = (float*)(wl + 8960);
    const bf16_t* RZ = (const bf16_t*)(wl + 9216);
    const bf16_t* RV = (const bf16_t*)(wl + 11264);
    const bf16_t* RQ = (const bf16_t*)(wl + 13312);
    const int fr = lane & 15, fq = lane >> 4;
#define HG_DMA(tbv) do { _Pragma("unroll") for (int i_ = 0; i_ < 2; ++i_) { const int r_ = 8 * i_ + (lane >> 3); const size_t go_ = ((tbv) + (dir ? 15 - r_ : r_)) * INW + (lane & 7) * 8; \
        __builtin_amdgcn_global_load_lds((const unsigned*)(zb + go_), (LAS unsigned*)(wll + 9216 + i_ * 1024), 16, 0, 0); \
        __builtin_amdgcn_global_load_lds((const unsigned*)(vb + go_), (LAS unsigned*)(wll + 11264 + i_ * 1024), 16, 0, 0); \
        if (PASS == 2) __builtin_amdgcn_global_load_lds((const unsigned*)(qbp + go_), (LAS unsigned*)(wll + 13312 + i_ * 1024), 16, 0, 0); } \
        asm volatile("" ::: "memory"); } while (0)
    for (int u = gw; u < 192 * 8; u += NGW) {
        const int dir = u & 1, h = (u >> 1) & 3, chunk = u >> 3; const size_t cs = (size_t)chunk * 512;
        const float lb = LB[l * 256 + h * 64 + lane], oml = 1.f - lb;
        f32x4 S[4][4];
        float* hf = HF + (size_t)u * 4096;
        if (PASS == 2) {
#pragma unroll
            for (int mt = 0; mt < 4; ++mt)
#pragma unroll
                for (int nt = 0; nt < 4; ++nt)
#pragma unroll
                    for (int r = 0; r < 4; ++r) S[mt][nt][r] = hf[(16 * mt + 4 * fq + r) * 64 + 16 * nt + fr];
        } else {
#pragma unroll
            for (int mt = 0; mt < 4; ++mt)
#pragma unroll
                for (int nt = 0; nt < 4; ++nt) S[mt][nt] = (f32x4){0.f, 0.f, 0.f, 0.f};
        }
        float bsum = 0.f;
        const bf16_t* zb = proj + (dir ? 2048 : 1792) + h * 64;
        const bf16_t* vb = proj + 2304 + h * 64;
        const bf16_t* qbp = proj + 1536 + h * 64;
        size_t tb = dir ? cs + 496 : cs;
        asm volatile("s_waitcnt vmcnt(0)" ::: "memory");
        HG_DMA(tb);
        asm volatile("s_waitcnt vmcnt(0)" ::: "memory");
        for (int blk = 0; blk < 32; ++blk) {
            if (blk > 0) { if (PASS == 2) asm volatile("s_waitcnt vmcnt(16)" ::: "memory"); else asm volatile("s_waitcnt vmcnt(0)" ::: "memory"); }
            wave_sync();
            float bs[16]; unsigned omp[8]; float c = 0.f, Bt = 0.f;
            { float b = 0.f;
#pragma unroll
              for (int s = 0; s < 16; ++s) { const float e = __expf(fminf(fmaxf(bf1(RZ[s * 64 + lane]), -20.f), 20.f)); const float o_ = oml * __builtin_amdgcn_rcpf(1.f + e);
                  if (s & 1) omp[s >> 1] |= (unsigned)tobf(o_) << 16; else omp[s >> 1] = (unsigned)tobf(o_);
                  b += __logf(1.f - o_); bs[s] = b; }
              c = bs[7]; Bt = b; }
            bsum += Bt;
            { u32x4 va, vbw; unsigned vw[8];
#pragma unroll
              for (int s = 0; s < 16; s += 2) vw[s >> 1] = (unsigned)RV[s * 64 + lane] | ((unsigned)RV[(s + 1) * 64 + lane] << 16);
              va.x = vw[0]; va.y = vw[1]; va.z = vw[2]; va.w = vw[3]; vbw.x = vw[4]; vbw.y = vw[5]; vbw.z = vw[6]; vbw.w = vw[7];
              *(u32x4*)(Vt + lane * 16) = va; *(u32x4*)(Vt + lane * 16 + 8) = vbw; }
            { u32x4 k2a, k2b; unsigned k2w[8];
#pragma unroll
              for (int s = 0; s < 16; s += 2) {
                  const float om0 = bflo(omp[s >> 1]), om1 = bfhi(omp[s >> 1]), b0 = bs[s], b1 = bs[s + 1];
                  const float k2_0 = om0 * __expf(Bt - b0), k2_1 = om1 * __expf(Bt - b1); k2w[s >> 1] = cvtpk(k2_0, k2_1);
                  Kt[s * 72 + lane] = tobf(om0 * __expf(c - b0)); Kt[(s + 1) * 72 + lane] = tobf(om1 * __expf(c - b1));
                  if (PASS == 2) { Qt[s * 72 + lane] = tobf(bf1(RQ[s * 64 + lane]) * __expf(b0 - c)); Qt[(s + 1) * 72 + lane] = tobf(bf1(RQ[(s + 1) * 64 + lane]) * __expf(b1 - c)); } }
              k2a.x = k2w[0]; k2a.y = k2w[1]; k2a.z = k2w[2]; k2a.w = k2w[3]; k2b.x = k2w[4]; k2b.y = k2w[5]; k2b.z = k2w[6]; k2b.w = k2w[7];
              *(u32x4*)(K2t + lane * 16) = k2a; *(u32x4*)(K2t + lane * 16 + 8) = k2b;
              EB[lane] = __expf(Bt); EC[lane] = __expf(c); }
            wave_sync();
            const size_t tcur = tb;
            if (blk < 31) { tb = dir ? tb - 16 : tb + 16; HG_DMA(tb); }
            s16x4 vB[4];
#pragma unroll
            for (int nt = 0; nt < 4; ++nt) vB[nt] = *(const s16x4*)(Vt + (16 * nt + fr) * 16 + 4 * fq);
            if (PASS == 2) {
                f32x4 at = {0.f, 0.f, 0.f, 0.f};
#pragma unroll
                for (int ks = 0; ks < 2; ++ks) { const bf16x8 ka = *(const bf16x8*)(Kt + fr * 72 + 32 * ks + 8 * fq), qb = *(const bf16x8*)(Qt + fr * 72 + 32 * ks + 8 * fq);
                    at = __builtin_amdgcn_mfma_f32_16x16x32_bf16(ka, qb, at, 0, 0, 0); }
#pragma unroll
                for (int r = 0; r < 4; ++r) at[r] = (4 * fq + r <= fr) ? at[r] : 0.f;
                u32x2 aw; aw.x = cvtpk(at[0], at[1]); aw.y = cvtpk(at[2], at[3]); const s16x4 aP = __builtin_bit_cast(s16x4, aw);
                bf16x8 qP[2];
#pragma unroll
                for (int ks = 0; ks < 2; ++ks) { const u32x2 x = *(const u32x2*)(Qt + fr * 72 + 32 * ks + 4 * fq), y = *(const u32x2*)(Qt + fr * 72 + 32 * ks + 16 + 4 * fq); u32x4 w; w.x = x.x; w.y = x.y; w.z = y.x; w.w = y.y; qP[ks] = __builtin_bit_cast(bf16x8, w); }
                f32x4 ec[4];
#pragma unroll
                for (int mt = 0; mt < 4; ++mt) ec[mt] = *(const f32x4*)(EC + 16 * mt + 4 * fq);
#pragma unroll
                for (int nt = 0; nt < 4; ++nt) { f32x4 o = {0.f, 0.f, 0.f, 0.f};
#pragma unroll
                    for (int ks = 0; ks < 2; ++ks) { const f32x4 e0 = ec[2 * ks], e1 = ec[2 * ks + 1]; u32x4 w; w.x = cvtpk(S[2 * ks][nt][0] * e0[0], S[2 * ks][nt][1] * e0[1]); w.y = cvtpk(S[2 * ks][nt][2] * e0[2], S[2 * ks][nt][3] * e0[3]);
                        w.z = cvtpk(S[2 * ks + 1][nt][0] * e1[0], S[2 * ks + 1][nt][1] * e1[1]); w.w = cvtpk(S[2 * ks + 1][nt][2] * e1[2], S[2 * ks + 1][nt][3] * e1[3]);
                        o = __builtin_amdgcn_mfma_f32_16x16x32_bf16(qP[ks], __builtin_bit_cast(bf16x8, w), o, 0, 0, 0); }
                    o = __builtin_amdgcn_mfma_f32_16x16x16bf16_1k(aP, vB[nt], o, 0, 0, 0);
#pragma unroll
                    for (int r = 0; r < 4; ++r) { const int t = 4 * fq + r; const int tl = dir ? 15 - t : t;
                        (OF + tcur * INW + (dir ? 2048 : 1792) + h * 64 + 16 * nt)[tl * INW + fr] = tobf(o[r]); } }
            }
#pragma unroll
            for (int mt = 0; mt < 4; ++mt) { const s16x4 k2A = *(const s16x4*)(K2t + (16 * mt + fr) * 16 + 4 * fq);
                const f32x4 eb = *(const f32x4*)(EB + 16 * mt + 4 * fq);
#pragma unroll
                for (int nt = 0; nt < 4; ++nt) { f32x4 cin; cin[0] = S[mt][nt][0] * eb[0]; cin[1] = S[mt][nt][1] * eb[1]; cin[2] = S[mt][nt][2] * eb[2]; cin[3] = S[mt][nt][3] * eb[3];
                    S[mt][nt] = __builtin_amdgcn_mfma_f32_16x16x16bf16_1k(k2A, vB[nt], cin, 0, 0, 0); } }
        }
        if (PASS == 1) {
#pragma unroll
            for (int mt = 0; mt < 4; ++mt)
#pragma unroll
                for (int nt = 0; nt < 4; ++nt)
#pragma unroll
                    for (int r = 0; r < 4; ++r) hf[(16 * mt + 4 * fq + r) * 64 + 16 * nt + fr] = S[mt][nt][r];
            HD[(size_t)u * 64 + lane] = __expf(bsum);
        }
    }
#undef HG_DMA
}
DEVI void hgrn_chain(float* HF, const float* HD, int gw, int NGW, int lane) {
    for (int w = gw; w < 34 * 8 * 4; w += NGW) {
        const int slab = w & 3, dir = (w >> 2) & 1, h = (w >> 3) & 3, sq = w >> 5;
        const int cb0 = sq < 32 ? sq * 4 : 128 + (sq - 32) * 32, nch = sq < 32 ? 4 : 32;
        float C[16], F[16], Dd[16];
#pragma unroll
        for (int k = 0; k < 16; ++k) C[k] = 0.f;
        { const int ci = dir ? nch - 1 : 0; const size_t uidx = ((size_t)(cb0 + ci) * 4 + h) * 2 + dir; const float* hf = HF + uidx * 4096 + (size_t)slab * 16 * 64 + lane; const float* hd = HD + uidx * 64 + slab * 16;
#pragma unroll
          for (int k = 0; k < 16; ++k) { F[k] = hf[k * 64]; Dd[k] = hd[k]; } }
        for (int i = 0; i < nch; ++i) { const int ci = dir ? nch - 1 - i : i; const size_t uidx = ((size_t)(cb0 + ci) * 4 + h) * 2 + dir;
            float* hf = HF + uidx * 4096 + (size_t)slab * 16 * 64 + lane;
            float Fn[16], Dn[16];
            { const int i2 = min(i + 1, nch - 1); const int ci2 = dir ? nch - 1 - i2 : i2; const size_t u2 = ((size_t)(cb0 + ci2) * 4 + h) * 2 + dir; const float* hf2 = HF + u2 * 4096 + (size_t)slab * 16 * 64 + lane; const float* hd2 = HD + u2 * 64 + slab * 16;
#pragma unroll
              for (int k = 0; k < 16; ++k) { Fn[k] = hf2[k * 64]; Dn[k] = hd2[k]; } }
#pragma unroll
            for (int k = 0; k < 16; ++k) { hf[k * 64] = C[k]; C[k] = Dd[k] * C[k] + F[k]; }
#pragma unroll
            for (int k = 0; k < 16; ++k) { F[k] = Fn[k]; Dd[k] = Dn[k]; } }
    }
}

DEVI void qk_finish(bf16_t* base, unsigned a, unsigned b, const f32x4 cs4, const f32x4 nw, float sc, int i) {
    float x0 = bflo(a), x1 = bfhi(a), y0 = bflo(b), y1 = bfhi(b);
    float s = x0 * x0 + x1 * x1 + y0 * y0 + y1 * y1;
    s += __shfl_xor(s, 1); s += __shfl_xor(s, 2); s += __shfl_xor(s, 4); s += __shfl_xor(s, 8);
    const float r = rsqrtf(s * (1.0f / 64.0f) + 1e-6f);
    x0 *= r * nw[0]; x1 *= r * nw[1]; y0 *= r * nw[2]; y1 *= r * nw[3];
    const float o0 = (x0 * cs4[0] - y0 * cs4[1]) * sc, o1 = (x1 * cs4[2] - y1 * cs4[3]) * sc, p0 = (y0 * cs4[0] + x0 * cs4[1]) * sc, p1 = (y1 * cs4[2] + x1 * cs4[3]) * sc;
    *(unsigned*)(base + 2 * i) = cvtpk(o0, o1); *(unsigned*)(base + 32 + 2 * i) = cvtpk(p0, p1);
}
DEVI void qk_prep(bf16_t* proj, const float* qw, const float* kw, const float* rope, int gw, int NGW, int lane) {
    const int i = lane & 15;
    const f32x4 qn = {qw[2 * i], qw[2 * i + 1], qw[32 + 2 * i], qw[33 + 2 * i]}, kn = {kw[2 * i], kw[2 * i + 1], kw[32 + 2 * i], kw[33 + 2 * i]};
    for (int tok0 = gw; tok0 < T; tok0 += 4 * NGW) {
        unsigned qa[4], qb[4], ka[4], kb[4]; f32x4 cs[4];
#pragma unroll
        for (int j = 0; j < 4; ++j) { const int tok = min(tok0 + j * NGW, T - 1);
            int ss, sl; seq_of(tok, ss, sl); const int pos = tok - ss, pr = pos >> 6, pc = pos & 63; const int pp = (2 * i < 16) ? pr : pc, fi = (2 * i) & 15;
            cs[j] = *(const f32x4*)(rope + ((size_t)pp * 16 + fi) * 2);
            const bf16_t* bq = proj + (size_t)tok * INW + 1024 + (lane >> 4) * 64; const bf16_t* bk = proj + (size_t)tok * INW + 1280 + ((lane >> 4) & 1) * 64;
            qa[j] = *(const unsigned*)(bq + 2 * i); qb[j] = *(const unsigned*)(bq + 32 + 2 * i); ka[j] = *(const unsigned*)(bk + 2 * i); kb[j] = *(const unsigned*)(bk + 32 + 2 * i); }
        asm volatile("" ::: "memory");
#pragma unroll
        for (int j = 0; j < 4; ++j) { const int tok = tok0 + j * NGW; if (tok < T) {
            qk_finish(proj + (size_t)tok * INW + 1024 + (lane >> 4) * 64, qa[j], qb[j], cs[j], qn, 0.125f * LOG2E, i);
            if (lane < 32) qk_finish(proj + (size_t)tok * INW + 1280 + (lane >> 4) * 64, ka[j], kb[j], cs[j], kn, 1.0f, i); } }
    }
}
DEVI void merge_row_finish(bf16_t* row, const u32x2 (&in)[6], const f32x4 (&w)[4]) {
#pragma unroll
    for (int gi = 0; gi < 4; ++gi) {
        const u32x2 a = in[gi]; float v0 = bflo(a.x), v1 = bfhi(a.x), v2 = bflo(a.y), v3 = bfhi(a.y);
        if (gi == 3) { const u32x2 b = in[4]; v0 += bflo(b.x); v1 += bfhi(b.x); v2 += bflo(b.y); v3 += bfhi(b.y); }
        const float s = wsum(v0 * v0 + v1 * v1 + v2 * v2 + v3 * v3); const float r = rsqrtf(s * (1.0f / 256.0f) + 1e-6f);
        v0 *= r * w[gi][0]; v1 *= r * w[gi][1]; v2 *= r * w[gi][2]; v3 *= r * w[gi][3];
        if (gi == 3) { const u32x2 g = in[5]; const float g0 = bflo(g.x), g1 = bfhi(g.x), g2 = bflo(g.y), g3 = bfhi(g.y);
            v0 *= g0 * sigmoidf_(g0); v1 *= g1 * sigmoidf_(g1); v2 *= g2 * sigmoidf_(g2); v3 *= g3 * sigmoidf_(g3); }
        u32x2 o; o.x = cvtpk(v0, v1); o.y = cvtpk(v2, v3); *(u32x2*)(row + gi * 256) = o;
    }
}
DEVI void merge_norm(bf16_t* proj, const float* gw_, int gwv, int NGW, int lane) {
    f32x4 w[4];
#pragma unroll
    for (int gi = 0; gi < 4; ++gi) w[gi] = *(const f32x4*)(gw_ + gi * 256 + 4 * lane);
    for (int tok = gwv; tok < T; tok += 2 * NGW) {
        bf16_t* r0 = proj + (size_t)tok * INW + 4 * lane; const bool two = tok + NGW < T; bf16_t* r1 = proj + (size_t)(two ? tok + NGW : tok) * INW + 4 * lane;
        u32x2 a[6], b[6];
        a[0] = *(const u32x2*)(r0); a[1] = *(const u32x2*)(r0 + 768); a[2] = *(const u32x2*)(r0 + 1024); a[3] = *(const u32x2*)(r0 + 1792); a[4] = *(const u32x2*)(r0 + 2048); a[5] = *(const u32x2*)(r0 + 2560);
        b[0] = *(const u32x2*)(r1); b[1] = *(const u32x2*)(r1 + 768); b[2] = *(const u32x2*)(r1 + 1024); b[3] = *(const u32x2*)(r1 + 1792); b[4] = *(const u32x2*)(r1 + 2048); b[5] = *(const u32x2*)(r1 + 2560);
        asm volatile("" ::: "memory");
        merge_row_finish(r0, a, w);
        if (two) merge_row_finish(r1, b, w);
    }
}
#define XB_TMO      128
#define XB_XCNT(j)  (256  + 64 * (j))
#define XB_XSUB(j)  (1280 + 64 * (j))
#define XB_XGEN(j)  (2304 + 64 * (j))
#define XB_TOP      3328
#define XB_TOPGEN   3392
#define XCD_BAR_WORDS 3456
#define XB_SPIN_CAP (1u << 18)

__device__ __forceinline__ unsigned xb_ld(unsigned* p)              { return __hip_atomic_load(p, __ATOMIC_RELAXED, __HIP_MEMORY_SCOPE_AGENT); }
__device__ __forceinline__ unsigned xb_add(unsigned* p, unsigned v) { return __hip_atomic_fetch_add(p, v, __ATOMIC_RELAXED, __HIP_MEMORY_SCOPE_AGENT); }
__device__ __forceinline__ unsigned xb_xcc_id() { return (unsigned)__builtin_amdgcn_s_getreg((3 << 11) | 20) & 0xFu; }
#define XB_SPIN(cond, bar) do { unsigned _sp = 0; while (cond) { __builtin_amdgcn_s_sleep(1); \
    if ((++_sp & 255u) == 0u) { if (xb_ld(&(bar)[XB_TMO])) break; if (_sp > XB_SPIN_CAP) { atomicAdd(&(bar)[XB_TMO], 1u); break; } } } } while (0)

struct XcdBarrier {
    unsigned* bar; unsigned x;
    volatile LAS unsigned* st;
};

__device__ __forceinline__ XcdBarrier xcd_barrier_post(unsigned* bar, volatile LAS unsigned* st) {
    XcdBarrier b; b.bar = bar; b.x = xb_xcc_id(); b.st = st;
    if (threadIdx.x == 0) (void)xb_add(&bar[XB_XCNT(b.x)], 1u);
    return b;
}
__device__ __forceinline__ void xcd_barrier_complete(unsigned* bar, unsigned x, unsigned& nloc, unsigned& nx) {
    const unsigned G = gridDim.x * gridDim.y * gridDim.z;
    unsigned sum, cnt, mine, sp = 0u;
    for (;;) {
        sum = 0u; cnt = 0u; mine = 0u;
#pragma unroll
        for (unsigned j = 0; j < 16; ++j) { const unsigned c = xb_ld(&bar[XB_XCNT(j)]); sum += c; cnt += (c > 0u) ? 1u : 0u; mine = (j == x) ? c : mine; }
        if (sum == G) break;
        __builtin_amdgcn_s_sleep(1);
        if ((++sp & 255u) == 0u) { if (xb_ld(&bar[XB_TMO])) break; if (sp > XB_SPIN_CAP) { atomicAdd(&bar[XB_TMO], 1u); break; } }
    }
    nloc = mine > 0u ? mine : 1u; nx = cnt > 0u ? cnt : 1u;
}

__device__ __forceinline__ void xcd_barrier(const XcdBarrier& b) {
    asm volatile("s_waitcnt vmcnt(0)" ::: "memory");
    __syncthreads();
    if (threadIdx.x == 0) {
        unsigned* bar = b.bar;
        __builtin_amdgcn_s_waitcnt(0);
        unsigned nloc = b.st[0], nx = b.st[1];
        if (nloc == 0u) { xcd_barrier_complete(bar, b.x, nloc, nx); b.st[0] = nloc; b.st[1] = nx; }
        const unsigned old = xb_add(&bar[XB_XSUB(b.x)], 1u);
        const unsigned gen = old / nloc;
        if (old + 1u == (gen + 1u) * nloc) {
            __builtin_amdgcn_fence(__ATOMIC_RELEASE, "agent");
            asm volatile("s_waitcnt vmcnt(0)" ::: "memory");
            const unsigned og = xb_add(&bar[XB_TOP], 1u);
            const unsigned tg = og / nx;
            if (og + 1u == (tg + 1u) * nx) xb_add(&bar[XB_TOPGEN], 1u);
            else XB_SPIN(xb_ld(&bar[XB_TOPGEN]) == tg, bar);
            __builtin_amdgcn_fence(__ATOMIC_ACQUIRE, "agent");
            xb_add(&bar[XB_XGEN(b.x)], 1u);
            asm volatile("s_waitcnt vmcnt(0)" ::: "memory");
        } else {
            XB_SPIN(xb_ld(&bar[XB_XGEN(b.x)]) == gen, bar);
            __builtin_amdgcn_fence(__ATOMIC_ACQUIRE, "agent");
            asm volatile("s_waitcnt vmcnt(0)" ::: "memory");
        }
    }
    __syncthreads();
}
typedef const Args __attribute__((address_space(4)))* ArgsP;
DEVI ArgsP argsp() { ArgsP p = (ArgsP)__builtin_amdgcn_kernarg_segment_ptr(); asm volatile("" : "+s"(p)); return p; }
DEVI int wave_id() { int t = threadIdx.x; asm volatile("" : "+v"(t)); return __builtin_amdgcn_readfirstlane(t >> 6); }
DEVI int lane_id() { int t = threadIdx.x; asm volatile("" : "+v"(t)); return t & 63; }
#define AIN(k) (argsp()->in[k])
#define WSP(off) (argsp()->ws + (off))
#define Wt ((bf16_t*)WSP(WS_W))
#define S5A ((float*)WSP(WS_TAB + TAB_S5A))
#define S5B ((float*)WSP(WS_TAB + TAB_S5B))
#define ROPE ((float*)WSP(WS_TAB + TAB_ROPE))
#define LBT ((float*)WSP(WS_TAB + TAB_LB))
#define XK ((bf16_t*)WSP(WS_XK))
#define XVT ((bf16_t*)WSP(WS_XVT))
#define ACT1 ((bf16_t*)WSP(WS_ACT1))
#define PROJ ((bf16_t*)WSP(WS_PROJ))
#define VTA ((bf16_t*)WSP(WS_VTA))
#define HB ((bf16_t*)WSP(WS_HB))
#define ODB ((bf16_t*)WSP(WS_ODB))
#define S5F ((float*)WSP(WS_S5F))
#define HF ((float*)WSP(WS_HF))
#define HD ((float*)WSP(WS_HD))
#define MN ((bf16_t*)WSP(WS_MN))
#define XQ ((bf16_t*)WSP(WS_XQ))
#define XO ((bf16_t*)WSP(WS_XO))
#define GB ((bf16_t*)WSP(WS_G))
#define HH ((bf16_t*)WSP(WS_H))
#define SSQ ((float*)WSP(WS_SS))
#define X (argsp()->out)
#define GRIDN (argsp()->grid)
#define WCTX const int lane = lane_id(), wave = wave_id(), G = GRIDN, gw = (int)blockIdx.x * NWAVES + wave, NGW = G * NWAVES; unsigned char* wl = lds + wave * WLDS; (void)lane; (void)gw; (void)NGW; (void)wl
#define SYNC_CG() cg::this_grid().sync()
#define SYNC() do { XcdBarrier b_; b_.bar = (unsigned*)WSP(4096); b_.x = xb_xcc_id(); b_.st = (volatile LAS unsigned*)(lds + 131072); xcd_barrier(b_); } while (0)
#ifndef REP_GEMM
#define REP_GEMM 1
#endif
#ifndef REP_GQA
#define REP_GQA 1
#endif
#ifndef REP_XA
#define REP_XA 1
#endif
#ifndef REP_S5
#define REP_S5 1
#endif
#ifndef REP_HG
#define REP_HG 1
#endif
#ifndef REP_NA
#define REP_NA 1
#endif
#define GEMM_CALL(EPI, KC_, g_, S_, E_) pg8::gemm_phase<EPI, pg8::StaticOrder, true, true, KC_>((PG8_LAS unsigned char*)lds, g_, S_, E_)
#define GEMM_CALL_LDA(EPI, KC_, LDA_, g_, S_, E_) pg8::gemm_phase<EPI, pg8::StaticOrder, true, true, KC_, LDA_>((PG8_LAS unsigned char*)lds, g_, S_, E_)
#define WL_(l) (Wt + (size_t)(l) * W_LAYER)
__global__ void __launch_bounds__(NWAVES * 64, 2) fwd_mega(Args a_unused) {
    extern __shared__ __attribute__((aligned(16))) unsigned char lds[];
    if (threadIdx.x < 64) ((volatile LAS unsigned*)(lds + 131072))[threadIdx.x] = 0u;
    __syncthreads();
    (void)xcd_barrier_post((unsigned*)WSP(4096), (volatile LAS unsigned*)(lds + 131072));
    {
        WCTX; float* scr = (float*)wl;
        for (int l = 0; l < 2; ++l) {
            bf16_t* wl_ = WL_(l);
            constexpr int I0 = 16 * 88, I1 = I0 + 16 * 32, I2 = I1 + 16 * 8, I3 = I2 + 16 * 16, I4 = I3 + 4 * 32, I5 = I4 + 16 * 176, I6 = I5 + 44 * 32, I7 = I6 + 4 * 8;
            for (int it = gw; it < I7; it += NGW) {
                if (it < I0) transpose_item(AIN(5) + (size_t)l * 1024 * 2816, 1024, 2816, wl_ + W_IN, scr, it, lane, AIN(4) + l * 1024);
                else if (it < I1) transpose_item(AIN(21) + (size_t)l * 1024 * 1024, 1024, 1024, wl_ + W_OUT, scr, it - I0, lane);
                else if (it < I2) transpose_item(AIN(24) + (size_t)l * 1024 * 256, 1024, 256, wl_ + W_Q, scr, it - I1, lane, AIN(22) + l * 1024);
                else if (it < I3) transpose_item(AIN(25) + (size_t)l * 1024 * 512, 1024, 512, wl_ + W_KV, scr, it - I2, lane);
                else if (it < I4) transpose_item(AIN(26) + (size_t)l * 256 * 1024, 256, 1024, wl_ + W_O, scr, it - I3, lane);
                else if (it < I5) transpose_item(AIN(28) + (size_t)l * 1024 * 5632, 1024, 5632, wl_ + W_UP, scr, it - I4, lane, AIN(27) + l * 1024);
                else if (it < I6) transpose_item(AIN(31) + (size_t)l * 2816 * 1024, 2816, 1024, wl_ + W_DN, scr, it - I5, lane);
                else transpose_item(AIN(15) + (size_t)l * 256 * 256, 256, 256, wl_ + W_GLU, scr, it - I6, lane);
            }
        }
        const int gt = (int)blockIdx.x * (NWAVES * 64) + (int)threadIdx.x, NGT = G * NWAVES * 64;
        for (int idx = gt; idx < 4096; idx += NGT) {
            const int ldg = idx >> 6;
            const double lre = fmin((double)AIN(7)[idx], -1e-4), lim = (double)AIN(8)[idx], dt = exp((double)AIN(9)[ldg]);
            const double mag = exp(lre * dt), are = mag * cos(lim * dt), aim = mag * sin(lim * dt);
            const double mag2 = exp(lre * dt * 128.0), pre = mag2 * cos(lim * dt * 128.0), pim = mag2 * sin(lim * dt * 128.0);
            const double den = lre * lre + lim * lim, nre = are - 1.0, nim = aim;
            const double cr = (nre * lre + nim * lim) / den, ci = (nim * lre - nre * lim) / den;
            float* sa = S5A; float* sb = S5B;
            sa[idx * 4 + 0] = (float)are; sa[idx * 4 + 1] = (float)aim; sa[idx * 4 + 2] = (float)pre; sa[idx * 4 + 3] = (float)pim;
            for (int c = 0; c < 16; ++c) { const double br = (double)AIN(10)[(size_t)idx * 16 + c], bi = (double)AIN(11)[(size_t)idx * 16 + c];
                sb[(size_t)idx * 32 + c] = (float)(cr * br - ci * bi); sb[(size_t)idx * 32 + 16 + c] = (float)(cr * bi + ci * br); }
        }
        for (int idx = gt; idx < 4096; idx += NGT) {
            const int p = idx >> 4, f = idx & 15; const float inv = (float)exp(-(double)f * (log(10000.0) / 16.0)); const float ang = (float)p * inv;
            float* rp = ROPE; rp[idx * 2] = (float)cos((double)ang); rp[idx * 2 + 1] = (float)sin((double)ang);
        }
        for (int idx = gt; idx < 512; idx += NGT) {
            const int c = idx & 255; const float p0 = AIN(19)[c], p1 = AIN(19)[256 + c];
            LBT[idx] = idx < 256 ? 0.f : 1.0f / (1.0f + __expf(p1 - p0));
        }
        for (int r = gw; r < 2 * MEMROWS; r += NGW) {
            const int l = r / MEMROWS, row = r % MEMROWS;
            const float* src = row < 8192 ? AIN(2) + (size_t)row * 1024 : AIN(3) + (size_t)(row - 8192) * 1024;
            norm_row(src, AIN(23) + l * 1024, MN + (size_t)r * 1024, nullptr, lane);
        }
        for (int r = gw; r < T; r += 2 * NGW) {
            const int r2 = r + NGW < T ? r + NGW : r;
            const float* s0 = r < TP ? AIN(0) + (size_t)r * 1024 : AIN(1) + (size_t)(r - TP) * 1024; const float* s1 = r2 < TP ? AIN(0) + (size_t)r2 * 1024 : AIN(1) + (size_t)(r2 - TP) * 1024;
            copy_rows2(s0, s1, ACT1 + (size_t)r * 1024, ACT1 + (size_t)r2 * 1024, SSQ + (size_t)r * 16, SSQ + (size_t)r2 * 16, lane);
        }
    }
    SYNC_CG();
    for (int l = 0; l < 2; ++l) {
        pg8::Gemm g{MN + (size_t)l * MEMROWS * 1024, WL_(l) + W_KV, MEMROWS, 512, 1024}; pg8::StaticOrder S; S.init(MEMROWS, 512, GRIDN, (int)blockIdx.x);
        EpiStore E{XK + (size_t)l * XK_LAYER, 256, 1, XVT + (size_t)l * XK_LAYER, 256, 65536, 8, nullptr};
        GEMM_CALL(EpiStore, 1024, g, S, E);
    }
    SYNC();
    for (int l = 0; l < 2; ++l) {
        {
            pg8::Gemm g{ACT1, WL_(l) + W_IN, T, INW, 1024}; EpiStore E{PROJ, INW, 2, VTA, 64, 16384, 6, SSQ}; pg8::StaticOrder S; S.init(T, INW, GRIDN, (int)blockIdx.x);
            for (int rep = 0; rep < REP_GEMM; ++rep) GEMM_CALL(EpiStore, 1024, g, S, E);
        }
        SYNC();
        {
            WCTX;
            qk_prep(PROJ, AIN(17) + l * 64, AIN(18) + l * 64, ROPE, gw, NGW, lane);
            for (int rep = 0; rep < REP_S5; ++rep) s5_pass1(PROJ, S5A, S5B, S5F, l, wl, gw, NGW, lane);
            for (int rep = 0; rep < REP_HG; ++rep) hgrn_pass<1>(PROJ, LBT, HF, HD, nullptr, (LAS unsigned char*)lds + wave * WLDS, l, wl, gw, NGW, lane);
#if REP_NA > 1
#define ATTN_NA attn256<NaGeom, true, false>
            for (int w = gw; w < (T / 16) * 4; w += NGW) {
                const int h = w & 3, blk = w >> 2, tok0 = blk * 16; int ss, sl; seq_of(tok0, ss, sl);
                const int pos = tok0 - ss, r = pos >> 6, cb = (pos & 63) >> 4, rows = sl >> 6;
                NaGeom ng; ng.proj = PROJ; ng.vta = VTA; ng.rpb = AIN(6) + (size_t)l * 4 * 15 * 31; ng.seq_start = ss; ng.r = r; ng.r0 = min(max(r - 4, 0), rows - 8);
                ng.qs = cb * 16; ng.ks = min(max(cb * 16 - 8, 0), 32); ng.h = h; ng.fr = lane & 15; ng.fq = lane >> 4;
                const size_t qtok = (size_t)tok0 + (lane & 15);
                ATTN_NA(ng.proj + qtok * INW + h * 64, ng, PROJ + qtok * INW + h * 64, 0.125f * LOG2E, lane);
            }
#undef ATTN_NA
#endif
#define ATTN_NA attn256<NaGeom, true, true>
            for (int w = gw; w < (T / 16) * 4; w += NGW) {
                const int h = w & 3, blk = w >> 2, tok0 = blk * 16; int ss, sl; seq_of(tok0, ss, sl);
                const int pos = tok0 - ss, r = pos >> 6, cb = (pos & 63) >> 4, rows = sl >> 6;
                NaGeom ng; ng.proj = PROJ; ng.vta = VTA; ng.rpb = AIN(6) + (size_t)l * 4 * 15 * 31; ng.seq_start = ss; ng.r = r; ng.r0 = min(max(r - 4, 0), rows - 8);
                ng.qs = cb * 16; ng.ks = min(max(cb * 16 - 8, 0), 32); ng.h = h; ng.fr = lane & 15; ng.fq = lane >> 4;
                const size_t qtok = (size_t)tok0 + (lane & 15);
                ATTN_NA(ng.proj + qtok * INW + h * 64, ng, PROJ + qtok * INW + h * 64, 0.125f * LOG2E, lane);
            }
#undef ATTN_NA
        }
        SYNC();
        {
            {
                const int G = GRIDN, bx = (int)blockIdx.x, wave = wave_id();
                const int vcu = (G % 8 == 0) ? (bx % 8) * (G / 8) + bx / 8 : bx;
                const int nun = (G == 256) ? 6 : (1536 + G - 1) / G;
                for (int ui = 0; ui < nun; ++ui) {
                    int sq, hh, qb;
                    if (G == 256) {
                        if (ui < 2) { const int grp = vcu >> 6; sq = 32 + (grp >> 1); hh = (grp & 1) * 2 + ui; qb = vcu & 63; }
                        else { const int pg = vcu >> 2, uu = (vcu & 3) * 4 + (ui - 2); sq = pg >> 1; hh = (pg & 1) * 2 + (uu >> 3); qb = uu & 7; }
                    } else {
                        const int idx = ui * G + bx; if (idx >= 1536) break;
                        if (idx < 512) { sq = 32 + (idx >> 8); hh = (idx >> 6) & 3; qb = idx & 63; } else { const int j = idx - 512; sq = j >> 5; hh = (j >> 3) & 3; qb = j & 7; }
                    }
                    const int ss = sq < 32 ? sq * 2048 : TP + (sq - 32) * 16384, sl = sq < 32 ? 2048 : 16384;
                    const size_t qrow = (size_t)ss + qb * 256 + wave * 32;
                    const bf16_t* pj = PROJ;
#if REP_GQA > 1
                    attn_body::attn_unit<8, false>(sl / 64, (const attn_body::bf16*)(pj + qrow * INW + 1024 + hh * 64), (const attn_body::bf16*)(pj + (size_t)ss * INW + 1280 + (hh >> 1) * 64),
                                            (const attn_body::bf16*)(pj + (size_t)ss * INW + 1408 + (hh >> 1) * 64), (attn_body::bf16*)(PROJ + qrow * INW + 1024 + hh * 64), (char*)lds);
#endif
                    attn_body::attn_unit<8>(sl / 64, (const attn_body::bf16*)(pj + qrow * INW + 1024 + hh * 64), (const attn_body::bf16*)(pj + (size_t)ss * INW + 1280 + (hh >> 1) * 64),
                                            (const attn_body::bf16*)(pj + (size_t)ss * INW + 1408 + (hh >> 1) * 64), (attn_body::bf16*)(PROJ + qrow * INW + 1024 + hh * 64), (char*)lds);
                }
            }
            __syncthreads();
            WCTX;
            for (int rep = 0; rep < REP_S5; ++rep) s5_pass2(PROJ, S5A, S5B, S5F, AIN(12), AIN(13), AIN(14) + l * 256, HB, l, wl, gw, NGW, lane);
            hgrn_chain(HF, HD, gw, NGW, lane);
        }
        SYNC();
        {
            { const int G = GRIDN, bx = (int)blockIdx.x; const bool split = (G == 256);
              pg8::Gemm g{HB, WL_(l) + W_GLU, T, 256, 256}; pg8::StaticOrder S; S.init(T, 256, split ? 64 : G, split ? (bx >= 192 ? bx - 192 : 0x3fffffff) : bx); EpiGlu E{HB, PROJ, AIN(16) + l * 256}; GEMM_CALL(EpiGlu, 256, g, S, E); }
            __syncthreads();
            WCTX;
            for (int rep = 0; rep < REP_HG; ++rep) hgrn_pass<2>(PROJ, LBT, HF, HD, PROJ, (LAS unsigned char*)lds + wave * WLDS, l, wl, gw, NGW, lane);
        }
        SYNC();
        { WCTX; merge_norm(PROJ, AIN(20) + l * 1024, gw, NGW, lane); }
        SYNC();
        { pg8::Gemm g{PROJ, WL_(l) + W_OUT, T, 1024, 1024}; EpiRes E{X, ACT1, SSQ, l == 0 ? AIN(0) : (const float*)X, l == 0 ? AIN(1) : (const float*)X + (size_t)TP * 1024, TP}; pg8::StaticOrder S; S.init(T, 1024, GRIDN, (int)blockIdx.x); GEMM_CALL_LDA(EpiRes, 1024, 2816, g, S, E); }
        SYNC();
        { pg8::Gemm g{ACT1, WL_(l) + W_Q, T, 256, 1024}; EpiStore E{XQ, 256, -1, nullptr, 0, 0, 0, SSQ}; pg8::StaticOrder S; S.init(T, 256, GRIDN, (int)blockIdx.x); GEMM_CALL(EpiStore, 1024, g, S, E); }
        SYNC();
        {
            WCTX;
            for (int rep = 0; rep < REP_XA; ++rep)
            for (int uidx = (int)blockIdx.x; uidx < 192; uidx += G) {
                const int h = uidx & 3, seg = uidx >> 2, tokS = seg * 2048, b = batch_of(tokS); int tid = (int)threadIdx.x; asm volatile("" : "+v"(tid));
                bf16_t* Kl = (bf16_t*)lds; bf16_t* VTl = (bf16_t*)(lds + 36864);
                const bf16_t* xk = XK + (size_t)l * XK_LAYER + (size_t)b * 65536 + h * 64;
                const bf16_t* xv = XVT + (size_t)l * XK_LAYER + ((size_t)b * 256 + h * 64) * 256;
#pragma unroll
                for (int i = tid; i < 2048; i += 512) { const int key = i >> 3, ch = i & 7; *(u32x4*)(Kl + key * 72 + ch * 8) = *(const u32x4*)(xk + (size_t)key * 256 + ch * 8); }
#pragma unroll
                for (int i = tid; i < 2048; i += 512) { const int d = i >> 5, ch = i & 31; *(u32x4*)(VTl + d * 264 + ch * 8) = *(const u32x4*)(xv + (size_t)d * 256 + ch * 8); }
                __syncthreads();
                XaGeomL xg; xg.kl = Kl; xg.vtl = VTl; xg.fr = lane & 15; xg.fq = lane >> 4;
                for (int t = wave; t < 128; t += NWAVES) { const size_t qt = (size_t)tokS + t * 16 + (lane & 15);
                    attn256<XaGeomL, false>(XQ + qt * 256 + h * 64, xg, XO + qt * 256 + h * 64, 0.125f * LOG2E, lane); }
                __syncthreads();
            }
        }
        SYNC();
        { pg8::Gemm g{XO, WL_(l) + W_O, T, 1024, 256}; EpiRes E{X, ACT1, SSQ, X, X, 0x7fffffff}; pg8::StaticOrder S; S.init(T, 1024, GRIDN, (int)blockIdx.x); GEMM_CALL(EpiRes, 256, g, S, E); }
        SYNC();
        for (int chunk = 0; chunk < 2; ++chunk) {
            { const int c_row0 = chunk ? TP : 0, c_rows = chunk ? (T - TP) : TP;
              pg8::Gemm g{ACT1 + (size_t)c_row0 * 1024, WL_(l) + W_UP + (size_t)DFF * 1024, c_rows, DFF, 1024}; EpiStore E{GB, DFF, -1, nullptr, 0, 0, 0, SSQ + (size_t)c_row0 * 16}; pg8::StaticOrder S; S.init(c_rows, DFF, GRIDN, (int)blockIdx.x);
              for (int rep = 0; rep < REP_GEMM; ++rep) GEMM_CALL(EpiStore, 1024, g, S, E); }
            SYNC();
            { const int c_row0 = chunk ? TP : 0, c_rows = chunk ? (T - TP) : TP;
              pg8::Gemm g{ACT1 + (size_t)c_row0 * 1024, WL_(l) + W_UP, c_rows, DFF, 1024}; pg8::StaticOrder S; S.init(c_rows, DFF, GRIDN, (int)blockIdx.x);
              EpiConv E{GB, HH, AIN(29) + (size_t)l * 3 * DFF, AIN(30) + (size_t)l * DFF, c_row0, SSQ + (size_t)c_row0 * 16};
              for (int rep = 0; rep < REP_GEMM; ++rep) GEMM_CALL(EpiConv, 1024, g, S, E); }
            SYNC();
            { const int c_row0 = chunk ? TP : 0, c_rows = chunk ? (T - TP) : TP;
              pg8::Gemm g{HH, WL_(l) + W_DN, c_rows, 1024, DFF}; EpiRes E{X + (size_t)c_row0 * 1024, ACT1 + (size_t)c_row0 * 1024, SSQ + (size_t)c_row0 * 16, X + (size_t)c_row0 * 1024, X, 0x7fffffff}; pg8::StaticOrder S; S.init(c_rows, 1024, GRIDN, (int)blockIdx.x); GEMM_CALL(EpiRes, 2816, g, S, E); }
            SYNC();
        }
        if (l == 1) { WCTX; for (int r = gw; r < T; r += 2 * NGW) { const int r1 = r + NGW < T ? r + NGW : r; if (r1 != r) final_norm_rows2(X + (size_t)r * 1024, X + (size_t)r1 * 1024, AIN(32), lane); else final_norm_rows2(X + (size_t)r * 1024, X + (size_t)r * 1024, AIN(32), lane); } }
    }
}

extern "C" void kernel_launch(void* const* d_in, const int* in_sizes, int n_in, void* d_out, int out_size, void* d_ws, size_t ws_size, hipStream_t stream) {
    static int grid = 0;
    if (grid == 0) {
        if (n_in != 33 || out_size != T * DM || ws_size < WS_END) { fprintf(stderr, "kernel_launch: unexpected shapes (n_in %d out %d ws %zu, need %zu)\n", n_in, out_size, ws_size, (size_t)WS_END); grid = -1; return; }
        int dev = 0, cus = 0, per_cu = 0;
        hipGetDevice(&dev); hipDeviceGetAttribute(&cus, hipDeviceAttributeMultiprocessorCount, dev);
        if (hipFuncSetAttribute((const void*)fwd_mega, hipFuncAttributeMaxDynamicSharedMemorySize, LDS_BYTES) != hipSuccess) { fprintf(stderr, "kernel_launch: hipFuncSetAttribute failed\n"); grid = -1; return; }
        hipOccupancyMaxActiveBlocksPerMultiprocessor(&per_cu, (const void*)fwd_mega, NWAVES * 64, LDS_BYTES);
        (void)hipGetLastError();
        if (per_cu < 1) per_cu = 1;
        grid = cus * 1;
        fprintf(stderr, "kernel_launch: cus %d per_cu %d grid %d\n", cus, per_cu, grid);
    }
    if (grid < 0) return;
    if (hipMemsetAsync(d_ws, 0, 65536, stream) != hipSuccess) { fprintf(stderr, "kernel_launch: memset failed\n"); return; }
    Args a{};
    for (int i = 0; i < 33; ++i) a.in[i] = (const float*)d_in[i];
    a.out = (float*)d_out; a.ws = (unsigned char*)d_ws; a.grid = grid; a.pad = 0;
    void* args[] = {&a};
    hipError_t e = hipLaunchCooperativeKernel((const void*)fwd_mega, dim3(grid), dim3(NWAVES * 64), args, LDS_BYTES, stream);
    if (e != hipSuccess) fprintf(stderr, "kernel_launch: cooperative launch failed: %s (grid %d)\n", hipGetErrorString(e), grid);
}
```

```cpp
#include <hip/hip_runtime.h>
#include <hip/hip_cooperative_groups.h>
#include <hip/hip_bf16.h>
#include <cstdio>
#include <cstdint>
#include <cmath>
namespace cg = cooperative_groups;
namespace pg8 {
#define PG8_LAS __attribute__((address_space(3)))
typedef unsigned short bf16_t;
typedef short bf16x8 __attribute__((ext_vector_type(8)));
typedef float f32x4 __attribute__((ext_vector_type(4)));
typedef unsigned u32x4 __attribute__((ext_vector_type(4)));
constexpr int BM = 256, BK = 64, HALF = 128, HTB = HALF * BK * 2  , STAGE_BYTES = 8 * HTB, NXCD = 8, WGM = 8;

__host__ __device__ __forceinline__ int lds_byte(int r, int c) { const int st = (r >> 4) * 2 + (c >> 5), rr = r & 15, cc = c & 31, ob = rr * 64 + cc * 2; return st * 1024 + (ob ^ (((ob >> 9) & 1) << 5)); }
__host__ __device__ __forceinline__ void stage_rc(int b, int& R, int& C) { const int st = b / 1024, sb = b % 1024, swz = sb ^ (((sb >> 9) & 1) << 5); R = (st >> 1) * 16 + swz / 64; C = (st & 1) * 32 + (swz % 64) / 2; }
__host__ __device__ __forceinline__ int perm32(int rho) { const int n = rho >> 4, i = rho & 15; return 8 * (i >> 2) + 4 * n + (i & 3); }

struct Unit { int pm, pn; };
struct Gemm { const bf16_t* A; const bf16_t* Bt; int M, N, K; };

struct StaticOrder {
    int nM, nN, nwg, G, c;
    __host__ __device__ void init(int M, int N, int G_, int c_) { nM = M / BM; nN = N / BM; nwg = nM * nN; G = G_; c = c_; }
    __host__ __device__ bool next(int i, Unit& u) const {
        const long L = (long)i * G + c; if (L >= nwg) return false;
        int wgid = (int)L; { const int q = nwg / NXCD, r = nwg % NXCD, xcd = wgid % NXCD, off = wgid / NXCD; wgid = (xcd < r ? xcd * (q + 1) : r * (q + 1) + (xcd - r) * q) + off; }
        const int nig = WGM * nN, gid = wgid / nig, fm = gid * WGM, gsz = (nM - fm) < WGM ? (nM - fm) : WGM;
        u.pm = fm + ((wgid % nig) % gsz); u.pn = (wgid % nig) / gsz; return true;
    }
    __device__ __forceinline__ void a_ready(const Unit&) const {}
    __device__ __forceinline__ void done(const Unit&) const {}
};

__device__ __forceinline__ unsigned cvt_pk_bf16(float lo, float hi) { typedef float f2_t __attribute__((ext_vector_type(2))); typedef __bf16 b2_t __attribute__((ext_vector_type(2))); f2_t v = {lo, hi}; b2_t b = __builtin_convertvector(v, b2_t); return __builtin_bit_cast(unsigned, b); }
template <class Epi, class Sched, bool ALIGN_EPI, bool SP2, int KC, int LDA = KC>
__device__ __forceinline__ void gemm_phase(PG8_LAS unsigned char* lds, const Gemm g, const Sched& S, const Epi& E) {
    int tid_ = threadIdx.x; asm volatile("" : "+v"(tid_)); const int tid = tid_, wid = __builtin_amdgcn_readfirstlane(tid >> 6), lane = tid & 63, wr = wid >> 2, wc = wid & 3, fr = lane & 15, fq = lane >> 4;
    constexpr int K = KC, nt = K / BK;
    unsigned voffA[2], voffB[2];
#pragma unroll
    for (int i = 0; i < 2; ++i) { int R, C; stage_rc(tid * 16 + i * 8192, R, C); const int Rb = Epi::PERM ? ((R & ~31) + perm32(R & 31)) : R;
        voffA[i] = (unsigned)(R * LDA + C) * 2u; voffB[i] = (unsigned)(Rb * K + C) * 2u; }
    const size_t kstep = (size_t)(BK * 2);
    const size_t hstep = (size_t)HALF * K * 2;
    const size_t tstep = 2 * hstep; const size_t hstepA = (size_t)HALF * LDA * 2, tstepA = 2 * hstepA;
    const unsigned ldsw = (unsigned)wid * 1024u;
    const int aoff = lds_byte(wr * 64 + fr, fq * 8), boff = lds_byte(wc * 32 + fr, fq * 8);
#define PG8_SA(b, h) (((b) * 2 + (h)) * HTB)
#define PG8_SB(b, h) ((4 + (b) * 2 + (h)) * HTB)
#define PG8_STAGE(bufoff, gbase, voff) do { _Pragma("unroll") for (int _i = 0; _i < 2; ++_i) \
        __builtin_amdgcn_global_load_lds((const unsigned*)((const char*)(gbase) + (voff)[_i]), (PG8_LAS unsigned*)(lds + (bufoff) + ldsw + _i * 8192), 16, 0, 0); } while (0)
#define PG8_LDA(dst, b, h) do { _Pragma("unroll") for (int m = 0; m < 4; ++m) _Pragma("unroll") for (int k = 0; k < 2; ++k) dst[m][k] = *(const PG8_LAS bf16x8*)(lds + PG8_SA(b, h) + aoff + m * 2048 + k * 1024); } while (0)
#define PG8_LDB(dst, b, h) do { _Pragma("unroll") for (int n = 0; n < 2; ++n) _Pragma("unroll") for (int k = 0; k < 2; ++k) dst[n][k] = *(const PG8_LAS bf16x8*)(lds + PG8_SB(b, h) + boff + n * 2048 + k * 1024); } while (0)
#define PG8_MMA(ai, bj, At, Bt) do { __builtin_amdgcn_s_setprio(1); _Pragma("unroll") for (int m = 0; m < 4; ++m) _Pragma("unroll") for (int n = 0; n < 2; ++n) _Pragma("unroll") for (int k = 0; k < 2; ++k) \
        acc[ai][bj][m][n] = __builtin_amdgcn_mfma_f32_16x16x32_bf16(Bt[n][k], At[m][k], acc[ai][bj][m][n], 0, 0, 0); __builtin_amdgcn_s_setprio(0); } while (0)
#define PG8_WAIT_V(n) asm volatile("s_waitcnt vmcnt(" #n ")" ::: "memory")
#define PG8_WAIT_L(n) asm volatile("s_waitcnt lgkmcnt(" #n ")" ::: "memory")
#define PG8_BAR __builtin_amdgcn_s_barrier()
#define PG8_SCHED __builtin_amdgcn_sched_barrier(0)
    Unit cur, nxt; int ui = 0;
    if (!S.next(0, cur)) return;
    f32x4 acc[2][2][4][2];
#pragma unroll
    for (int a = 0; a < 2; ++a)
#pragma unroll
        for (int b = 0; b < 2; ++b)
#pragma unroll
            for (int m = 0; m < 4; ++m)
#pragma unroll
                for (int n = 0; n < 2; ++n) acc[a][b][m][n] = (f32x4){0.f, 0.f, 0.f, 0.f};
    bf16x8 At[4][2], B0[2][2], B1[2][2];
    const char* cA = (const char*)g.A + (size_t)cur.pm * tstepA; const char* cB = (const char*)g.Bt + (size_t)cur.pn * tstep;
    S.a_ready(cur);
    if constexpr (SP2) {
        PG8_STAGE(PG8_SB(0, 0), cB, voffB); PG8_STAGE(PG8_SB(0, 1), cB + hstep, voffB); PG8_STAGE(PG8_SA(0, 0), cA, voffA); PG8_STAGE(PG8_SA(0, 1), cA + hstepA, voffA);
        if (wr == 1) PG8_BAR;
        PG8_WAIT_V(2); PG8_BAR;
        PG8_STAGE(PG8_SB(1, 0), cB + kstep, voffB); PG8_STAGE(PG8_SA(1, 0), cA + kstep, voffA); PG8_STAGE(PG8_SB(1, 1), cB + hstep + kstep, voffB);
        PG8_WAIT_V(6); PG8_BAR;
    } else {
        PG8_STAGE(PG8_SB(0, 0), cB, voffB); PG8_STAGE(PG8_SA(0, 0), cA, voffA); PG8_STAGE(PG8_SB(0, 1), cB + hstep, voffB); PG8_STAGE(PG8_SA(0, 1), cA + hstepA, voffA);
        if (wr == 1) PG8_BAR;
        PG8_WAIT_V(4); PG8_BAR;
        PG8_STAGE(PG8_SB(1, 0), cB + kstep, voffB); PG8_STAGE(PG8_SA(1, 0), cA + kstep, voffA); PG8_STAGE(PG8_SB(1, 1), cB + hstep + kstep, voffB);
        PG8_WAIT_V(6); PG8_BAR;
    }
    for (;;) {
        const bool has_next = S.next(ui + 1, nxt);
        const char* nA = has_next ? (const char*)g.A + (size_t)nxt.pm * tstepA : cA; const char* nB = has_next ? (const char*)g.Bt + (size_t)nxt.pn * tstep : cB;
#pragma nounroll
        for (int t = 0; t < nt; t += 2) {
            const bool last = (t == nt - 2);
            const char* a1 = cA + (size_t)(t + 1) * kstep;
            const char* a2 = last ? nA : cA + (size_t)(t + 2) * kstep; const char* b2 = last ? nB : cB + (size_t)(t + 2) * kstep;
            const char* a3 = a2 + kstep; const char* b3 = b2 + kstep;
            if (last && has_next) S.a_ready(nxt);
            if constexpr (SP2) {
            PG8_LDB(B0, 0, 0); PG8_LDB(B1, 0, 1); PG8_SCHED; PG8_LDA(At, 0, 0); PG8_STAGE(PG8_SA(1, 1), a1 + hstepA, voffA);
            PG8_WAIT_V(8); PG8_WAIT_L(0); PG8_BAR; PG8_MMA(0, 0, At, B0); PG8_MMA(0, 1, At, B1); PG8_BAR; PG8_SCHED;
            PG8_LDA(At, 0, 1); PG8_STAGE(PG8_SB(0, 0), b2, voffB); PG8_STAGE(PG8_SB(0, 1), b2 + hstep, voffB); PG8_STAGE(PG8_SA(0, 0), a2, voffA);
            PG8_WAIT_V(8); PG8_WAIT_L(0); PG8_BAR; PG8_MMA(1, 0, At, B0); PG8_MMA(1, 1, At, B1); PG8_BAR; PG8_SCHED;
            PG8_LDB(B0, 1, 0); PG8_LDB(B1, 1, 1); PG8_SCHED; PG8_LDA(At, 1, 0); PG8_STAGE(PG8_SA(0, 1), a2 + hstepA, voffA);
            PG8_WAIT_V(8); PG8_WAIT_L(0); PG8_BAR; PG8_MMA(0, 0, At, B0); PG8_MMA(0, 1, At, B1); PG8_BAR; PG8_SCHED;
            PG8_LDA(At, 1, 1); PG8_STAGE(PG8_SB(1, 0), b3, voffB); PG8_STAGE(PG8_SB(1, 1), b3 + hstep, voffB); PG8_STAGE(PG8_SA(1, 0), a3, voffA);
            PG8_WAIT_V(8); PG8_WAIT_L(0); PG8_BAR; PG8_MMA(1, 0, At, B0); PG8_MMA(1, 1, At, B1); PG8_BAR; PG8_SCHED;
            } else {
            PG8_LDB(B0, 0, 0); PG8_SCHED; PG8_LDA(At, 0, 0); PG8_STAGE(PG8_SA(1, 1), a1 + hstepA, voffA);
            PG8_WAIT_L(8); PG8_BAR; PG8_WAIT_L(0); PG8_MMA(0, 0, At, B0); PG8_BAR; PG8_SCHED;
            PG8_LDB(B1, 0, 1); PG8_STAGE(PG8_SB(0, 0), b2, voffB);
            PG8_BAR; PG8_WAIT_L(0); PG8_MMA(0, 1, At, B1); PG8_BAR;
            PG8_LDA(At, 0, 1); PG8_STAGE(PG8_SA(0, 0), a2, voffA);
            PG8_BAR; PG8_WAIT_L(0); PG8_MMA(1, 0, At, B0); PG8_BAR; PG8_SCHED;
            PG8_STAGE(PG8_SB(0, 1), b2 + hstep, voffB);
            PG8_WAIT_V(6); PG8_BAR; PG8_MMA(1, 1, At, B1); PG8_BAR;
            PG8_LDB(B0, 1, 0); PG8_SCHED; PG8_LDA(At, 1, 0); PG8_STAGE(PG8_SA(0, 1), a2 + hstepA, voffA);
            PG8_WAIT_L(8); PG8_BAR; PG8_WAIT_L(0); PG8_MMA(0, 0, At, B0); PG8_BAR; PG8_SCHED;
            PG8_LDB(B1, 1, 1); PG8_STAGE(PG8_SB(1, 0), b3, voffB);
            PG8_BAR; PG8_WAIT_L(0); PG8_MMA(0, 1, At, B1); PG8_BAR;
            PG8_LDA(At, 1, 1); PG8_STAGE(PG8_SA(1, 0), a3, voffA);
            PG8_BAR; PG8_WAIT_L(0); PG8_MMA(1, 0, At, B0); PG8_BAR; PG8_SCHED;
            PG8_STAGE(PG8_SB(1, 1), b3 + hstep, voffB);
            PG8_WAIT_V(6); PG8_BAR; PG8_MMA(1, 1, At, B1); PG8_BAR;
            }
        }
        if constexpr (ALIGN_EPI) { if (wr == 0) PG8_BAR; }
        if constexpr (!Epi::AFTER_DRAIN) { E(acc, cur, wr, wc, fr, fq); S.done(cur); }
        if (!has_next) break;
#pragma unroll
        for (int a = 0; a < 2; ++a)
#pragma unroll
            for (int b = 0; b < 2; ++b)
#pragma unroll
                for (int m = 0; m < 4; ++m)
#pragma unroll
                    for (int n = 0; n < 2; ++n) acc[a][b][m][n] = (f32x4){0.f, 0.f, 0.f, 0.f};
        cur = nxt; cA = nA; cB = nB; ++ui;
        if constexpr (ALIGN_EPI) { if (wr == 1) PG8_BAR; }
    }
    PG8_WAIT_V(0);
    if constexpr (!ALIGN_EPI) { if (wr == 0) PG8_BAR; }
    PG8_BAR;
    if constexpr (Epi::AFTER_DRAIN) { E.fused(acc, cur, wr, wc, fr, fq, lds, wid, lane); S.done(cur); }
#undef PG8_SA
#undef PG8_SB
#undef PG8_STAGE
#undef PG8_LDA
#undef PG8_LDB
#undef PG8_MMA
#undef PG8_WAIT_V
#undef PG8_WAIT_L
#undef PG8_BAR
#undef PG8_SCHED
}
}
namespace attn_body {
using bf16=__hip_bfloat16;
using bf16x8=__attribute__((ext_vector_type(8)))short;
using s16x4=__attribute__((ext_vector_type(4)))short;
using f32x16=__attribute__((ext_vector_type(16)))float;
using u32x4=__attribute__((ext_vector_type(4)))unsigned;
constexpr int D=64;
constexpr int NW=8,QBLK=32,QB=QBLK*NW,KVBLK=64;
constexpr int KVP=2816,QP=2816,OP=2816;
__device__ __forceinline__ int crow(int r,int hi){return (r&3)+8*(r>>2)+4*hi;}
#define SBAR() __builtin_amdgcn_sched_barrier(0)
constexpr int NSLOT=3, SLOTB=8192;
constexpr int LDS_K=0, LDS_V=NSLOT*SLOTB, LDS_WS=2*NSLOT*SLOTB, LDS_OST=LDS_WS+NW*64*4, LDS_BYTES=LDS_OST+NW*4096;
constexpr float C2=0.125f*1.4426950408889634f;
__device__ __forceinline__ void glds16(const void*gsrc,unsigned lds_dst){unsigned keep;
  asm volatile("s_mov_b32 %0, m0\n\ts_mov_b32 m0, %2\n\ts_nop 0\n\tglobal_load_lds_dwordx4 %1, off\n\ts_mov_b32 m0, %0":"=&s"(keep):"v"(gsrc),"s"(lds_dst):"memory");}
__device__ __forceinline__ float max3f(float a,float b,float c){float r;asm("v_max3_f32 %0, %1, %2, %3":"=v"(r):"v"(a),"v"(b),"v"(c));return r;}
__device__ __forceinline__ float max2f(float a,float b){float r;asm("v_max_f32_e32 %0, %1, %2":"=v"(r):"v"(a),"v"(b));return r;}
__device__ __forceinline__ float fadd_s(float a,float b){float r;asm("v_add_f32_e32 %0, %1, %2":"=v"(r):"v"(a),"v"(b));return r;}
__device__ __forceinline__ float fsub_s(float a,float b){float r;asm("v_sub_f32_e32 %0, %1, %2":"=v"(r):"v"(a),"v"(b));return r;}
typedef float f32x2_t __attribute__((ext_vector_type(2))); typedef __bf16 bf16x2_t __attribute__((ext_vector_type(2)));
__device__ __forceinline__ unsigned cvtpk_s(float lo,float hi){f32x2_t v={lo,hi};bf16x2_t b=__builtin_convertvector(v,bf16x2_t);return __builtin_bit_cast(unsigned,b);}
#define WAIT_BAR(N) asm volatile("s_waitcnt vmcnt(" #N ") lgkmcnt(0)\n\ts_barrier":::"memory")

__device__ __forceinline__ void qkt(f32x16&p0,f32x16&p1,const char*Kslot,const bf16x8*qr,const f32x16&negm,int r32,int hi){
  const char*kb=Kslot+hi*1024+r32*16;
  #pragma unroll
  for(int d0=0;d0<4;++d0){
    const bf16x8 b0=*reinterpret_cast<const bf16x8*>(kb+d0*2048);
    const bf16x8 b1=*reinterpret_cast<const bf16x8*>(kb+d0*2048+512);
    if(d0==0){p0=__builtin_amdgcn_mfma_f32_32x32x16_bf16(b0,qr[0],negm,0,0,0);p1=__builtin_amdgcn_mfma_f32_32x32x16_bf16(b1,qr[0],negm,0,0,0);}
    else{p0=__builtin_amdgcn_mfma_f32_32x32x16_bf16(b0,qr[d0],p0,0,0,0);p1=__builtin_amdgcn_mfma_f32_32x32x16_bf16(b1,qr[d0],p1,0,0,0);}}
}
typedef __attribute__((address_space(3))) const char* lds_cptr;
typedef short v4i16_t __attribute__((ext_vector_type(4)));
__device__ __forceinline__ void kload8(bf16x8*kf,lds_cptr kp){
  kf[0]=*(const __attribute__((address_space(3))) bf16x8*)(kp);      kf[1]=*(const __attribute__((address_space(3))) bf16x8*)(kp+512);
  kf[2]=*(const __attribute__((address_space(3))) bf16x8*)(kp+2048); kf[3]=*(const __attribute__((address_space(3))) bf16x8*)(kp+2560);
  kf[4]=*(const __attribute__((address_space(3))) bf16x8*)(kp+4096); kf[5]=*(const __attribute__((address_space(3))) bf16x8*)(kp+4608);
  kf[6]=*(const __attribute__((address_space(3))) bf16x8*)(kp+6144); kf[7]=*(const __attribute__((address_space(3))) bf16x8*)(kp+6656);
}
__device__ __forceinline__ void kload2(bf16x8*kf,lds_cptr kp,int j){ kf[2*j]=*(const __attribute__((address_space(3))) bf16x8*)(kp+j*2048); kf[2*j+1]=*(const __attribute__((address_space(3))) bf16x8*)(kp+j*2048+512); }
__device__ __forceinline__ s16x4 vtr(lds_cptr p){ return __builtin_bit_cast(s16x4,__builtin_amdgcn_ds_read_tr16_b64_v4i16((__attribute__((address_space(3))) v4i16_t*)p)); }
__device__ __forceinline__ float rowmax(const f32x16&p0,const f32x16&p1){
  float a=max3f(p0[0],p0[1],p1[0]),b=max3f(p0[2],p0[3],p1[1]);a=max3f(a,p1[2],p1[3]);
  #pragma unroll
  for(int r=4;r<16;r+=4){a=max3f(a,p0[r],p0[r+1]);b=max3f(b,p0[r+2],p0[r+3]);a=max3f(a,p1[r],p1[r+1]);b=max3f(b,p1[r+2],p1[r+3]);}
  const float m=max2f(a,b);
  auto rr=__builtin_amdgcn_permlane32_swap(__float_as_uint(m),__float_as_uint(m),false,false);
  return max2f(__uint_as_float(rr[0]),__uint_as_float(rr[1]));
}
__device__ __forceinline__ void pv(f32x16*o,int vb,bf16x8 pa0,bf16x8 pa1,bf16x8 pa2,bf16x8 pa3){
  #pragma unroll
  for(int d0=0;d0<2;++d0){s16x4 lo[4],hi[4];
    #pragma unroll
    for(int ks=0;ks<4;++ks){
      asm volatile("ds_read_b64_tr_b16 %0,%1 offset:%c2":"=&v"(lo[ks]):"v"(vb),"i"(d0*4096+ks*1024):"memory");
      asm volatile("ds_read_b64_tr_b16 %0,%1 offset:%c2":"=&v"(hi[ks]):"v"(vb),"i"(d0*4096+ks*1024+512):"memory");}
    asm volatile("s_waitcnt lgkmcnt(0)":::"memory");SBAR();
    #define PK(k) (bf16x8){lo[k][0],lo[k][1],lo[k][2],lo[k][3],hi[k][0],hi[k][1],hi[k][2],hi[k][3]}
    o[d0]=__builtin_amdgcn_mfma_f32_32x32x16_bf16(pa0,PK(0),o[d0],0,0,0);
    o[d0]=__builtin_amdgcn_mfma_f32_32x32x16_bf16(pa1,PK(1),o[d0],0,0,0);
    o[d0]=__builtin_amdgcn_mfma_f32_32x32x16_bf16(pa2,PK(2),o[d0],0,0,0);
    o[d0]=__builtin_amdgcn_mfma_f32_32x32x16_bf16(pa3,PK(3),o[d0],0,0,0);
    #undef PK
  }
}
#ifndef ATTN_STORE16
#define ATTN_STORE16(p,v) (*(u32x4*)(p)=(v))
#endif
template<int THRL, bool STORE = true> __device__ __forceinline__ void attn_unit(const int NT,const bf16*Qw,const bf16*__restrict__ Kh,const bf16*__restrict__ Vh,bf16*Ow,char*shm){
  int tid_=threadIdx.x; asm volatile("":"+v"(tid_)); const int tid=tid_,lane=tid&63,r32=lane&31,hi=lane>>5; const int wid=__builtin_amdgcn_readfirstlane(tid>>6);
  const unsigned lds0=(unsigned)(uintptr_t)shm;
  float*wsf=(float*)(shm+LDS_WS)+wid*64;
  const bf16*ksrc=Kh+(long)lane*KVP+wid*8;
  const bf16*vsrc=Vh+(long)(16*(wid&3)+(lane>>2))*KVP+(wid>>2)*32+(lane&3)*8;
  const unsigned kdst=lds0+LDS_K+wid*1024, vdst=lds0+LDS_V+wid*1024;
  #define DMA_K(t,slot) glds16(ksrc+(long)(t)*KVBLK*KVP,(unsigned)__builtin_amdgcn_readfirstlane(kdst+(slot)))
  #define DMA_V(t,slot) glds16(vsrc+(long)(t)*KVBLK*KVP,(unsigned)__builtin_amdgcn_readfirstlane(vdst+(slot)))
  const int vb0=(int)(lds0+LDS_V)+((lane>>4)&1)*32+(lane&3)*8+(4*hi+((lane&15)>>2))*64;
  const char*Kbase=shm+LDS_K; bf16x8 kf[8];
  const lds_cptr shm3=(lds_cptr)shm; const lds_cptr kp0=shm3+LDS_K+hi*1024+r32*16; const lds_cptr vp0=shm3+LDS_V+((lane>>4)&1)*32+(lane&3)*8+(4*hi+((lane&15)>>2))*64;

  DMA_K(0,0);DMA_V(0,0);DMA_K(1,SLOTB);
  bf16x8 qr[4];
  #pragma unroll
  for(int d0=0;d0<4;++d0)qr[d0]=*reinterpret_cast<const bf16x8*>(&Qw[(long)r32*QP+d0*16+hi*8]);
  float mhat=0.f,l_reg=0.f;f32x16 o[2];o[0]=f32x16{};o[1]=f32x16{};f32x16 negm=f32x16{};asm volatile("":"+v"(negm));
  const int qrel=wid*QBLK+r32;
  #define CMASK(P0,P1,t) do{}while(0)
  bool resc=false;
  #define START(P0,P1) do{ const float rm=rowmax(P0,P1); resc=false; \
    { const float dl=rm; mhat=fadd_s(mhat,dl); \
      _Pragma("unroll") for(int r=0;r<16;++r){P0[r]=fsub_s(P0[r],dl);P1[r]=fsub_s(P1[r],dl);} \
      _Pragma("unroll") for(int r=0;r<16;++r)negm[r]=-mhat; asm volatile("":"+v"(negm)); } \
    _Pragma("unroll") for(int r=0;r<16;++r)P0[r]=__builtin_amdgcn_exp2f(P0[r]); }while(0)
  #define RESC() do{ if(resc){ asm volatile("s_waitcnt lgkmcnt(0)":::"memory"); \
      _Pragma("unroll") for(int d_=0;d_<2;++d_) _Pragma("unroll") for(int r=0;r<16;++r)o[d_][r]*=wsf[crow(r,hi)]; } }while(0)
  f32x16 pA0,pA1,pB0,pB1;
  int sl_prev=0,sl_cur=0,sl_next=SLOTB;
  #define ROT() do{sl_prev=sl_cur;sl_cur=sl_next;sl_next=(sl_next==(NSLOT-1)*SLOTB)?0:sl_next+SLOTB;}while(0)
  DMA_K(2,2*SLOTB);
  WAIT_BAR(3);
  qkt(pA0,pA1,Kbase,qr,negm,r32,hi);asm volatile("s_nop 15\n\ts_nop 7":"+v"(pA0),"+v"(pA1));CMASK(pA0,pA1,0);
  START(pA0,pA1);
  _Pragma("unroll") for(int r=0;r<16;++r)pA1[r]=__builtin_amdgcn_exp2f(pA1[r]);
  WAIT_BAR(0);
  DMA_K(3,0);DMA_V(1,SLOTB);
  ROT();
  kload8(kf,kp0+sl_cur);
  WAIT_BAR(2);
  s16x4 vlo[8],vhi[8]; u32x4 pw0,pw1,pw2,pw3;
  #define PKW(P,B) cvtpk_s(P[B],P[B+1])
  #define PAF(k) __builtin_bit_cast(bf16x8,pw##k)
  #define VFR(i) (bf16x8){vlo[i][0],vlo[i][1],vlo[i][2],vlo[i][3],vhi[i][0],vhi[i][1],vhi[i][2],vhi[i][3]}
  #define PIN(x) asm volatile("":"+v"(x))
  #define MX3(a,b,c) __builtin_fmaxf(__builtin_fmaxf((a),(b)),(c))
  #define GAPA(MF,A0,A1,A2,A3,W0,W1,PW) do{ MF; sacc+=A0; sacc+=A1; sacc+=A2; sacc+=A3; PIN(sacc); W0; W1; PIN(PW); SBAR(); }while(0)
  #define EX(v) __builtin_amdgcn_exp2f(v)
  #define GAPB(MF,X,B) do{ MF; X[B]=EX(X[B]); X[B+1]=EX(X[B+1]); X[B+2]=EX(X[B+2]); X[B+3]=EX(X[B+3]); PIN(X); SBAR(); }while(0)
  #define VRD(i) do{ vlo[i]=vtr(vp_+(((i)>>2)*4096+((i)&3)*1024)); vhi[i]=vtr(vp_+(((i)>>2)*4096+((i)&3)*1024+512)); }while(0)
  #define KRD(G,j) do{ if(G){ kload2(kf,kp0+sl_next,j); SBAR(); } }while(0)
  #define STEP(C0,C1,P0,P1,t,GK,GV,GL) do{ SBAR(); \
    const lds_cptr vp_=vp0+sl_prev; \
    VRD(0); SBAR(); float sacc=(P0[0]+P0[1]); \
    GAPA(C0=__builtin_amdgcn_mfma_f32_32x32x16_bf16(kf[0],qr[0],negm,0,0,0), P0[2],P0[3],P0[4],P0[5],     pw0[0]=PKW(P0,0), pw0[1]=PKW(P0,2), pw0); \
    VRD(4); SBAR(); GAPA(C1=__builtin_amdgcn_mfma_f32_32x32x16_bf16(kf[1],qr[0],negm,0,0,0), P0[6],P0[7],P0[8],P0[9],     pw0[2]=PKW(P0,4), pw0[3]=PKW(P0,6), pw0); \
    VRD(1); SBAR(); GAPA(C0=__builtin_amdgcn_mfma_f32_32x32x16_bf16(kf[2],qr[1],C0,0,0,0),   P0[10],P0[11],P0[12],P0[13], pw1[0]=PKW(P0,8), pw1[1]=PKW(P0,10), pw1); \
    VRD(5); SBAR(); GAPA(C1=__builtin_amdgcn_mfma_f32_32x32x16_bf16(kf[3],qr[1],C1,0,0,0),   P0[14],P0[15],P1[0],P1[1],   pw1[2]=PKW(P0,12),pw1[3]=PKW(P0,14), pw1); \
    VRD(2); SBAR(); GAPA(C0=__builtin_amdgcn_mfma_f32_32x32x16_bf16(kf[4],qr[2],C0,0,0,0),   P1[2],P1[3],P1[4],P1[5],     pw2[0]=PKW(P1,0), pw2[1]=PKW(P1,2), pw2); \
    VRD(6); SBAR(); GAPA(C1=__builtin_amdgcn_mfma_f32_32x32x16_bf16(kf[5],qr[2],C1,0,0,0),   P1[6],P1[7],P1[8],P1[9],     pw2[2]=PKW(P1,4), pw2[3]=PKW(P1,6), pw2); \
    VRD(3); SBAR(); GAPA(C0=__builtin_amdgcn_mfma_f32_32x32x16_bf16(kf[6],qr[3],C0,0,0,0),   P1[10],P1[11],P1[12],P1[13], pw3[0]=PKW(P1,8), pw3[1]=PKW(P1,10), pw3); \
    VRD(7); SBAR(); GAPA(C1=__builtin_amdgcn_mfma_f32_32x32x16_bf16(kf[7],qr[3],C1,0,0,0),   P1[14],P1[15],0.f,0.f,       pw3[2]=PKW(P1,12),pw3[3]=PKW(P1,14), pw3); \
    l_reg+=sacc; \
    if(GK){DMA_K((t)+3,sl_cur);} if(GV){DMA_V((t)+1,sl_next);} \
    CMASK(C0,C1,t); \
    { float a=MX3(C0[0],C0[1],C1[0]),b=MX3(C0[2],C0[3],C1[1]); a=MX3(a,C1[2],C1[3]); \
      _Pragma("unroll") for(int r=4;r<16;r+=4){a=MX3(a,C0[r],C0[r+1]);b=MX3(b,C0[r+2],C0[r+3]);a=MX3(a,C1[r],C1[r+1]);b=MX3(b,C1[r+2],C1[r+3]);} \
      float rm=__builtin_fmaxf(a,b); { auto rr=__builtin_amdgcn_permlane32_swap(__float_as_uint(rm),__float_as_uint(rm),false,false); rm=__builtin_fmaxf(__uint_as_float(rr[0]),__uint_as_float(rr[1])); } \
      resc=false; \
      if(__builtin_expect(__any(rm>(float)THRL),0)){ const float dl=__builtin_fmaxf(rm,0.f); mhat+=dl; \
        _Pragma("unroll") for(int r=0;r<16;++r){C0[r]-=dl;C1[r]-=dl;} \
        _Pragma("unroll") for(int r=0;r<16;++r)negm[r]=-mhat; asm volatile("":"+v"(negm)); \
        const float f=__builtin_amdgcn_exp2f(-dl); l_reg*=f; if(hi==0)wsf[r32]=f; resc=true; } } \
    SBAR(); \
    GAPB(o[0]=__builtin_amdgcn_mfma_f32_32x32x16_bf16(PAF(0),VFR(0),o[0],0,0,0), C0,0); \
    GAPB(o[1]=__builtin_amdgcn_mfma_f32_32x32x16_bf16(PAF(0),VFR(4),o[1],0,0,0), C0,4); \
    KRD(GL,0); GAPB(o[0]=__builtin_amdgcn_mfma_f32_32x32x16_bf16(PAF(1),VFR(1),o[0],0,0,0), C0,8); \
    KRD(GL,1); GAPB(o[1]=__builtin_amdgcn_mfma_f32_32x32x16_bf16(PAF(1),VFR(5),o[1],0,0,0), C0,12); \
    KRD(GL,2); GAPB(o[0]=__builtin_amdgcn_mfma_f32_32x32x16_bf16(PAF(2),VFR(2),o[0],0,0,0), C1,0); \
    KRD(GL,3); GAPB(o[1]=__builtin_amdgcn_mfma_f32_32x32x16_bf16(PAF(2),VFR(6),o[1],0,0,0), C1,4); \
    GAPB(o[0]=__builtin_amdgcn_mfma_f32_32x32x16_bf16(PAF(3),VFR(3),o[0],0,0,0), C1,8); \
    GAPB(o[1]=__builtin_amdgcn_mfma_f32_32x32x16_bf16(PAF(3),VFR(7),o[1],0,0,0), C1,12); \
    }while(0)
  int t=1;
  #undef CMASK
  #define CMASK(P0,P1,t) do{}while(0)
  for(;t+5<NT;t+=2){
    STEP(pB0,pB1,pA0,pA1,t,true,true,true);     WAIT_BAR(2); RESC(); ROT();
    STEP(pA0,pA1,pB0,pB1,t+1,true,true,true);   WAIT_BAR(2); RESC(); ROT();
  }
  #undef CMASK
  #define CMASK(P0,P1,t) do{}while(0)
  #define ENDW(tt) do{ if((tt)+3<NT){WAIT_BAR(2);} else if((tt)+2<NT){WAIT_BAR(1);} else {WAIT_BAR(0);} }while(0)
  for(;t+1<NT;t+=2){
    STEP(pB0,pB1,pA0,pA1,t,(t+3<NT),(t+1<NT),(t+1<NT));       ENDW(t);   RESC(); ROT();
    STEP(pA0,pA1,pB0,pB1,t+1,(t+4<NT),(t+2<NT),(t+2<NT));     ENDW(t+1); RESC(); ROT();
  }
  STEP(pB0,pB1,pA0,pA1,NT-1,false,false,false); RESC();
  { float sacc=pB0[0]+pB0[1]; _Pragma("unroll") for(int r=2;r<16;++r)sacc+=pB0[r]; _Pragma("unroll") for(int r=0;r<16;++r)sacc+=pB1[r]; l_reg+=sacc;
    pw0=(u32x4){PKW(pB0,0),PKW(pB0,2),PKW(pB0,4),PKW(pB0,6)};pw1=(u32x4){PKW(pB0,8),PKW(pB0,10),PKW(pB0,12),PKW(pB0,14)};pw2=(u32x4){PKW(pB1,0),PKW(pB1,2),PKW(pB1,4),PKW(pB1,6)};pw3=(u32x4){PKW(pB1,8),PKW(pB1,10),PKW(pB1,12),PKW(pB1,14)};
    SBAR(); pv(o,vb0+sl_cur,PAF(0),PAF(1),PAF(2),PAF(3)); }
  #undef PKW
  #undef PAF
  #undef VFR
  #undef PIN
  #undef MX3
  #undef GAPA
  #undef GAPB
  #undef EX
  #undef VRD
  #undef KRD
  #undef STEP
  #undef ENDW
  {auto rr=__builtin_amdgcn_permlane32_swap(__float_as_uint(l_reg),__float_as_uint(l_reg),false,false);l_reg=__uint_as_float(rr[0])+__uint_as_float(rr[1]);}
  if(hi==0)wsf[32+r32]=l_reg;asm volatile("s_waitcnt lgkmcnt(0)":::"memory");
  float rli[16];
  #pragma unroll
  for(int r=0;r<16;++r)rli[r]=__builtin_amdgcn_rcpf(wsf[32+crow(r,hi)]);

  { bf16*stg=(bf16*)(shm+LDS_OST)+wid*2048;
    #pragma unroll
    for(int r=0;r<16;++r){const int orow=crow(r,hi);
      #pragma unroll
      for(int d0=0;d0<2;++d0)stg[orow*64+d0*32+r32]=__float2bfloat16(o[d0][r]*rli[r]);}
    asm volatile("s_waitcnt lgkmcnt(0)":::"memory");
    #pragma unroll
    for(int i=0;i<4;++i){const int row=i*8+(lane>>3),ch=lane&7; const u32x4 v=*(const u32x4*)(stg+row*64+ch*8); if(STORE)ATTN_STORE16(Ow+(long)row*OP+ch*8,v);} }
  asm volatile("s_waitcnt lgkmcnt(0)\n\ts_barrier":::"memory");
  #undef DMA_K
  #undef DMA_V
  #undef CMASK
  #undef START
  #undef RESC
  #undef ROT
}
constexpr int ATTN_LDS_BYTES=LDS_BYTES;
#undef SBAR
#undef WAIT_BAR
}
#define DEVI __device__ __forceinline__
typedef unsigned short bf16_t;
typedef short bf16x8 __attribute__((ext_vector_type(8)));
typedef float f32x4 __attribute__((ext_vector_type(4)));
typedef unsigned u32x4 __attribute__((ext_vector_type(4)));
typedef unsigned u32x2 __attribute__((ext_vector_type(2)));
typedef short s16x4 __attribute__((ext_vector_type(4)));
#define LAS __attribute__((address_space(3)))

constexpr int T = 98304, TP = 65536, DM = 1024, INW = 2816, DFF = 2816, MEMROWS = 8704;
constexpr int NWAVES = 8;
constexpr float LOG2E = 1.4426950408889634f;
constexpr size_t MiB = 1u << 20;
constexpr size_t W_IN = 0, W_OUT = W_IN + (size_t)2816 * 1024, W_Q = W_OUT + (size_t)1024 * 1024, W_KV = W_Q + (size_t)256 * 1024, W_O = W_KV + (size_t)512 * 1024,
                 W_UP = W_O + (size_t)1024 * 256, W_DN = W_UP + (size_t)5632 * 1024, W_GLU = W_DN + (size_t)1024 * 2816, W_LAYER = W_GLU + (size_t)256 * 256;
constexpr size_t WS_W = 1 * MiB, WS_TAB = 54 * MiB, WS_XK = 55 * MiB, WS_XVT = 64 * MiB, WS_ACT1 = 75 * MiB, WS_BIG = 267 * MiB;
static_assert(WS_W + 2 * W_LAYER * 2 <= WS_TAB, "weights fit");
constexpr size_t TAB_S5A = 0, TAB_S5B = 64 * 1024, TAB_ROPE = 640 * 1024, TAB_LB = 704 * 1024;
constexpr size_t XK_LAYER = (size_t)MEMROWS * 256;
constexpr size_t WS_PROJ = WS_BIG, WS_VTA = WS_BIG + 528 * MiB, WS_HB = WS_VTA + 48 * MiB, WS_ODB = WS_HB + 48 * MiB, WS_S5F = WS_ODB + 48 * MiB,
                 WS_HF = WS_S5F + 12 * MiB, WS_HD = WS_HF + 24 * MiB, WS_SS = 977 * MiB, WS_END = WS_SS + 7 * MiB;
constexpr size_t WS_MN = WS_BIG;
constexpr size_t WS_XQ = WS_BIG, WS_XO = WS_BIG + 48 * MiB;
constexpr size_t WS_G = WS_BIG, WS_H = WS_BIG + 352 * MiB;
static_assert(WS_H + 352 * MiB <= WS_SS && WS_HD + 1 * MiB <= WS_SS && WS_END <= 1024 * MiB, "workspace map");
constexpr int LDS_BYTES = 147456;
constexpr int WLDS = 16384;

struct Args { const float* in[33]; float* out; unsigned char* ws; int grid, pad; };

DEVI float wsum(float v) {
#pragma unroll
    for (int o = 1; o < 64; o <<= 1) v += __shfl_xor(v, o);
    return v;
}
DEVI unsigned cvtpk(float lo, float hi) { return pg8::cvt_pk_bf16(lo, hi); }
DEVI float bflo(unsigned u) { return __uint_as_float(u << 16); }
DEVI float bfhi(unsigned u) { return __uint_as_float(u & 0xffff0000u); }
DEVI float bf1(bf16_t h) { return __uint_as_float((unsigned)h << 16); }
DEVI bf16_t tobf(float f) { return (bf16_t)(cvtpk(f, 0.f) & 0xffffu); }
DEVI void wave_sync() { asm volatile("s_waitcnt lgkmcnt(0)" ::: "memory"); __builtin_amdgcn_wave_barrier(); asm volatile("" ::: "memory"); }
DEVI float sigmoidf_(float x) { return __builtin_amdgcn_rcpf(1.0f + __expf(-x)); }
DEVI void seq_of(int tok, int& start, int& len) { if (tok < TP) { start = tok & ~2047; len = 2048; } else { start = TP + ((tok - TP) & ~16383); len = 16384; } }
DEVI int batch_of(int tok) { return tok < TP ? (tok >> 11) : 32 + ((tok - TP) >> 14); }

DEVI float row_rstd(const float* SS, size_t row) { const f32x4* p = (const f32x4*)(SS + row * 16); const f32x4 a0 = p[0], a1 = p[1], a2 = p[2], a3 = p[3];
    const float s = ((a0[0] + a0[1]) + (a0[2] + a0[3])) + ((a1[0] + a1[1]) + (a1[2] + a1[3])) + ((a2[0] + a2[1]) + (a2[2] + a2[3])) + ((a3[0] + a3[1]) + (a3[2] + a3[3]));
    return rsqrtf(s * (1.0f / 1024.0f) + 1e-6f); }
DEVI void rows_rstd8(const float* SS, int row0, int fq, float (&rs)[8]) {
    f32x4 p[8];
#pragma unroll
    for (int i = 0; i < 8; ++i) p[i] = *(const f32x4*)(SS + (size_t)(row0 + (i >> 2) * 128 + (i & 3) * 16) * 16 + 4 * fq);
    asm volatile("" ::: "memory");
#pragma unroll
    for (int i = 0; i < 8; ++i) { float s = (p[i][0] + p[i][1]) + (p[i][2] + p[i][3]); s += __shfl_xor(s, 16); s += __shfl_xor(s, 32); rs[i] = rsqrtf(s * (1.0f / 1024.0f) + 1e-6f); }
}
struct EpiStore {
    static constexpr bool PERM = true, AFTER_DRAIN = false;
    bf16_t* O; int ldc; int tpn; bf16_t* TB; int tcs, trb, tsh; const float* SS;
    DEVI void operator()(const pg8::f32x4 (&acc)[2][2][4][2], const pg8::Unit& u, int, int, int, int) const {
        int t_ = threadIdx.x; asm volatile("" : "+v"(t_)); const int fr = t_ & 15, fq = (t_ >> 4) & 3, wid_ = __builtin_amdgcn_readfirstlane(t_ >> 6), wr = wid_ >> 2, wc = wid_ & 3;
        const int row0 = u.pm * 256 + wr * 64 + fr, col0 = u.pn * 256 + wc * 32 + 8 * fq;
        float rsv[8];
        if (SS) rows_rstd8(SS, row0, fq, rsv); else {
#pragma unroll
            for (int i = 0; i < 8; ++i) rsv[i] = 1.f; }
        if (u.pn == tpn) {
#pragma unroll
            for (int ai = 0; ai < 2; ++ai)
#pragma unroll
                for (int m = 0; m < 4; ++m) { const int row = row0 + ai * 128 + m * 16; bf16_t* tp = TB + (size_t)(row >> tsh) * trb + (row & ((1 << tsh) - 1)); const float rs = rsv[ai * 4 + m];
#pragma unroll
                    for (int bj = 0; bj < 2; ++bj) { const int tc = wc * 32 + 8 * fq + bj * 128;
#pragma unroll
                        for (int n = 0; n < 2; ++n)
#pragma unroll
                            for (int e = 0; e < 4; ++e) tp[(size_t)(tc + 4 * n + e) * tcs] = tobf(acc[ai][bj][m][n][e] * rs); } }
        } else {
#pragma unroll
            for (int ai = 0; ai < 2; ++ai)
#pragma unroll
                for (int m = 0; m < 4; ++m) { bf16_t* rowp = O + (size_t)(row0 + ai * 128 + m * 16) * ldc + col0; const float rs = rsv[ai * 4 + m];
#pragma unroll
                    for (int bj = 0; bj < 2; ++bj) { const pg8::f32x4 v0 = acc[ai][bj][m][0] * rs, v1 = acc[ai][bj][m][1] * rs; u32x4 w;
                        w.x = cvtpk(v0[0], v0[1]); w.y = cvtpk(v0[2], v0[3]); w.z = cvtpk(v1[0], v1[1]); w.w = cvtpk(v1[2], v1[3]);
                        *(u32x4*)(rowp + bj * 128) = w; } }
        }
    }
};
struct EpiGlu {
    static constexpr bool PERM = true, AFTER_DRAIN = false;
    const bf16_t* HB; bf16_t* O; const float* bias;
    DEVI void operator()(const pg8::f32x4 (&acc)[2][2][4][2], const pg8::Unit& u, int, int, int, int) const {
        int t_ = threadIdx.x; asm volatile("" : "+v"(t_)); const int fr = t_ & 15, fq = (t_ >> 4) & 3, wid_ = __builtin_amdgcn_readfirstlane(t_ >> 6), wr = wid_ >> 2, wc = wid_ & 3;
        const int row0 = u.pm * 256 + wr * 64 + fr, col0 = wc * 32 + 8 * fq;
        f32x4 bb[2][2];
#pragma unroll
        for (int bj = 0; bj < 2; ++bj)
#pragma unroll
            for (int n = 0; n < 2; ++n) bb[bj][n] = *(const f32x4*)(bias + col0 + bj * 128 + 4 * n);
#pragma unroll
        for (int ai = 0; ai < 2; ++ai) {
            u32x4 hv[4][2];
#pragma unroll
            for (int m = 0; m < 4; ++m)
#pragma unroll
                for (int bj = 0; bj < 2; ++bj) hv[m][bj] = *(const u32x4*)(HB + (size_t)(row0 + ai * 128 + m * 16) * 256 + col0 + bj * 128);
            asm volatile("" ::: "memory");
#pragma unroll
            for (int m = 0; m < 4; ++m) { const size_t row = row0 + ai * 128 + m * 16;
#pragma unroll
                for (int bj = 0; bj < 2; ++bj) { const int col = col0 + bj * 128; u32x4 w;
#pragma unroll
                    for (int n = 0; n < 2; ++n) { const f32x4 b = bb[bj][n]; const pg8::f32x4 v = acc[ai][bj][m][n]; const unsigned h0 = hv[m][bj][2 * n], h1 = hv[m][bj][2 * n + 1];
                        const float s0 = __builtin_amdgcn_rcpf(1.f + __expf(-(v[0] + b[0]))), s1 = __builtin_amdgcn_rcpf(1.f + __expf(-(v[1] + b[1])));
                        const float s2 = __builtin_amdgcn_rcpf(1.f + __expf(-(v[2] + b[2]))), s3 = __builtin_amdgcn_rcpf(1.f + __expf(-(v[3] + b[3])));
                        w[2 * n] = cvtpk(bflo(h0) * s0, bfhi(h0) * s1); w[2 * n + 1] = cvtpk(bflo(h1) * s2, bfhi(h1) * s3); }
                    *(u32x4*)(O + row * INW + 768 + col) = w; } }
            asm volatile("" ::: "memory"); }
    }
};
struct EpiRes {
    static constexpr bool PERM = false, AFTER_DRAIN = false;
    float* X; bf16_t* XB; float* SS; const float* S0; const float* S1; int split;
    DEVI void operator()(const pg8::f32x4 (&acc)[2][2][4][2], const pg8::Unit& u, int, int, int, int) const {
        int t_ = threadIdx.x; asm volatile("" : "+v"(t_)); const int fr = t_ & 15, fq = (t_ >> 4) & 3, wid_ = __builtin_amdgcn_readfirstlane(t_ >> 6), wr = wid_ >> 2, wc = wid_ & 3;
        const int row0 = u.pm * 256 + wr * 64 + fr, col0 = u.pn * 256 + wc * 32 + 4 * fq;
#pragma unroll
        for (int ai = 0; ai < 2; ++ai)
#pragma unroll
            for (int mp = 0; mp < 2; ++mp) {
                f32x4 xin[2][2][2];
#pragma unroll
                for (int mm = 0; mm < 2; ++mm) { const size_t row = (size_t)(row0 + ai * 128 + (2 * mp + mm) * 16);
                    const float* srcp = ((int)row < split ? S0 + row * 1024 : S1 + (row - split) * 1024) + col0;
#pragma unroll
                    for (int bj = 0; bj < 2; ++bj)
#pragma unroll
                        for (int n = 0; n < 2; ++n) xin[mm][bj][n] = *(const f32x4*)(srcp + bj * 128 + n * 16); }
                asm volatile("" ::: "memory");
#pragma unroll
                for (int mm = 0; mm < 2; ++mm) { const int m = 2 * mp + mm; const size_t row = (size_t)(row0 + ai * 128 + m * 16); float* rowp = X + row * 1024 + col0; bf16_t* rowb = XB + row * 1024 + col0; float ssq = 0.f;
#pragma unroll
                    for (int bj = 0; bj < 2; ++bj)
#pragma unroll
                        for (int n = 0; n < 2; ++n) { f32x4 x = xin[mm][bj][n]; const pg8::f32x4 a = acc[ai][bj][m][n];
                            x[0] += a[0]; x[1] += a[1]; x[2] += a[2]; x[3] += a[3]; *(f32x4*)(rowp + bj * 128 + n * 16) = x; ssq += (x[0] * x[0] + x[1] * x[1]) + (x[2] * x[2] + x[3] * x[3]);
                            u32x2 w; w.x = cvtpk(x[0], x[1]); w.y = cvtpk(x[2], x[3]); *(u32x2*)(rowb + bj * 128 + n * 16) = w; }
                    ssq += __shfl_xor(ssq, 16); ssq += __shfl_xor(ssq, 32);
                    if (fq == 0) SS[row * 16 + u.pn * 4 + wc] = ssq; }
                asm volatile("" ::: "memory");
            }
    }
};
struct EpiConv {
    static constexpr bool PERM = true, AFTER_DRAIN = false;
    const bf16_t* G; bf16_t* H; const float* cw; const float* cb; int tok0; const float* SS;
    DEVI void operator()(const pg8::f32x4 (&acc)[2][2][4][2], const pg8::Unit& u, int, int, int, int) const {
        int t_ = threadIdx.x; asm volatile("" : "+v"(t_)); const int fr = t_ & 15, fq = (t_ >> 4) & 3, wid_ = __builtin_amdgcn_readfirstlane(t_ >> 6), wr = wid_ >> 2, wc = wid_ & 3;
        const int row0 = u.pm * 256 + wr * 64 + fr, col0 = u.pn * 256 + wc * 32 + 8 * fq;
        float rsv[8]; rows_rstd8(SS, row0, fq, rsv);
#pragma unroll
        for (int bj = 0; bj < 2; ++bj) { const int col = col0 + bj * 128;
            float w0[8], w1[8], w2[8], b[8];
#pragma unroll
            for (int e = 0; e < 8; e += 4) { const f32x4 a0 = *(const f32x4*)(cw + col + e), a1 = *(const f32x4*)(cw + DFF + col + e), a2 = *(const f32x4*)(cw + 2 * DFF + col + e), bb = *(const f32x4*)(cb + col + e);
#pragma unroll
                for (int q = 0; q < 4; ++q) { w0[e + q] = a0[q]; w1[e + q] = a1[q]; w2[e + q] = a2[q]; b[e + q] = bb[q]; } }
#pragma unroll
            for (int ai = 0; ai < 2; ++ai) {
#pragma unroll
              for (int mp = 0; mp < 2; ++mp) {
                u32x4 gl[4], gm[4], gr[4];
#pragma unroll
                for (int m = 2 * mp; m < 2 * mp + 2; ++m) { const int row = row0 + ai * 128 + m * 16; const int tok = tok0 + row; int ss, sl; seq_of(tok, ss, sl); const int pos = tok - ss;
                    const bf16_t* gp = G + (size_t)row * DFF + col; const u32x4 z4 = {0u, 0u, 0u, 0u};
                    gm[m] = *(const u32x4*)gp; gl[m] = pos > 0 ? *(const u32x4*)(gp - DFF) : z4; gr[m] = pos < sl - 1 ? *(const u32x4*)(gp + DFF) : z4; }
                asm volatile("" ::: "memory");
#pragma unroll
                for (int m = 2 * mp; m < 2 * mp + 2; ++m) { const int row = row0 + ai * 128 + m * 16; const float rs = rsv[ai * 4 + m];
                    float o[8];
#pragma unroll
                    for (int e = 0; e < 4; ++e) { const unsigned l2 = gl[m][e], m2 = gm[m][e], r2 = gr[m][e];
                        const float c0 = b[2 * e] + w0[2 * e] * bflo(l2) + w1[2 * e] * bflo(m2) + w2[2 * e] * bflo(r2);
                        const float c1 = b[2 * e + 1] + w0[2 * e + 1] * bfhi(l2) + w1[2 * e + 1] * bfhi(m2) + w2[2 * e + 1] * bfhi(r2);
                        o[2 * e] = c0 * sigmoidf_(c0) * rs * acc[ai][bj][m][e >> 1][(2 * e) & 3]; o[2 * e + 1] = c1 * sigmoidf_(c1) * rs * acc[ai][bj][m][e >> 1][(2 * e + 1) & 3]; }
                    u32x4 w; w.x = cvtpk(o[0], o[1]); w.y = cvtpk(o[2], o[3]); w.z = cvtpk(o[4], o[5]); w.w = cvtpk(o[6], o[7]);
                    *(u32x4*)(H + (size_t)row * DFF + col) = w; }
                asm volatile("" ::: "memory"); } } }
    }
};
DEVI void transpose_item(const float* W, int K, int N, bf16_t* WT, float* scr, int item, int lane, const float* ksc = nullptr) {
    const int nblk = N / 32, kb = item / nblk, nb = item % nblk, k0 = 64 * kb, n0 = 32 * nb;
#pragma unroll 8
    for (int i = 0; i < 32; ++i) { const int kk = 2 * i + (lane >> 5); scr[kk * 33 + (lane & 31)] = W[(size_t)(k0 + kk) * N + n0 + (lane & 31)] * (ksc ? ksc[k0 + kk] : 1.0f); }
    wave_sync();
    const int c = lane & 7;
#pragma unroll
    for (int j = 0; j < 4; ++j) { const int n = (lane >> 3) + 8 * j; const float* s = scr + (8 * c) * 33 + n;
        u32x4 o; o.x = cvtpk(s[0 * 33], s[1 * 33]); o.y = cvtpk(s[2 * 33], s[3 * 33]); o.z = cvtpk(s[4 * 33], s[5 * 33]); o.w = cvtpk(s[6 * 33], s[7 * 33]);
        *(u32x4*)(WT + (size_t)(n0 + n) * K + k0 + 8 * c) = o; }
    wave_sync();
}
DEVI void norm_row(const float* xrow, const float* w, bf16_t* orow, float* copy, int lane) {
    const f32x4* xr = (const f32x4*)xrow + lane; f32x4 v[4]; float s = 0.f;
#pragma unroll
    for (int j = 0; j < 4; ++j) { v[j] = xr[64 * j]; s += (v[j][0] * v[j][0] + v[j][1] * v[j][1]) + (v[j][2] * v[j][2] + v[j][3] * v[j][3]); }
    if (copy) {
#pragma unroll
        for (int j = 0; j < 4; ++j) ((f32x4*)copy + lane)[64 * j] = v[j]; }
    const float r = rsqrtf(wsum(s) * (1.0f / 1024.0f) + 1e-6f);
    const f32x4* wr = (const f32x4*)w + lane;
#pragma unroll
    for (int j = 0; j < 4; ++j) { const f32x4 ww = wr[64 * j]; u32x2 o; o.x = cvtpk(v[j][0] * r * ww[0], v[j][1] * r * ww[1]); o.y = cvtpk(v[j][2] * r * ww[2], v[j][3] * r * ww[3]);
        ((u32x2*)orow + lane)[64 * j] = o; }
}
DEVI void copy_rows2(const float* xa, const float* xb_, bf16_t* oa, bf16_t* ob, float* ssa, float* ssb, int lane) {
    const f32x4* pa = (const f32x4*)xa + lane; const f32x4* pb = (const f32x4*)xb_ + lane; f32x4 v[4], u[4];
#pragma unroll
    for (int j = 0; j < 4; ++j) { v[j] = pa[64 * j]; u[j] = pb[64 * j]; }
    asm volatile("" ::: "memory");
    float s = 0.f, q = 0.f;
#pragma unroll
    for (int j = 0; j < 4; ++j) { s += (v[j][0] * v[j][0] + v[j][1] * v[j][1]) + (v[j][2] * v[j][2] + v[j][3] * v[j][3]); q += (u[j][0] * u[j][0] + u[j][1] * u[j][1]) + (u[j][2] * u[j][2] + u[j][3] * u[j][3]);
        u32x2 o; o.x = cvtpk(v[j][0], v[j][1]); o.y = cvtpk(v[j][2], v[j][3]); ((u32x2*)oa + lane)[64 * j] = o; u32x2 p; p.x = cvtpk(u[j][0], u[j][1]); p.y = cvtpk(u[j][2], u[j][3]); ((u32x2*)ob + lane)[64 * j] = p; }
    s = wsum(s); q = wsum(q);
    if (lane < 16) { ssa[lane] = lane == 0 ? s : 0.f; ssb[lane] = lane == 0 ? q : 0.f; }
}
DEVI void final_norm_rows2(float* xrow0, float* xrow1, const float* w, int lane) {
    f32x4* x0 = (f32x4*)xrow0 + lane; f32x4* x1 = (f32x4*)xrow1 + lane; f32x4 v[4], u[4];
#pragma unroll
    for (int j = 0; j < 4; ++j) { v[j] = x0[64 * j]; u[j] = x1[64 * j]; }
    asm volatile("" ::: "memory");
    float s = 0.f, q = 0.f;
#pragma unroll
    for (int j = 0; j < 4; ++j) { s += (v[j][0] * v[j][0] + v[j][1] * v[j][1]) + (v[j][2] * v[j][2] + v[j][3] * v[j][3]); q += (u[j][0] * u[j][0] + u[j][1] * u[j][1]) + (u[j][2] * u[j][2] + u[j][3] * u[j][3]); }
    const float r = rsqrtf(wsum(s) * (1.0f / 1024.0f) + 1e-6f), r2 = rsqrtf(wsum(q) * (1.0f / 1024.0f) + 1e-6f);
    const f32x4* wr = (const f32x4*)w + lane;
#pragma unroll
    for (int j = 0; j < 4; ++j) { const f32x4 ww = wr[64 * j]; f32x4 o, p; o[0] = v[j][0] * r * ww[0]; o[1] = v[j][1] * r * ww[1]; o[2] = v[j][2] * r * ww[2]; o[3] = v[j][3] * r * ww[3];
        p[0] = u[j][0] * r2 * ww[0]; p[1] = u[j][1] * r2 * ww[1]; p[2] = u[j][2] * r2 * ww[2]; p[3] = u[j][3] * r2 * ww[3]; x0[64 * j] = o; x1[64 * j] = p; }
}

template <class G, bool BATCH = true, bool STORE = true> DEVI void attn256(const bf16_t* qrow, const G& g, bf16_t* orow, float scale2, int lane) {
    const int fq = lane >> 4;
    const bf16x8 qb0 = *(const bf16x8*)(qrow + 8 * fq), qb1 = *(const bf16x8*)(qrow + 32 + 8 * fq);
    f32x4 st[16];
#pragma unroll
    for (int half = 0; half < 2; ++half) {
        bf16x8 ka[8][2];
#pragma unroll
        for (int i = 0; i < 8; ++i) { const bf16_t* kp = g.krow(8 * half + i); ka[i][0] = *(const bf16x8*)(kp + 8 * fq); ka[i][1] = *(const bf16x8*)(kp + 32 + 8 * fq); }
        asm volatile("" ::: "memory");
#pragma unroll
        for (int i = 0; i < 8; ++i) { f32x4 acc = {0.f, 0.f, 0.f, 0.f};
            acc = __builtin_amdgcn_mfma_f32_16x16x32_bf16(ka[i][0], qb0, acc, 0, 0, 0);
            acc = __builtin_amdgcn_mfma_f32_16x16x32_bf16(ka[i][1], qb1, acc, 0, 0, 0);
            st[8 * half + i] = acc; }
    }
    u32x2 vlo0[4][4], vhi0[4][4];
    if (BATCH) {
#pragma unroll
        for (int k4 = 0; k4 < 4; ++k4)
#pragma unroll
            for (int dt = 0; dt < 4; ++dt) { vlo0[k4][dt] = *(const u32x2*)g.vt(k4, dt, 0); vhi0[k4][dt] = *(const u32x2*)g.vt(k4, dt, 1); }
        asm volatile("" ::: "memory");
    }
    float mx = -INFINITY;
    {   f32x4 bz[16];
#pragma unroll
        for (int nt = 0; nt < 16; ++nt)
#pragma unroll
            for (int r = 0; r < 4; ++r) bz[nt][r] = g.bias2(nt, r);
        asm volatile("" ::: "memory");
#pragma unroll
        for (int nt = 0; nt < 16; ++nt)
#pragma unroll
            for (int r = 0; r < 4; ++r) { const float v = st[nt][r] * scale2 + bz[nt][r]; st[nt][r] = v; mx = fmaxf(mx, v); } }
    mx = fmaxf(mx, __shfl_xor(mx, 16)); mx = fmaxf(mx, __shfl_xor(mx, 32));
    float sum = 0.f;
#pragma unroll
    for (int nt = 0; nt < 16; ++nt)
#pragma unroll
        for (int r = 0; r < 4; ++r) { const float p = __builtin_amdgcn_exp2f(st[nt][r] - mx); st[nt][r] = p; sum += p; }
    sum += __shfl_xor(sum, 16); sum += __shfl_xor(sum, 32);
    const float inv = 1.0f / sum;
    f32x4 o[4];
#pragma unroll
    for (int dt = 0; dt < 4; ++dt) o[dt] = (f32x4){0.f, 0.f, 0.f, 0.f};
    if (BATCH)
#pragma unroll
    for (int half = 0; half < 2; ++half) {
        u32x2 vlo[4][4], vhi[4][4];
#pragma unroll
        for (int k4 = 0; k4 < 4; ++k4)
#pragma unroll
            for (int dt = 0; dt < 4; ++dt) { if (half == 0) { vlo[k4][dt] = vlo0[k4][dt]; vhi[k4][dt] = vhi0[k4][dt]; } else { vlo[k4][dt] = *(const u32x2*)g.vt(4 + k4, dt, 0); vhi[k4][dt] = *(const u32x2*)g.vt(4 + k4, dt, 1); } }
        asm volatile("" ::: "memory");
#pragma unroll
        for (int k4 = 0; k4 < 4; ++k4) { const int ks = 4 * half + k4;
            u32x4 pw; pw.x = cvtpk(st[2 * ks][0], st[2 * ks][1]); pw.y = cvtpk(st[2 * ks][2], st[2 * ks][3]); pw.z = cvtpk(st[2 * ks + 1][0], st[2 * ks + 1][1]); pw.w = cvtpk(st[2 * ks + 1][2], st[2 * ks + 1][3]);
            const bf16x8 pb = __builtin_bit_cast(bf16x8, pw);
#pragma unroll
            for (int dt = 0; dt < 4; ++dt) { u32x4 vw; vw.x = vlo[k4][dt].x; vw.y = vlo[k4][dt].y; vw.z = vhi[k4][dt].x; vw.w = vhi[k4][dt].y;
                o[dt] = __builtin_amdgcn_mfma_f32_16x16x32_bf16(__builtin_bit_cast(bf16x8, vw), pb, o[dt], 0, 0, 0); } }
    }
    if (!BATCH) {
#pragma unroll
        for (int ks = 0; ks < 8; ++ks) {
            u32x4 pw; pw.x = cvtpk(st[2 * ks][0], st[2 * ks][1]); pw.y = cvtpk(st[2 * ks][2], st[2 * ks][3]); pw.z = cvtpk(st[2 * ks + 1][0], st[2 * ks + 1][1]); pw.w = cvtpk(st[2 * ks + 1][2], st[2 * ks + 1][3]);
            const bf16x8 pb = __builtin_bit_cast(bf16x8, pw);
#pragma unroll
            for (int dt = 0; dt < 4; ++dt) { const u32x2 lo = *(const u32x2*)g.vt(ks, dt, 0), hi = *(const u32x2*)g.vt(ks, dt, 1); u32x4 vw; vw.x = lo.x; vw.y = lo.y; vw.z = hi.x; vw.w = hi.y;
                o[dt] = __builtin_amdgcn_mfma_f32_16x16x32_bf16(__builtin_bit_cast(bf16x8, vw), pb, o[dt], 0, 0, 0); } }
    }
#pragma unroll
    for (int dt = 0; dt < 4; ++dt) { u32x2 w; w.x = cvtpk(o[dt][0] * inv, o[dt][1] * inv); w.y = cvtpk(o[dt][2] * inv, o[dt][3] * inv); if (STORE || w.x == 0x12345678u) *(u32x2*)(orow + 16 * dt + 4 * fq) = w; }
}
struct NaGeom {
    const bf16_t* proj; const bf16_t* vta; const float* rpb; int seq_start, r, r0, qs, ks, h, fr, fq;
    DEVI const bf16_t* krow(int nt) const { const int i = nt >> 1, kc = (nt & 1) * 16 + fr; const size_t tok = (size_t)(seq_start + (r0 + i) * 64 + ks + kc); return proj + tok * INW + 256 + h * 64; }
    DEVI const bf16_t* vt(int kstep, int dt, int half) const { const int d = 16 * dt + fr; const size_t tok = (size_t)(seq_start + (r0 + kstep) * 64 + ks + 16 * half + 4 * fq); return vta + ((tok >> 6) * 256 + (size_t)(h * 64 + d)) * 64 + (tok & 63); }
    DEVI float bias2(int nt, int reg) const { const int i = nt >> 1, kcol = ks + (nt & 1) * 16 + 4 * fq + reg, qcol = qs + fr; const int c0 = min(max(qcol - 8, 0), 48);
        const bool in = (kcol >= c0) && (kcol < c0 + 16); const int dr = (r0 + i) - r + 7, dc = min(max(kcol - qcol, -15), 15) + 15;
        const float bv = rpb[(h * 15 + dr) * 31 + dc]; return in ? bv * LOG2E : -INFINITY; }
};
struct XaGeomL {
    const bf16_t* kl; const bf16_t* vtl; int fr, fq;
    DEVI const bf16_t* krow(int nt) const { return kl + (16 * nt + fr) * 72; }
    DEVI const bf16_t* vt(int kstep, int dt, int half) const { return vtl + (16 * dt + fr) * 264 + 32 * kstep + 16 * half + 4 * fq; }
    DEVI float bias2(int, int) const { return 0.f; }
};
struct XaGeom {
    const bf16_t* xk; const bf16_t* xvt; int b, h, fr, fq;
    DEVI const bf16_t* krow(int nt) const { return xk + (size_t)(b * 256 + 16 * nt + fr) * 256 + h * 64; }
    DEVI const bf16_t* vt(int kstep, int dt, int half) const { return xvt + (size_t)(b * 256 + h * 64 + 16 * dt + fr) * 256 + 32 * kstep + 16 * half + 4 * fq; }
    DEVI float bias2(int, int) const { return 0.f; }
};
DEVI void s5_load_b(const float* S5B, int pg, int lane, bf16x8 (&bB)[8]) {
    const int fr = lane & 15, fq = lane >> 4;
    f32x4 x[8], y[8];
#pragma unroll
    for (int nt = 0; nt < 8; ++nt) { const float* src = S5B + ((size_t)pg * 64 + 16 * (nt & 3) + fr) * 32 + (nt >> 2) * 16 + 8 * (fq & 1); x[nt] = *(const f32x4*)src; y[nt] = *(const f32x4*)(src + 4); }
    asm volatile("" ::: "memory");
#pragma unroll
    for (int nt = 0; nt < 8; ++nt) { u32x4 w = {0u, 0u, 0u, 0u};
        if (fq < 2) { w.x = cvtpk(x[nt][0], x[nt][1]); w.y = cvtpk(x[nt][2], x[nt][3]); w.z = cvtpk(y[nt][0], y[nt][1]); w.w = cvtpk(y[nt][2], y[nt][3]); }
        bB[nt] = __builtin_bit_cast(bf16x8, w); }
}
DEVI void s5_bu_block(const bf16_t* Ubf, unsigned* BUX, const bf16x8 (&bB)[8], int lane) {
    const int fr = lane & 15, fq = lane >> 4;
    u32x4 aw = {0u, 0u, 0u, 0u}; if (fq < 2) aw = *(const u32x4*)(Ubf + fr * 16 + 8 * fq);
    const bf16x8 aU = __builtin_bit_cast(bf16x8, aw);
#pragma unroll
    for (int q = 0; q < 4; ++q) { f32x4 dre = {0.f, 0.f, 0.f, 0.f}, dim = {0.f, 0.f, 0.f, 0.f};
        dre = __builtin_amdgcn_mfma_f32_16x16x32_bf16(aU, bB[q], dre, 0, 0, 0); dim = __builtin_amdgcn_mfma_f32_16x16x32_bf16(aU, bB[q + 4], dim, 0, 0, 0);
#pragma unroll
        for (int r = 0; r < 4; ++r) BUX[(4 * fq + r) * 68 + 16 * q + fr] = cvtpk(dre[r], dim[r]); }
}
DEVI void s5_pass1(const bf16_t* proj, const float* S5A, const float* S5B, float* S5F, int l, unsigned char* wl, int gw, int NGW, int lane) {
    bf16_t* Ubf = (bf16_t*)wl;
    unsigned* BUX = (unsigned*)(wl + 512);
    const int srow = lane >> 2, spc = lane & 3;
    for (int u = gw; u < 768 * 32; u += NGW) {
        const int dir = u & 1, g = (u >> 1) & 15, chunk = u >> 5; const size_t cs = (size_t)chunk * 128;
        const int pg = (l * 2 + dir) * 16 + g; const int p = pg * 64 + lane;
        const f32x4 a4 = *(const f32x4*)(S5A + (size_t)p * 4); const float ar = a4[0], ai = a4[1];
        bf16x8 bB[8]; s5_load_b(S5B, pg, lane, bB);
        float xr = 0.f, xi = 0.f;
        const bf16_t* ub = proj + 768 + g * 16 + spc * 4;
        u32x2 cur = *(const u32x2*)(ub + ((dir ? cs + 112 : cs) + srow) * INW);
        for (int blk = 0; blk < 8; ++blk) {
            u32x2 nxt = cur;
            if (blk < 7) { const size_t tb = dir ? cs + 112 - 16 * (blk + 1) : cs + 16 * (blk + 1); nxt = *(const u32x2*)(ub + (tb + srow) * INW); }
            *(u32x2*)(Ubf + srow * 16 + spc * 4) = cur;
            wave_sync();
            s5_bu_block(Ubf, BUX, bB, lane);
            wave_sync();
#pragma unroll
            for (int k = 0; k < 16; ++k) { const int row = dir ? 15 - k : k; const unsigned bw = BUX[row * 68 + lane]; const float bur = bflo(bw), bui = bfhi(bw);
                const float nr = ar * xr - ai * xi + bur, ni = ar * xi + ai * xr + bui; xr = nr; xi = ni; }
            wave_sync();
            cur = nxt;
        }
        float* f = S5F + ((size_t)(chunk * 16 + g) * 2 + dir) * 128;
        f[lane] = xr; f[64 + lane] = xi;
    }
}
DEVI float gelu_tanh(float y) { const float z = 0.7978845608028654f * (y + 0.044715f * y * y * y); const float e = __expf(2.0f * z); const float th = 1.0f - 2.0f * __builtin_amdgcn_rcpf(1.0f + e); return 0.5f * y * (1.0f + th); }
DEVI void s5_pass2(const bf16_t* proj, const float* S5A, const float* S5B, const float* S5F, const float* cre, const float* cim, const float* dskip, bf16_t* HB,
                   int l, unsigned char* wl, int gw, int NGW, int lane) {
    bf16_t* Ubf = (bf16_t*)wl;
    unsigned* BUX = (unsigned*)(wl + 512);
    float* YL = (float*)(wl + 512 + 4352);
    const int srow = lane >> 2, spc = lane & 3, fr = lane & 15, fq = lane >> 4;
    for (int u = gw; u < 768 * 16; u += NGW) {
        const int g = u & 15, chunk = u >> 4; const int csi = chunk * 128; const size_t cs = (size_t)csi;
        int ss, sl; seq_of(csi, ss, sl); const int nch = sl >> 7, cj = (csi - ss) >> 7, cb0 = ss >> 7;
        const bf16_t* ub = proj + 768 + g * 16 + spc * 4;
        for (int dir = 0; dir < 2; ++dir) {
            const int pg = (l * 2 + dir) * 16 + g; const int p = pg * 64 + lane;
            const f32x4 a4 = *(const f32x4*)(S5A + (size_t)p * 4); const float ar = a4[0], ai = a4[1], pr = a4[2], pi = a4[3];
            bf16x8 bB[8]; s5_load_b(S5B, pg, lane, bB);
            bf16x8 Cb[4];
            { f32x4 cx[4], cy[4];
#pragma unroll
              for (int s = 0; s < 4; ++s) { const size_t o_ = ((size_t)pg * 16 + fr) * 64 + 16 * s + 4 * fq; cx[s] = *(const f32x4*)(cre + o_); cy[s] = *(const f32x4*)(cim + o_); }
              asm volatile("" ::: "memory");
#pragma unroll
              for (int s = 0; s < 4; ++s) { const f32x4 x = cx[s], y = cy[s]; u32x4 w;
                w.x = cvtpk(x[0], -y[0]); w.y = cvtpk(x[1], -y[1]); w.z = cvtpk(x[2], -y[2]); w.w = cvtpk(x[3], -y[3]); Cb[s] = __builtin_bit_cast(bf16x8, w); } }
            float xr = 0.f, xi = 0.f;
            {
                const int n = dir == 0 ? cj : nch - 1 - cj; const int c0 = dir == 0 ? cb0 : cb0 + nch - 1; const int cstep = dir == 0 ? 1 : -1;
                for (int i0 = 0; i0 < n; i0 += 8) { float fr_[8], fi_[8];
#pragma unroll
                    for (int j = 0; j < 8; ++j) { const int i = min(i0 + j, n - 1); const float* f = S5F + ((size_t)((c0 + cstep * i) * 16 + g) * 2 + dir) * 128; fr_[j] = f[lane]; fi_[j] = f[64 + lane]; }
#pragma unroll
                    for (int j = 0; j < 8; ++j) if (i0 + j < n) { const float nr = pr * xr - pi * xi + fr_[j], ni = pr * xi + pi * xr + fi_[j]; xr = nr; xi = ni; } }
            }
            u32x2 cur = *(const u32x2*)(ub + ((dir ? cs + 112 : cs) + srow) * INW);
            for (int blk = 0; blk < 8; ++blk) {
                const int tl0 = dir ? 112 - 16 * blk : 16 * blk;
                u32x2 nxt = cur;
                if (blk < 7) { const size_t tb = dir ? cs + 112 - 16 * (blk + 1) : cs + 16 * (blk + 1); nxt = *(const u32x2*)(ub + (tb + srow) * INW); }
                *(u32x2*)(Ubf + srow * 16 + spc * 4) = cur;
                wave_sync();
                s5_bu_block(Ubf, BUX, bB, lane);
                wave_sync();
#pragma unroll
                for (int k = 0; k < 16; ++k) { const int row = dir ? 15 - k : k; const unsigned bw = BUX[row * 68 + lane]; const float bur = bflo(bw), bui = bfhi(bw);
                    const float nr = ar * xr - ai * xi + bur, ni = ar * xi + ai * xr + bui; xr = nr; xi = ni;
                    BUX[row * 68 + lane] = cvtpk(xr, xi); }
                wave_sync();
                f32x4 acc = {0.f, 0.f, 0.f, 0.f};
#pragma unroll
                for (int s = 0; s < 4; ++s) { const bf16x8 a = *(const bf16x8*)((const bf16_t*)BUX + fr * 136 + 32 * s + 8 * fq); acc = __builtin_amdgcn_mfma_f32_16x16x32_bf16(a, Cb[s], acc, 0, 0, 0); }
#pragma unroll
                for (int r = 0; r < 4; ++r) { float* yp = YL + (tl0 + 4 * fq + r) * 17 + fr; if (dir == 0) *yp = acc[r]; else *yp += acc[r]; }
                wave_sync();
                cur = nxt;
            }
        }
        for (int i0 = 0; i0 < 32; i0 += 16) { bf16_t ur[16];
#pragma unroll
            for (int j = 0; j < 16; ++j) { const int idx = (i0 + j) * 64 + lane, t = idx >> 4, c = idx & 15; ur[j] = proj[(cs + t) * INW + 768 + g * 16 + c]; }
            asm volatile("" ::: "memory");
#pragma unroll
            for (int j = 0; j < 16; ++j) { const int idx = (i0 + j) * 64 + lane, t = idx >> 4, c = idx & 15;
                const float y = YL[t * 17 + c] + dskip[g * 16 + c] * bf1(ur[j]); HB[(cs + t) * 256 + g * 16 + c] = tobf(gelu_tanh(y)); } }
        wave_sync();
    }
}

template <int PASS> DEVI void hgrn_pass(const bf16_t* proj, const float* LB, float* HF, float* HD, bf16_t* OF, LAS unsigned char* wll, int l, unsigned char* wl, int gw, int NGW, int lane) {
    bf16_t* Qt = (bf16_t*)wl;
    bf16_t* Kt = (bf16_t*)(wl + 2304);
    bf16_t* Vt = (bf16_t*)(wl + 4608);
    bf16_t* K2t = (bf16_t*)(wl + 6656);
    float* EB = (float*)(wl + 8704);
    float* EC = (float*)(wl + 8960);
    const bf16_t* RZ = (const bf16_t*)(wl + 9216);
    const bf16_t* RV = (const bf16_t*)(wl + 11264);
    const bf16_t* RQ = (const bf16_t*)(wl + 13312);
    const int fr = lane & 15, fq = lane >> 4;
#define HG_DMA(tbv) do { _Pragma("unroll") for (int i_ = 0; i_ < 2; ++i_) { const int r_ = 8 * i_ + (lane >> 3); const size_t go_ = ((tbv) + (dir ? 15 - r_ : r_)) * INW + (lane & 7) * 8; \
        __builtin_amdgcn_global_load_lds((const unsigned*)(zb + go_), (LAS unsigned*)(wll + 9216 + i_ * 1024), 16, 0, 0); \
        __builtin_amdgcn_global_load_lds((const unsigned*)(vb + go_), (LAS unsigned*)(wll + 11264 + i_ * 1024), 16, 0, 0); \
        if (PASS == 2) __builtin_amdgcn_global_load_lds((const unsigned*)(qbp + go_), (LAS unsigned*)(wll + 13312 + i_ * 1024), 16, 0, 0); } \
        asm volatile("" ::: "memory"); } while (0)
    for (int u = gw; u < 192 * 8; u += NGW) {
        const int dir = u & 1, h = (u >> 1) & 3, chunk = u >> 3; const size_t cs = (size_t)chunk * 512;
        const float lb = LB[l * 256 + h * 64 + lane], oml = 1.f - lb;
        f32x4 S[4][4];
        float* hf = HF + (size_t)u * 4096;
        if (PASS == 2) {
#pragma unroll
            for (int mt = 0; mt < 4; ++mt)
#pragma unroll
                for (int nt = 0; nt < 4; ++nt)
#pragma unroll
                    for (int r = 0; r < 4; ++r) S[mt][nt][r] = hf[(16 * mt + 4 * fq + r) * 64 + 16 * nt + fr];
        } else {
#pragma unroll
            for (int mt = 0; mt < 4; ++mt)
#pragma unroll
                for (int nt = 0; nt < 4; ++nt) S[mt][nt] = (f32x4){0.f, 0.f, 0.f, 0.f};
        }
        float bsum = 0.f;
        const bf16_t* zb = proj + (dir ? 2048 : 1792) + h * 64;
        const bf16_t* vb = proj + 2304 + h * 64;
        const bf16_t* qbp = proj + 1536 + h * 64;
        size_t tb = dir ? cs + 496 : cs;
        asm volatile("s_waitcnt vmcnt(0)" ::: "memory");
        HG_DMA(tb);
        asm volatile("s_waitcnt vmcnt(0)" ::: "memory");
        for (int blk = 0; blk < 32; ++blk) {
            if (blk > 0) { if (PASS == 2) asm volatile("s_waitcnt vmcnt(16)" ::: "memory"); else asm volatile("s_waitcnt vmcnt(0)" ::: "memory"); }
            wave_sync();
            float bs[16]; unsigned omp[8]; float c = 0.f, Bt = 0.f;
            { float b = 0.f;
#pragma unroll
              for (int s = 0; s < 16; ++s) { const float e = __expf(fminf(fmaxf(bf1(RZ[s * 64 + lane]), -20.f), 20.f)); const float o_ = oml * __builtin_amdgcn_rcpf(1.f + e);
                  if (s & 1) omp[s >> 1] |= (unsigned)tobf(o_) << 16; else omp[s >> 1] = (unsigned)tobf(o_);
                  b += __logf(1.f - o_); bs[s] = b; }
              c = bs[7]; Bt = b; }
            bsum += Bt;
            { u32x4 va, vbw; unsigned vw[8];
#pragma unroll
              for (int s = 0; s < 16; s += 2) vw[s >> 1] = (unsigned)RV[s * 64 + lane] | ((unsigned)RV[(s + 1) * 64 + lane] << 16);
              va.x = vw[0]; va.y = vw[1]; va.z = vw[2]; va.w = vw[3]; vbw.x = vw[4]; vbw.y = vw[5]; vbw.z = vw[6]; vbw.w = vw[7];
              *(u32x4*)(Vt + lane * 16) = va; *(u32x4*)(Vt + lane * 16 + 8) = vbw; }
            { u32x4 k2a, k2b; unsigned k2w[8];
#pragma unroll
              for (int s = 0; s < 16; s += 2) {
                  const float om0 = bflo(omp[s >> 1]), om1 = bfhi(omp[s >> 1]), b0 = bs[s], b1 = bs[s + 1];
                  const float k2_0 = om0 * __expf(Bt - b0), k2_1 = om1 * __expf(Bt - b1); k2w[s >> 1] = cvtpk(k2_0, k2_1);
                  Kt[s * 72 + lane] = tobf(om0 * __expf(c - b0)); Kt[(s + 1) * 72 + lane] = tobf(om1 * __expf(c - b1));
                  if (PASS == 2) { Qt[s * 72 + lane] = tobf(bf1(RQ[s * 64 + lane]) * __expf(b0 - c)); Qt[(s + 1) * 72 + lane] = tobf(bf1(RQ[(s + 1) * 64 + lane]) * __expf(b1 - c)); } }
              k2a.x = k2w[0]; k2a.y = k2w[1]; k2a.z = k2w[2]; k2a.w = k2w[3]; k2b.x = k2w[4]; k2b.y = k2w[5]; k2b.z = k2w[6]; k2b.w = k2w[7];
              *(u32x4*)(K2t + lane * 16) = k2a; *(u32x4*)(K2t + lane * 16 + 8) = k2b;
              EB[lane] = __expf(Bt); EC[lane] = __expf(c); }
            wave_sync();
            const size_t tcur = tb;
            if (blk < 31) { tb = dir ? tb - 16 : tb + 16; HG_DMA(tb); }
            s16x4 vB[4];
#pragma unroll
            for (int nt = 0; nt < 4; ++nt) vB[nt] = *(const s16x4*)(Vt + (16 * nt + fr) * 16 + 4 * fq);
            if (PASS == 2) {
                f32x4 at = {0.f, 0.f, 0.f, 0.f};
#pragma unroll
                for (int ks = 0; ks < 2; ++ks) { const bf16x8 ka = *(const bf16x8*)(Kt + fr * 72 + 32 * ks + 8 * fq), qb = *(const bf16x8*)(Qt + fr * 72 + 32 * ks + 8 * fq);
                    at = __builtin_amdgcn_mfma_f32_16x16x32_bf16(ka, qb, at, 0, 0, 0); }
#pragma unroll
                for (int r = 0; r < 4; ++r) at[r] = (4 * fq + r <= fr) ? at[r] : 0.f;
                u32x2 aw; aw.x = cvtpk(at[0], at[1]); aw.y = cvtpk(at[2], at[3]); const s16x4 aP = __builtin_bit_cast(s16x4, aw);
                bf16x8 qP[2];
#pragma unroll
                for (int ks = 0; ks < 2; ++ks) { const u32x2 x = *(const u32x2*)(Qt + fr * 72 + 32 * ks + 4 * fq), y = *(const u32x2*)(Qt + fr * 72 + 32 * ks + 16 + 4 * fq); u32x4 w; w.x = x.x; w.y = x.y; w.z = y.x; w.w = y.y; qP[ks] = __builtin_bit_cast(bf16x8, w); }
                f32x4 ec[4];
#pragma unroll
                for (int mt = 0; mt < 4; ++mt) ec[mt] = *(const f32x4*)(EC + 16 * mt + 4 * fq);
#pragma unroll
                for (int nt = 0; nt < 4; ++nt) { f32x4 o = {0.f, 0.f, 0.f, 0.f};
#pragma unroll
                    for (int ks = 0; ks < 2; ++ks) { const f32x4 e0 = ec[2 * ks], e1 = ec[2 * ks + 1]; u32x4 w; w.x = cvtpk(S[2 * ks][nt][0] * e0[0], S[2 * ks][nt][1] * e0[1]); w.y = cvtpk(S[2 * ks][nt][2] * e0[2], S[2 * ks][nt][3] * e0[3]);
                        w.z = cvtpk(S[2 * ks + 1][nt][0] * e1[0], S[2 * ks + 1][nt][1] * e1[1]); w.w = cvtpk(S[2 * ks + 1][nt][2] * e1[2], S[2 * ks + 1][nt][3] * e1[3]);
                        o = __builtin_amdgcn_mfma_f32_16x16x32_bf16(qP[ks], __builtin_bit_cast(bf16x8, w), o, 0, 0, 0); }
                    o = __builtin_amdgcn_mfma_f32_16x16x16bf16_1k(aP, vB[nt], o, 0, 0, 0);
#pragma unroll
                    for (int r = 0; r < 4; ++r) { const int t = 4 * fq + r; const int tl = dir ? 15 - t : t;
                        (OF + tcur * INW + (dir ? 2048 : 1792) + h * 64 + 16 * nt)[tl * INW + fr] = tobf(o[r]); } }
            }
#pragma unroll
            for (int mt = 0; mt < 4; ++mt) { const s16x4 k2A = *(const s16x4*)(K2t + (16 * mt + fr) * 16 + 4 * fq);
                const f32x4 eb = *(const f32x4*)(EB + 16 * mt + 4 * fq);
#pragma unroll
                for (int nt = 0; nt < 4; ++nt) { f32x4 cin; cin[0] = S[mt][nt][0] * eb[0]; cin[1] = S[mt][nt][1] * eb[1]; cin[2] = S[mt][nt][2] * eb[2]; cin[3] = S[mt][nt][3] * eb[3];
                    S[mt][nt] = __builtin_amdgcn_mfma_f32_16x16x16bf16_1k(k2A, vB[nt], cin, 0, 0, 0); } }
        }
        if (PASS == 1) {
#pragma unroll
            for (int mt = 0; mt < 4; ++mt)
#pragma unroll
                for (int nt = 0; nt < 4; ++nt)
#pragma unroll
                    for (int r = 0; r < 4; ++r) hf[(16 * mt + 4 * fq + r) * 64 + 16 * nt + fr] = S[mt][nt][r];
            HD[(size_t)u * 64 + lane] = __expf(bsum);
        }
    }
#undef HG_DMA
}
DEVI void hgrn_chain(float* HF, const float* HD, int gw, int NGW, int lane) {
    for (int w = gw; w < 34 * 8 * 4; w += NGW) {
        const int slab = w & 3, dir = (w >> 2) & 1, h = (w >> 3) & 3, sq = w >> 5;
        const int cb0 = sq < 32 ? sq * 4 : 128 + (sq - 32) * 32, nch = sq < 32 ? 4 : 32;
        float C[16], F[16], Dd[16];
#pragma unroll
        for (int k = 0; k < 16; ++k) C[k] = 0.f;
        { const int ci = dir ? nch - 1 : 0; const size_t uidx = ((size_t)(cb0 + ci) * 4 + h) * 2 + dir; const float* hf = HF + uidx * 4096 + (size_t)slab * 16 * 64 + lane; const float* hd = HD + uidx * 64 + slab * 16;
#pragma unroll
          for (int k = 0; k < 16; ++k) { F[k] = hf[k * 64]; Dd[k] = hd[k]; } }
        for (int i = 0; i < nch; ++i) { const int ci = dir ? nch - 1 - i : i; const size_t uidx = ((size_t)(cb0 + ci) * 4 + h) * 2 + dir;
            float* hf = HF + uidx * 4096 + (size_t)slab * 16 * 64 + lane;
            float Fn[16], Dn[16];
            { const int i2 = min(i + 1, nch - 1); const int ci2 = dir ? nch - 1 - i2 : i2; const size_t u2 = ((size_t)(cb0 + ci2) * 4 + h) * 2 + dir; const float* hf2 = HF + u2 * 4096 + (size_t)slab * 16 * 64 + lane; const float* hd2 = HD + u2 * 64 + slab * 16;
#pragma unroll
              for (int k = 0; k < 16; ++k) { Fn[k] = hf2[k * 64]; Dn[k] = hd2[k]; } }
#pragma unroll
            for (int k = 0; k < 16; ++k) { hf[k * 64] = C[k]; C[k] = Dd[k] * C[k] + F[k]; }
#pragma unroll
            for (int k = 0; k < 16; ++k) { F[k] = Fn[k]; Dd[k] = Dn[k]; } }
    }
}

DEVI void qk_finish(bf16_t* base, unsigned a, unsigned b, const f32x4 cs4, const f32x4 nw, float sc, int i) {
    float x0 = bflo(a), x1 = bfhi(a), y0 = bflo(b), y1 = bfhi(b);
    float s = x0 * x0 + x1 * x1 + y0 * y0 + y1 * y1;
    s += __shfl_xor(s, 1); s += __shfl_xor(s, 2); s += __shfl_xor(s, 4); s += __shfl_xor(s, 8);
    const float r = rsqrtf(s * (1.0f / 64.0f) + 1e-6f);
    x0 *= r * nw[0]; x1 *= r * nw[1]; y0 *= r * nw[2]; y1 *= r * nw[3];
    const float o0 = (x0 * cs4[0] - y0 * cs4[1]) * sc, o1 = (x1 * cs4[2] - y1 * cs4[3]) * sc, p0 = (y0 * cs4[0] + x0 * cs4[1]) * sc, p1 = (y1 * cs4[2] + x1 * cs4[3]) * sc;
    *(unsigned*)(base + 2 * i) = cvtpk(o0, o1); *(unsigned*)(base + 32 + 2 * i) = cvtpk(p0, p1);
}
DEVI void qk_prep(bf16_t* proj, const float* qw, const float* kw, const float* rope, int gw, int NGW, int lane) {
    const int i = lane & 15;
    const f32x4 qn = {qw[2 * i], qw[2 * i + 1], qw[32 + 2 * i], qw[33 + 2 * i]}, kn = {kw[2 * i], kw[2 * i + 1], kw[32 + 2 * i], kw[33 + 2 * i]};
    for (int tok0 = gw; tok0 < T; tok0 += 4 * NGW) {
        unsigned qa[4], qb[4], ka[4], kb[4]; f32x4 cs[4];
#pragma unroll
        for (int j = 0; j < 4; ++j) { const int tok = min(tok0 + j * NGW, T - 1);
            int ss, sl; seq_of(tok, ss, sl); const int pos = tok - ss, pr = pos >> 6, pc = pos & 63; const int pp = (2 * i < 16) ? pr : pc, fi = (2 * i) & 15;
            cs[j] = *(const f32x4*)(rope + ((size_t)pp * 16 + fi) * 2);
            const bf16_t* bq = proj + (size_t)tok * INW + 1024 + (lane >> 4) * 64; const bf16_t* bk = proj + (size_t)tok * INW + 1280 + ((lane >> 4) & 1) * 64;
            qa[j] = *(const unsigned*)(bq + 2 * i); qb[j] = *(const unsigned*)(bq + 32 + 2 * i); ka[j] = *(const unsigned*)(bk + 2 * i); kb[j] = *(const unsigned*)(bk + 32 + 2 * i); }
        asm volatile("" ::: "memory");
#pragma unroll
        for (int j = 0; j < 4; ++j) { const int tok = tok0 + j * NGW; if (tok < T) {
            qk_finish(proj + (size_t)tok * INW + 1024 + (lane >> 4) * 64, qa[j], qb[j], cs[j], qn, 0.125f * LOG2E, i);
            if (lane < 32) qk_finish(proj + (size_t)tok * INW + 1280 + (lane >> 4) * 64, ka[j], kb[j], cs[j], kn, 1.0f, i); } }
    }
}
DEVI void merge_row_finish(bf16_t* row, const u32x2 (&in)[6], const f32x4 (&w)[4]) {
#pragma unroll
    for (int gi = 0; gi < 4; ++gi) {
        const u32x2 a = in[gi]; float v0 = bflo(a.x), v1 = bfhi(a.x), v2 = bflo(a.y), v3 = bfhi(a.y);
        if (gi == 3) { const u32x2 b = in[4]; v0 += bflo(b.x); v1 += bfhi(b.x); v2 += bflo(b.y); v3 += bfhi(b.y); }
        const float s = wsum(v0 * v0 + v1 * v1 + v2 * v2 + v3 * v3); const float r = rsqrtf(s * (1.0f / 256.0f) + 1e-6f);
        v0 *= r * w[gi][0]; v1 *= r * w[gi][1]; v2 *= r * w[gi][2]; v3 *= r * w[gi][3];
        if (gi == 3) { const u32x2 g = in[5]; const float g0 = bflo(g.x), g1 = bfhi(g.x), g2 = bflo(g.y), g3 = bfhi(g.y);
            v0 *= g0 * sigmoidf_(g0); v1 *= g1 * sigmoidf_(g1); v2 *= g2 * sigmoidf_(g2); v3 *= g3 * sigmoidf_(g3); }
        u32x2 o; o.x = cvtpk(v0, v1); o.y = cvtpk(v2, v3); *(u32x2*)(row + gi * 256) = o;
    }
}
DEVI void merge_norm(bf16_t* proj, const float* gw_, int gwv, int NGW, int lane) {
    f32x4 w[4];
#pragma unroll
    for (int gi = 0; gi < 4; ++gi) w[gi] = *(const f32x4*)(gw_ + gi * 256 + 4 * lane);
    for (int tok = gwv; tok < T; tok += 2 * NGW) {
        bf16_t* r0 = proj + (size_t)tok * INW + 4 * lane; const bool two = tok + NGW < T; bf16_t* r1 = proj + (size_t)(two ? tok + NGW : tok) * INW + 4 * lane;
        u32x2 a[6], b[6];
        a[0] = *(const u32x2*)(r0); a[1] = *(const u32x2*)(r0 + 768); a[2] = *(const u32x2*)(r0 + 1024); a[3] = *(const u32x2*)(r0 + 1792); a[4] = *(const u32x2*)(r0 + 2048); a[5] = *(const u32x2*)(r0 + 2560);
        b[0] = *(const u32x2*)(r1); b[1] = *(const u32x2*)(r1 + 768); b[2] = *(const u32x2*)(r1 + 1024); b[3] = *(const u32x2*)(r1 + 1792); b[4] = *(const u32x2*)(r1 + 2048); b[5] = *(const u32x2*)(r1 + 2560);
        asm volatile("" ::: "memory");
        merge_row_finish(r0, a, w);
        if (two) merge_row_finish(r1, b, w);
    }
}
#define XB_TMO      128
#define XB_XCNT(j)  (256  + 64 * (j))
#define XB_XSUB(j)  (1280 + 64 * (j))
#define XB_XGEN(j)  (2304 + 64 * (j))
#define XB_TOP      3328
#define XB_TOPGEN   3392
#define XCD_BAR_WORDS 3456
#define XB_SPIN_CAP (1u << 18)

__device__ __forceinline__ unsigned xb_ld(unsigned* p)              { return __hip_atomic_load(p, __ATOMIC_RELAXED, __HIP_MEMORY_SCOPE_AGENT); }
__device__ __forceinline__ unsigned xb_add(unsigned* p, unsigned v) { return __hip_atomic_fetch_add(p, v, __ATOMIC_RELAXED, __HIP_MEMORY_SCOPE_AGENT); }
__device__ __forceinline__ unsigned xb_xcc_id() { return (unsigned)__builtin_amdgcn_s_getreg((3 << 11) | 20) & 0xFu; }
#define XB_SPIN(cond, bar) do { unsigned _sp = 0; while (cond) { __builtin_amdgcn_s_sleep(1); \
    if ((++_sp & 255u) == 0u) { if (xb_ld(&(bar)[XB_TMO])) break; if (_sp > XB_SPIN_CAP) { atomicAdd(&(bar)[XB_TMO], 1u); break; } } } } while (0)

struct XcdBarrier {
    unsigned* bar; unsigned x;
    volatile LAS unsigned* st;
};

__device__ __forceinline__ XcdBarrier xcd_barrier_post(unsigned* bar, volatile LAS unsigned* st) {
    XcdBarrier b; b.bar = bar; b.x = xb_xcc_id(); b.st = st;
    if (threadIdx.x == 0) (void)xb_add(&bar[XB_XCNT(b.x)], 1u);
    return b;
}
__device__ __forceinline__ void xcd_barrier_complete(unsigned* bar, unsigned x, unsigned& nloc, unsigned& nx) {
    const unsigned G = gridDim.x * gridDim.y * gridDim.z;
    unsigned sum, cnt, mine, sp = 0u;
    for (;;) {
        sum = 0u; cnt = 0u; mine = 0u;
#pragma unroll
        for (unsigned j = 0; j < 16; ++j) { const unsigned c = xb_ld(&bar[XB_XCNT(j)]); sum += c; cnt += (c > 0u) ? 1u : 0u; mine = (j == x) ? c : mine; }
        if (sum == G) break;
        __builtin_amdgcn_s_sleep(1);
        if ((++sp & 255u) == 0u) { if (xb_ld(&bar[XB_TMO])) break; if (sp > XB_SPIN_CAP) { atomicAdd(&bar[XB_TMO], 1u); break; } }
    }
    nloc = mine > 0u ? mine : 1u; nx = cnt > 0u ? cnt : 1u;
}

__device__ __forceinline__ void xcd_barrier(const XcdBarrier& b) {
    asm volatile("s_waitcnt vmcnt(0)" ::: "memory");
    __syncthreads();
    if (threadIdx.x == 0) {
        unsigned* bar = b.bar;
        __builtin_amdgcn_s_waitcnt(0);
        unsigned nloc = b.st[0], nx = b.st[1];
        if (nloc == 0u) { xcd_barrier_complete(bar, b.x, nloc, nx); b.st[0] = nloc; b.st[1] = nx; }
        const unsigned old = xb_add(&bar[XB_XSUB(b.x)], 1u);
        const unsigned gen = old / nloc;
        if (old + 1u == (gen + 1u) * nloc) {
            __builtin_amdgcn_fence(__ATOMIC_RELEASE, "agent");
            asm volatile("s_waitcnt vmcnt(0)" ::: "memory");
            const unsigned og = xb_add(&bar[XB_TOP], 1u);
            const unsigned tg = og / nx;
            if (og + 1u == (tg + 1u) * nx) xb_add(&bar[XB_TOPGEN], 1u);
            else XB_SPIN(xb_ld(&bar[XB_TOPGEN]) == tg, bar);
            __builtin_amdgcn_fence(__ATOMIC_ACQUIRE, "agent");
            xb_add(&bar[XB_XGEN(b.x)], 1u);
            asm volatile("s_waitcnt vmcnt(0)" ::: "memory");
        } else {
            XB_SPIN(xb_ld(&bar[XB_XGEN(b.x)]) == gen, bar);
            __builtin_amdgcn_fence(__ATOMIC_ACQUIRE, "agent");
            asm volatile("s_waitcnt vmcnt(0)" ::: "memory");
        }
    }
    __syncthreads();
}
typedef const Args __attribute__((address_space(4)))* ArgsP;
DEVI ArgsP argsp() { ArgsP p = (ArgsP)__builtin_amdgcn_kernarg_segment_ptr(); asm volatile("" : "+s"(p)); return p; }
DEVI int wave_id() { int t = threadIdx.x; asm volatile("" : "+v"(t)); return __builtin_amdgcn_readfirstlane(t >> 6); }
DEVI int lane_id() { int t = threadIdx.x; asm volatile("" : "+v"(t)); return t & 63; }
#define AIN(k) (argsp()->in[k])
#define WSP(off) (argsp()->ws + (off))
#define Wt ((bf16_t*)WSP(WS_W))
#define S5A ((float*)WSP(WS_TAB + TAB_S5A))
#define S5B ((float*)WSP(WS_TAB + TAB_S5B))
#define ROPE ((float*)WSP(WS_TAB + TAB_ROPE))
#define LBT ((float*)WSP(WS_TAB + TAB_LB))
#define XK ((bf16_t*)WSP(WS_XK))
#define XVT ((bf16_t*)WSP(WS_XVT))
#define ACT1 ((bf16_t*)WSP(WS_ACT1))
#define PROJ ((bf16_t*)WSP(WS_PROJ))
#define VTA ((bf16_t*)WSP(WS_VTA))
#define HB ((bf16_t*)WSP(WS_HB))
#define ODB ((bf16_t*)WSP(WS_ODB))
#define S5F ((float*)WSP(WS_S5F))
#define HF ((float*)WSP(WS_HF))
#define HD ((float*)WSP(WS_HD))
#define MN ((bf16_t*)WSP(WS_MN))
#define XQ ((bf16_t*)WSP(WS_XQ))
#define XO ((bf16_t*)WSP(WS_XO))
#define GB ((bf16_t*)WSP(WS_G))
#define HH ((bf16_t*)WSP(WS_H))
#define SSQ ((float*)WSP(WS_SS))
#define X (argsp()->out)
#define GRIDN (argsp()->grid)
#define WCTX const int lane = lane_id(), wave = wave_id(), G = GRIDN, gw = (int)blockIdx.x * NWAVES + wave, NGW = G * NWAVES; unsigned char* wl = lds + wave * WLDS; (void)lane; (void)gw; (void)NGW; (void)wl
#define SYNC_CG() cg::this_grid().sync()
#define SYNC() do { XcdBarrier b_; b_.bar = (unsigned*)WSP(4096); b_.x = xb_xcc_id(); b_.st = (volatile LAS unsigned*)(lds + 131072); xcd_barrier(b_); } while (0)
#ifndef REP_GEMM
#define REP_GEMM 1
#endif
#ifndef REP_GQA
#define REP_GQA 1
#endif
#ifndef REP_XA
#define REP_XA 1
#endif
#ifndef REP_S5
#define REP_S5 1
#endif
#ifndef REP_HG
#define REP_HG 1
#endif
#ifndef REP_NA
#define REP_NA 1
#endif
#define GEMM_CALL(EPI, KC_, g_, S_, E_) pg8::gemm_phase<EPI, pg8::StaticOrder, true, true, KC_>((PG8_LAS unsigned char*)lds, g_, S_, E_)
#define GEMM_CALL_LDA(EPI, KC_, LDA_, g_, S_, E_) pg8::gemm_phase<EPI, pg8::StaticOrder, true, true, KC_, LDA_>((PG8_LAS unsigned char*)lds, g_, S_, E_)
#define WL_(l) (Wt + (size_t)(l) * W_LAYER)
__global__ void __launch_bounds__(NWAVES * 64, 2) fwd_mega(Args a_unused) {
    extern __shared__ __attribute__((aligned(16))) unsigned char lds[];
    if (threadIdx.x < 64) ((volatile LAS unsigned*)(lds + 131072))[threadIdx.x] = 0u;
    __syncthreads();
    (void)xcd_barrier_post((unsigned*)WSP(4096), (volatile LAS unsigned*)(lds + 131072));
    {
        WCTX; float* scr = (float*)wl;
        for (int l = 0; l < 2; ++l) {
            bf16_t* wl_ = WL_(l);
            constexpr int I0 = 16 * 88, I1 = I0 + 16 * 32, I2 = I1 + 16 * 8, I3 = I2 + 16 * 16, I4 = I3 + 4 * 32, I5 = I4 + 16 * 176, I6 = I5 + 44 * 32, I7 = I6 + 4 * 8;
            for (int it = gw; it < I7; it += NGW) {
                if (it < I0) transpose_item(AIN(5) + (size_t)l * 1024 * 2816, 1024, 2816, wl_ + W_IN, scr, it, lane, AIN(4) + l * 1024);
                else if (it < I1) transpose_item(AIN(21) + (size_t)l * 1024 * 1024, 1024, 1024, wl_ + W_OUT, scr, it - I0, lane);
                else if (it < I2) transpose_item(AIN(24) + (size_t)l * 1024 * 256, 1024, 256, wl_ + W_Q, scr, it - I1, lane, AIN(22) + l * 1024);
                else if (it < I3) transpose_item(AIN(25) + (size_t)l * 1024 * 512, 1024, 512, wl_ + W_KV, scr, it - I2, lane);
                else if (it < I4) transpose_item(AIN(26) + (size_t)l * 256 * 1024, 256, 1024, wl_ + W_O, scr, it - I3, lane);
                else if (it < I5) transpose_item(AIN(28) + (size_t)l * 1024 * 5632, 1024, 5632, wl_ + W_UP, scr, it - I4, lane, AIN(27) + l * 1024);
                else if (it < I6) transpose_item(AIN(31) + (size_t)l * 2816 * 1024, 2816, 1024, wl_ + W_DN, scr, it - I5, lane);
                else transpose_item(AIN(15) + (size_t)l * 256 * 256, 256, 256, wl_ + W_GLU, scr, it - I6, lane);
            }
        }
        const int gt = (int)blockIdx.x * (NWAVES * 64) + (int)threadIdx.x, NGT = G * NWAVES * 64;
        for (int idx = gt; idx < 4096; idx += NGT) {
            const int ldg = idx >> 6;
            const double lre = fmin((double)AIN(7)[idx], -1e-4), lim = (double)AIN(8)[idx], dt = exp((double)AIN(9)[ldg]);
            const double mag = exp(lre * dt), are = mag * cos(lim * dt), aim = mag * sin(lim * dt);
            const double mag2 = exp(lre * dt * 128.0), pre = mag2 * cos(lim * dt * 128.0), pim = mag2 * sin(lim * dt * 128.0);
            const double den = lre * lre + lim * lim, nre = are - 1.0, nim = aim;
            const double cr = (nre * lre + nim * lim) / den, ci = (nim * lre - nre * lim) / den;
            float* sa = S5A; float* sb = S5B;
            sa[idx * 4 + 0] = (float)are; sa[idx * 4 + 1] = (float)aim; sa[idx * 4 + 2] = (float)pre; sa[idx * 4 + 3] = (float)pim;
            for (int c = 0; c < 16; ++c) { const double br = (double)AIN(10)[(size_t)idx * 16 + c], bi = (double)AIN(11)[(size_t)idx * 16 + c];
                sb[(size_t)idx * 32 + c] = (float)(cr * br - ci * bi); sb[(size_t)idx * 32 + 16 + c] = (float)(cr * bi + ci * br); }
        }
        for (int idx = gt; idx < 4096; idx += NGT) {
            const int p = idx >> 4, f = idx & 15; const float inv = (float)exp(-(double)f * (log(10000.0) / 16.0)); const float ang = (float)p * inv;
            float* rp = ROPE; rp[idx * 2] = (float)cos((double)ang); rp[idx * 2 + 1] = (float)sin((double)ang);
        }
        for (int idx = gt; idx < 512; idx += NGT) {
            const int c = idx & 255; const float p0 = AIN(19)[c], p1 = AIN(19)[256 + c];
            LBT[idx] = idx < 256 ? 0.f : 1.0f / (1.0f + __expf(p1 - p0));
        }
        for (int r = gw; r < 2 * MEMROWS; r += NGW) {
            const int l = r / MEMROWS, row = r % MEMROWS;
            const float* src = row < 8192 ? AIN(2) + (size_t)row * 1024 : AIN(3) + (size_t)(row - 8192) * 1024;
            norm_row(src, AIN(23) + l * 1024, MN + (size_t)r * 1024, nullptr, lane);
        }
        for (int r = gw; r < T; r += 2 * NGW) {
            const int r2 = r + NGW < T ? r + NGW : r;
            const float* s0 = r < TP ? AIN(0) + (size_t)r * 1024 : AIN(1) + (size_t)(r - TP) * 1024; const float* s1 = r2 < TP ? AIN(0) + (size_t)r2 * 1024 : AIN(1) + (size_t)(r2 - TP) * 1024;
            copy_rows2(s0, s1, ACT1 + (size_t)r * 1024, ACT1 + (size_t)r2 * 1024, SSQ + (size_t)r * 16, SSQ + (size_t)r2 * 16, lane);
        }
    }
    SYNC_CG();
    for (int l = 0; l < 2; ++l) {
        pg8::Gemm g{MN + (size_t)l * MEMROWS * 1024, WL_(l) + W_KV, MEMROWS, 512, 1024}; pg8::StaticOrder S; S.init(MEMROWS, 512, GRIDN, (int)blockIdx.x);
        EpiStore E{XK + (size_t)l * XK_LAYER, 256, 1, XVT + (size_t)l * XK_LAYER, 256, 65536, 8, nullptr};
        GEMM_CALL(EpiStore, 1024, g, S, E);
    }
    SYNC();
    for (int l = 0; l < 2; ++l) {
        {
            pg8::Gemm g{ACT1, WL_(l) + W_IN, T, INW, 1024}; EpiStore E{PROJ, INW, 2, VTA, 64, 16384, 6, SSQ}; pg8::StaticOrder S; S.init(T, INW, GRIDN, (int)blockIdx.x);
            for (int rep = 0; rep < REP_GEMM; ++rep) GEMM_CALL(EpiStore, 1024, g, S, E);
        }
        SYNC();
        {
            WCTX;
            qk_prep(PROJ, AIN(17) + l * 64, AIN(18) + l * 64, ROPE, gw, NGW, lane);
            for (int rep = 0; rep < REP_S5; ++rep) s5_pass1(PROJ, S5A, S5B, S5F, l, wl, gw, NGW, lane);
            for (int rep = 0; rep < REP_HG; ++rep) hgrn_pass<1>(PROJ, LBT, HF, HD, nullptr, (LAS unsigned char*)lds + wave * WLDS, l, wl, gw, NGW, lane);
#if REP_NA > 1
#define ATTN_NA attn256<NaGeom, true, false>
            for (int w = gw; w < (T / 16) * 4; w += NGW) {
                const int h = w & 3, blk = w >> 2, tok0 = blk * 16; int ss, sl; seq_of(tok0, ss, sl);
                const int pos = tok0 - ss, r = pos >> 6, cb = (pos & 63) >> 4, rows = sl >> 6;
                NaGeom ng; ng.proj = PROJ; ng.vta = VTA; ng.rpb = AIN(6) + (size_t)l * 4 * 15 * 31; ng.seq_start = ss; ng.r = r; ng.r0 = min(max(r - 4, 0), rows - 8);
                ng.qs = cb * 16; ng.ks = min(max(cb * 16 - 8, 0), 32); ng.h = h; ng.fr = lane & 15; ng.fq = lane >> 4;
                const size_t qtok = (size_t)tok0 + (lane & 15);
                ATTN_NA(ng.proj + qtok * INW + h * 64, ng, PROJ + qtok * INW + h * 64, 0.125f * LOG2E, lane);
            }
#undef ATTN_NA
#endif
#define ATTN_NA attn256<NaGeom, true, true>
            for (int w = gw; w < (T / 16) * 4; w += NGW) {
                const int h = w & 3, blk = w >> 2, tok0 = blk * 16; int ss, sl; seq_of(tok0, ss, sl);
                const int pos = tok0 - ss, r = pos >> 6, cb = (pos & 63) >> 4, rows = sl >> 6;
                NaGeom ng; ng.proj = PROJ; ng.vta = VTA; ng.rpb = AIN(6) + (size_t)l * 4 * 15 * 31; ng.seq_start = ss; ng.r = r; ng.r0 = min(max(r - 4, 0), rows - 8);
                ng.qs = cb * 16; ng.ks = min(max(cb * 16 - 8, 0), 32); ng.h = h; ng.fr = lane & 15; ng.fq = lane >> 4;
                const size_t qtok = (size_t)tok0 + (lane & 15);
                ATTN_NA(ng.proj + qtok * INW + h * 64, ng, PROJ + qtok * INW + h * 64, 0.125f * LOG2E, lane);
            }
#undef ATTN_NA
        }
        SYNC();
        {
            {
                const int G = GRIDN, bx = (int)blockIdx.x, wave = wave_id();
                const int vcu = (G % 8 == 0) ? (bx % 8) * (G / 8) + bx / 8 : bx;
                const int nun = (G == 256) ? 6 : (1536 + G - 1) / G;
                for (int ui = 0; ui < nun; ++ui) {
                    int sq, hh, qb;
                    if (G == 256) {
                        if (ui < 2) { const int grp = vcu >> 6; sq = 32 + (grp >> 1); hh = (grp & 1) * 2 + ui; qb = vcu & 63; }
                        else { const int pg = vcu >> 2, uu = (vcu & 3) * 4 + (ui - 2); sq = pg >> 1; hh = (pg & 1) * 2 + (uu >> 3); qb = uu & 7; }
                    } else {
                        const int idx = ui * G + bx; if (idx >= 1536) break;
                        if (idx < 512) { sq = 32 + (idx >> 8); hh = (idx >> 6) & 3; qb = idx & 63; } else { const int j = idx - 512; sq = j >> 5; hh = (j >> 3) & 3; qb = j & 7; }
                    }
                    const int ss = sq < 32 ? sq * 2048 : TP + (sq - 32) * 16384, sl = sq < 32 ? 2048 : 16384;
                    const size_t qrow = (size_t)ss + qb * 256 + wave * 32;
                    const bf16_t* pj = PROJ;
#if REP_GQA > 1
                    attn_body::attn_unit<8, false>(sl / 64, (const attn_body::bf16*)(pj + qrow * INW + 1024 + hh * 64), (const attn_body::bf16*)(pj + (size_t)ss * INW + 1280 + (hh >> 1) * 64),
                                            (const attn_body::bf16*)(pj + (size_t)ss * INW + 1408 + (hh >> 1) * 64), (attn_body::bf16*)(PROJ + qrow * INW + 1024 + hh * 64), (char*)lds);
#endif
                    attn_body::attn_unit<8>(sl / 64, (const attn_body::bf16*)(pj + qrow * INW + 1024 + hh * 64), (const attn_body::bf16*)(pj + (size_t)ss * INW + 1280 + (hh >> 1) * 64),
                                            (const attn_body::bf16*)(pj + (size_t)ss * INW + 1408 + (hh >> 1) * 64), (attn_body::bf16*)(PROJ + qrow * INW + 1024 + hh * 64), (char*)lds);
                }
            }
            __syncthreads();
            WCTX;
            for (int rep = 0; rep < REP_S5; ++rep) s5_pass2(PROJ, S5A, S5B, S5F, AIN(12), AIN(13), AIN(14) + l * 256, HB, l, wl, gw, NGW, lane);
            hgrn_chain(HF, HD, gw, NGW, lane);
        }
        SYNC();
        {
            { const int G = GRIDN, bx = (int)blockIdx.x; const bool split = (G == 256);
              pg8::Gemm g{HB, WL_(l) + W_GLU, T, 256, 256}; pg8::StaticOrder S; S.init(T, 256, split ? 64 : G, split ? (bx >= 192 ? bx - 192 : 0x3fffffff) : bx); EpiGlu E{HB, PROJ, AIN(16) + l * 256}; GEMM_CALL(EpiGlu, 256, g, S, E); }
            __syncthreads();
            WCTX;
            for (int rep = 0; rep < REP_HG; ++rep) hgrn_pass<2>(PROJ, LBT, HF, HD, PROJ, (LAS unsigned char*)lds + wave * WLDS, l, wl, gw, NGW, lane);
        }
        SYNC();
        { WCTX; merge_norm(PROJ, AIN(20) + l * 1024, gw, NGW, lane); }
        SYNC();
        { pg8::Gemm g{PROJ, WL_(l) + W_OUT, T, 1024, 1024}; EpiRes E{X, ACT1, SSQ, l == 0 ? AIN(0) : (const float*)X, l == 0 ? AIN(1) : (const float*)X + (size_t)TP * 1024, TP}; pg8::StaticOrder S; S.init(T, 1024, GRIDN, (int)blockIdx.x); GEMM_CALL_LDA(EpiRes, 1024, 2816, g, S, E); }
        SYNC();
        { pg8::Gemm g{ACT1, WL_(l) + W_Q, T, 256, 1024}; EpiStore E{XQ, 256, -1, nullptr, 0, 0, 0, SSQ}; pg8::StaticOrder S; S.init(T, 256, GRIDN, (int)blockIdx.x); GEMM_CALL(EpiStore, 1024, g, S, E); }
        SYNC();
        {
            WCTX;
            for (int rep = 0; rep < REP_XA; ++rep)
            for (int uidx = (int)blockIdx.x; uidx < 192; uidx += G) {
                const int h = uidx & 3, seg = uidx >> 2, tokS = seg * 2048, b = batch_of(tokS); int tid = (int)threadIdx.x; asm volatile("" : "+v"(tid));
                bf16_t* Kl = (bf16_t*)lds; bf16_t* VTl = (bf16_t*)(lds + 36864);
                const bf16_t* xk = XK + (size_t)l * XK_LAYER + (size_t)b * 65536 + h * 64;
                const bf16_t* xv = XVT + (size_t)l * XK_LAYER + ((size_t)b * 256 + h * 64) * 256;
#pragma unroll
                for (int i = tid; i < 2048; i += 512) { const int key = i >> 3, ch = i & 7; *(u32x4*)(Kl + key * 72 + ch * 8) = *(const u32x4*)(xk + (size_t)key * 256 + ch * 8); }
#pragma unroll
                for (int i = tid; i < 2048; i += 512) { const int d = i >> 5, ch = i & 31; *(u32x4*)(VTl + d * 264 + ch * 8) = *(const u32x4*)(xv + (size_t)d * 256 + ch * 8); }
                __syncthreads();
                XaGeomL xg; xg.kl = Kl; xg.vtl = VTl; xg.fr = lane & 15; xg.fq = lane >> 4;
                for (int t = wave; t < 128; t += NWAVES) { const size_t qt = (size_t)tokS + t * 16 + (lane & 15);
                    attn256<XaGeomL, false>(XQ + qt * 256 + h * 64, xg, XO + qt * 256 + h * 64, 0.125f * LOG2E, lane); }
                __syncthreads();
            }
        }
        SYNC();
        { pg8::Gemm g{XO, WL_(l) + W_O, T, 1024, 256}; EpiRes E{X, ACT1, SSQ, X, X, 0x7fffffff}; pg8::StaticOrder S; S.init(T, 1024, GRIDN, (int)blockIdx.x); GEMM_CALL(EpiRes, 256, g, S, E); }
        SYNC();
        for (int chunk = 0; chunk < 2; ++chunk) {
            { const int c_row0 = chunk ? TP : 0, c_rows = chunk ? (T - TP) : TP;
              pg8::Gemm g{ACT1 + (size_t)c_row0 * 1024, WL_(l) + W_UP + (size_t)DFF * 1024, c_rows, DFF, 1024}; EpiStore E{GB, DFF, -1, nullptr, 0, 0, 0, SSQ + (size_t)c_row0 * 16}; pg8::StaticOrder S; S.init(c_rows, DFF, GRIDN, (int)blockIdx.x);
              for (int rep = 0; rep < REP_GEMM; ++rep) GEMM_CALL(EpiStore, 1024, g, S, E); }
            SYNC();
            { const int c_row0 = chunk ? TP : 0, c_rows = chunk ? (T - TP) : TP;
              pg8::Gemm g{ACT1 + (size_t)c_row0 * 1024, WL_(l) + W_UP, c_rows, DFF, 1024}; pg8::StaticOrder S; S.init(c_rows, DFF, GRIDN, (int)blockIdx.x);
              EpiConv E{GB, HH, AIN(29) + (size_t)l * 3 * DFF, AIN(30) + (size_t)l * DFF, c_row0, SSQ + (size_t)c_row0 * 16};
              for (int rep = 0; rep < REP_GEMM; ++rep) GEMM_CALL(EpiConv, 1024, g, S, E); }
            SYNC();
            { const int c_row0 = chunk ? TP : 0, c_rows = chunk ? (T - TP) : TP;
              pg8::Gemm g{HH, WL_(l) + W_DN, c_rows, 1024, DFF}; EpiRes E{X + (size_t)c_row0 * 1024, ACT1 + (size_t)c_row0 * 1024, SSQ + (size_t)c_row0 * 16, X + (size_t)c_row0 * 1024, X, 0x7fffffff}; pg8::StaticOrder S; S.init(c_rows, 1024, GRIDN, (int)blockIdx.x); GEMM_CALL(EpiRes, 2816, g, S, E); }
            SYNC();
        }
        if (l == 1) { WCTX; for (int r = gw; r < T; r += 2 * NGW) { const int r1 = r + NGW < T ? r + NGW : r; if (r1 != r) final_norm_rows2(X + (size_t)r * 1024, X + (size_t)r1 * 1024, AIN(32), lane); else final_norm_rows2(X + (size_t)r * 1024, X + (size_t)r * 1024, AIN(32), lane); } }
    }
}

extern "C" void kernel_launch(void* const* d_in, const int* in_sizes, int n_in, void* d_out, int out_size, void* d_ws, size_t ws_size, hipStream_t stream) {
    static int grid = 0;
    if (grid == 0) {
        if (n_in != 33 || out_size != T * DM || ws_size < WS_END) { fprintf(stderr, "kernel_launch: unexpected shapes (n_in %d out %d ws %zu, need %zu)\n", n_in, out_size, ws_size, (size_t)WS_END); grid = -1; return; }
        int dev = 0, cus = 0, per_cu = 0;
        hipGetDevice(&dev); hipDeviceGetAttribute(&cus, hipDeviceAttributeMultiprocessorCount, dev);
        if (hipFuncSetAttribute((const void*)fwd_mega, hipFuncAttributeMaxDynamicSharedMemorySize, LDS_BYTES) != hipSuccess) { fprintf(stderr, "kernel_launch: hipFuncSetAttribute failed\n"); grid = -1; return; }
        hipOccupancyMaxActiveBlocksPerMultiprocessor(&per_cu, (const void*)fwd_mega, NWAVES * 64, LDS_BYTES);
        (void)hipGetLastError();
        if (per_cu < 1) per_cu = 1;
        grid = cus * 1;
        fprintf(stderr, "kernel_launch: cus %d per_cu %d grid %d\n", cus, per_cu, grid);
    }
    if (grid < 0) return;
    if (hipMemsetAsync(d_ws, 0, 65536, stream) != hipSuccess) { fprintf(stderr, "kernel_launch: memset failed\n"); return; }
    Args a{};
    for (int i = 0; i < 33; ++i) a.in[i] = (const float*)d_in[i];
    a.out = (float*)d_out; a.ws = (unsigned char*)d_ws; a.grid = grid; a.pad = 0;
    void* args[] = {&a};
    hipError_t e = hipLaunchCooperativeKernel((const void*)fwd_mega, dim3(grid), dim3(NWAVES * 64), args, LDS_BYTES, stream);
    if (e != hipSuccess) fprintf(stderr, "kernel_launch: cooperative launch failed: %s (grid %d)\n", hipGetErrorString(e), grid);
}
```

```cpp
#include <hip/hip_runtime.h>
#include <hip/hip_cooperative_groups.h>
#include <hip/hip_bf16.h>
#include <cstdio>
#include <cstdint>
#include <cmath>
namespace cg = cooperative_groups;
namespace pg8 {
#define PG8_LAS __attribute__((address_space(3)))
typedef unsigned short bf16_t;
typedef short bf16x8 __attribute__((ext_vector_type(8)));
typedef float f32x4 __attribute__((ext_vector_type(4)));
typedef unsigned u32x4 __attribute__((ext_vector_type(4)));
constexpr int BM = 256, BK = 64, HALF = 128, HTB = HALF * BK * 2  , STAGE_BYTES = 8 * HTB, NXCD = 8, WGM = 8;

__host__ __device__ __forceinline__ int lds_byte(int r, int c) { const int st = (r >> 4) * 2 + (c >> 5), rr = r & 15, cc = c & 31, ob = rr * 64 + cc * 2; return st * 1024 + (ob ^ (((ob >> 9) & 1) << 5)); }
__host__ __device__ __forceinline__ void stage_rc(int b, int& R, int& C) { const int st = b / 1024, sb = b % 1024, swz = sb ^ (((sb >> 9) & 1) << 5); R = (st >> 1) * 16 + swz / 64; C = (st & 1) * 32 + (swz % 64) / 2; }
__host__ __device__ __forceinline__ int perm32(int rho) { const int n = rho >> 4, i = rho & 15; return 8 * (i >> 2) + 4 * n + (i & 3); }

struct Unit { int pm, pn; };
struct Gemm { const bf16_t* A; const bf16_t* Bt; int M, N, K; };

struct StaticOrder {
    int nM, nN, nwg, G, c;
    __host__ __device__ void init(int M, int N, int G_, int c_) { nM = M / BM; nN = N / BM; nwg = nM * nN; G = G_; c = c_; }
    __host__ __device__ bool next(int i, Unit& u) const {
        const long L = (long)i * G + c; if (L >= nwg) return false;
        int wgid = (int)L; { const int q = nwg / NXCD, r = nwg % NXCD, xcd = wgid % NXCD, off = wgid / NXCD; wgid = (xcd < r ? xcd * (q + 1) : r * (q + 1) + (xcd - r) * q) + off; }
        const int nig = WGM * nN, gid = wgid / nig, fm = gid * WGM, gsz = (nM - fm) < WGM ? (nM - fm) : WGM;
        u.pm = fm + ((wgid % nig) % gsz); u.pn = (wgid % nig) / gsz; return true;
    }
    __device__ __forceinline__ void a_ready(const Unit&) const {}
    __device__ __forceinline__ void done(const Unit&) const {}
};

__device__ __forceinline__ unsigned cvt_pk_bf16(float lo, float hi) { typedef float f2_t __attribute__((ext_vector_type(2))); typedef __bf16 b2_t __attribute__((ext_vector_type(2))); f2_t v = {lo, hi}; b2_t b = __builtin_convertvector(v, b2_t); return __builtin_bit_cast(unsigned, b); }
template <class Epi, class Sched, bool ALIGN_EPI, bool SP2, int KC, int LDA = KC>
__device__ __forceinline__ void gemm_phase(PG8_LAS unsigned char* lds, const Gemm g, const Sched& S, const Epi& E) {
    int tid_ = threadIdx.x; asm volatile("" : "+v"(tid_)); const int tid = tid_, wid = __builtin_amdgcn_readfirstlane(tid >> 6), lane = tid & 63, wr = wid >> 2, wc = wid & 3, fr = lane & 15, fq = lane >> 4;
    constexpr int K = KC, nt = K / BK;
    unsigned voffA[2], voffB[2];
#pragma unroll
    for (int i = 0; i < 2; ++i) { int R, C; stage_rc(tid * 16 + i * 8192, R, C); const int Rb = Epi::PERM ? ((R & ~31) + perm32(R & 31)) : R;
        voffA[i] = (unsigned)(R * LDA + C) * 2u; voffB[i] = (unsigned)(Rb * K + C) * 2u; }
    const size_t kstep = (size_t)(BK * 2);
    const size_t hstep = (size_t)HALF * K * 2;
    const size_t tstep = 2 * hstep; const size_t hstepA = (size_t)HALF * LDA * 2, tstepA = 2 * hstepA;
    const unsigned ldsw = (unsigned)wid * 1024u;
    const int aoff = lds_byte(wr * 64 + fr, fq * 8), boff = lds_byte(wc * 32 + fr, fq * 8);
#define PG8_SA(b, h) (((b) * 2 + (h)) * HTB)
#define PG8_SB(b, h) ((4 + (b) * 2 + (h)) * HTB)
#define PG8_STAGE(bufoff, gbase, voff) do { _Pragma("unroll") for (int _i = 0; _i < 2; ++_i) \
        __builtin_amdgcn_global_load_lds((const unsigned*)((const char*)(gbase) + (voff)[_i]), (PG8_LAS unsigned*)(lds + (bufoff) + ldsw + _i * 8192), 16, 0, 0); } while (0)
#define PG8_LDA(dst, b, h) do { _Pragma("unroll") for (int m = 0; m < 4; ++m) _Pragma("unroll") for (int k = 0; k < 2; ++k) dst[m][k] = *(const PG8_LAS bf16x8*)(lds + PG8_SA(b, h) + aoff + m * 2048 + k * 1024); } while (0)
#define PG8_LDB(dst, b, h) do { _Pragma("unroll") for (int n = 0; n < 2; ++n) _Pragma("unroll") for (int k = 0; k < 2; ++k) dst[n][k] = *(const PG8_LAS bf16x8*)(lds + PG8_SB(b, h) + boff + n * 2048 + k * 1024); } while (0)
#define PG8_MMA(ai, bj, At, Bt) do { __builtin_amdgcn_s_setprio(1); _Pragma("unroll") for (int m = 0; m < 4; ++m) _Pragma("unroll") for (int n = 0; n < 2; ++n) _Pragma("unroll") for (int k = 0; k < 2; ++k) \
        acc[ai][bj][m][n] = __builtin_amdgcn_mfma_f32_16x16x32_bf16(Bt[n][k], At[m][k], acc[ai][bj][m][n], 0, 0, 0); __builtin_amdgcn_s_setprio(0); } while (0)
#define PG8_WAIT_V(n) asm volatile("s_waitcnt vmcnt(" #n ")" ::: "memory")
#define PG8_WAIT_L(n) asm volatile("s_waitcnt lgkmcnt(" #n ")" ::: "memory")
#define PG8_BAR __builtin_amdgcn_s_barrier()
#define PG8_SCHED __builtin_amdgcn_sched_barrier(0)
    Unit cur, nxt; int ui = 0;
    if (!S.next(0, cur)) return;
    f32x4 acc[2][2][4][2];
#pragma unroll
    for (int a = 0; a < 2; ++a)
#pragma unroll
        for (int b = 0; b < 2; ++b)
#pragma unroll
            for (int m = 0; m < 4; ++m)
#pragma unroll
                for (int n = 0; n < 2; ++n) acc[a][b][m][n] = (f32x4){0.f, 0.f, 0.f, 0.f};
    bf16x8 At[4][2], B0[2][2], B1[2][2];
    const char* cA = (const char*)g.A + (size_t)cur.pm * tstepA; const char* cB = (const char*)g.Bt + (size_t)cur.pn * tstep;
    S.a_ready(cur);
    if constexpr (SP2) {
        PG8_STAGE(PG8_SB(0, 0), cB, voffB); PG8_STAGE(PG8_SB(0, 1), cB + hstep, voffB); PG8_STAGE(PG8_SA(0, 0), cA, voffA); PG8_STAGE(PG8_SA(0, 1), cA + hstepA, voffA);
        if (wr == 1) PG8_BAR;
        PG8_WAIT_V(2); PG8_BAR;
        PG8_STAGE(PG8_SB(1, 0), cB + kstep, voffB); PG8_STAGE(PG8_SA(1, 0), cA + kstep, voffA); PG8_STAGE(PG8_SB(1, 1), cB + hstep + kstep, voffB);
        PG8_WAIT_V(6); PG8_BAR;
    } else {
        PG8_STAGE(PG8_SB(0, 0), cB, voffB); PG8_STAGE(PG8_SA(0, 0), cA, voffA); PG8_STAGE(PG8_SB(0, 1), cB + hstep, voffB); PG8_STAGE(PG8_SA(0, 1), cA + hstepA, voffA);
        if (wr == 1) PG8_BAR;
        PG8_WAIT_V(4); PG8_BAR;
        PG8_STAGE(PG8_SB(1, 0), cB + kstep, voffB); PG8_STAGE(PG8_SA(1, 0), cA + kstep, voffA); PG8_STAGE(PG8_SB(1, 1), cB + hstep + kstep, voffB);
        PG8_WAIT_V(6); PG8_BAR;
    }
    for (;;) {
        const bool has_next = S.next(ui + 1, nxt);
        const char* nA = has_next ? (const char*)g.A + (size_t)nxt.pm * tstepA : cA; const char* nB = has_next ? (const char*)g.Bt + (size_t)nxt.pn * tstep : cB;
#pragma nounroll
        for (int t = 0; t < nt; t += 2) {
            const bool last = (t == nt - 2);
            const char* a1 = cA + (size_t)(t + 1) * kstep;
            const char* a2 = last ? nA : cA + (size_t)(t + 2) * kstep; const char* b2 = last ? nB : cB + (size_t)(t + 2) * kstep;
            const char* a3 = a2 + kstep; const char* b3 = b2 + kstep;
            if (last && has_next) S.a_ready(nxt);
            if constexpr (SP2) {
            PG8_LDB(B0, 0, 0); PG8_LDB(B1, 0, 1); PG8_SCHED; PG8_LDA(At, 0, 0); PG8_STAGE(PG8_SA(1, 1), a1 + hstepA, voffA);
            PG8_WAIT_V(8); PG8_WAIT_L(0); PG8_BAR; PG8_MMA(0, 0, At, B0); PG8_MMA(0, 1, At, B1); PG8_BAR; PG8_SCHED;
            PG8_LDA(At, 0, 1); PG8_STAGE(PG8_SB(0, 0), b2, voffB); PG8_STAGE(PG8_SB(0, 1), b2 + hstep, voffB); PG8_STAGE(PG8_SA(0, 0), a2, voffA);
            PG8_WAIT_V(8); PG8_WAIT_L(0); PG8_BAR; PG8_MMA(1, 0, At, B0); PG8_MMA(1, 1, At, B1); PG8_BAR; PG8_SCHED;
            PG8_LDB(B0, 1, 0); PG8_LDB(B1, 1, 1); PG8_SCHED; PG8_LDA(At, 1, 0); PG8_STAGE(PG8_SA(0, 1), a2 + hstepA, voffA);
            PG8_WAIT_V(8); PG8_WAIT_L(0); PG8_BAR; PG8_MMA(0, 0, At, B0); PG8_MMA(0, 1, At, B1); PG8_BAR; PG8_SCHED;
            PG8_LDA(At, 1, 1); PG8_STAGE(PG8_SB(1, 0), b3, voffB); PG8_STAGE(PG8_SB(1, 1), b3 + hstep, voffB); PG8_STAGE(PG8_SA(1, 0), a3, voffA);
            PG8_WAIT_V(8); PG8_WAIT_L(0); PG8_BAR; PG8_MMA(1, 0, At, B0); PG8_MMA(1, 1, At, B1); PG8_BAR; PG8_SCHED;
            } else {
            PG8_LDB(B0, 0, 0); PG8_SCHED; PG8_LDA(At, 0, 0); PG8_STAGE(PG8_SA(1, 1), a1 + hstepA, voffA);
            PG8_WAIT_L(8); PG8_BAR; PG8_WAIT_L(0); PG8_MMA(0, 0, At, B0); PG8_BAR; PG8_SCHED;
            PG8_LDB(B1, 0, 1); PG8_STAGE(PG8_SB(0, 0), b2, voffB);
            PG8_BAR; PG8_WAIT_L(0); PG8_MMA(0, 1, At, B1); PG8_BAR;
            PG8_LDA(At, 0, 1); PG8_STAGE(PG8_SA(0, 0), a2, voffA);
            PG8_BAR; PG8_WAIT_L(0); PG8_MMA(1, 0, At, B0); PG8_BAR; PG8_SCHED;
            PG8_STAGE(PG8_SB(0, 1), b2 + hstep, voffB);
            PG8_WAIT_V(6); PG8_BAR; PG8_MMA(1, 1, At, B1); PG8_BAR;
            PG8_LDB(B0, 1, 0); PG8_SCHED; PG8_LDA(At, 1, 0); PG8_STAGE(PG8_SA(0, 1), a2 + hstepA, voffA);
            PG8_WAIT_L(8); PG8_BAR; PG8_WAIT_L(0); PG8_MMA(0, 0, At, B0); PG8_BAR; PG8_SCHED;
            PG8_LDB(B1, 1, 1); PG8_STAGE(PG8_SB(1, 0), b3, voffB);
            PG8_BAR; PG8_WAIT_L(0); PG8_MMA(0, 1, At, B1); PG8_BAR;
            PG8_LDA(At, 1, 1); PG8_STAGE(PG8_SA(1, 0), a3, voffA);
            PG8_BAR; PG8_WAIT_L(0); PG8_MMA(1, 0, At, B0); PG8_BAR; PG8_SCHED;
            PG8_STAGE(PG8_SB(1, 1), b3 + hstep, voffB);
            PG8_WAIT_V(6); PG8_BAR; PG8_MMA(1, 1, At, B1); PG8_BAR;
            }
        }
        if constexpr (ALIGN_EPI) { if (wr == 0) PG8_BAR; }
        if constexpr (!Epi::AFTER_DRAIN) { E(acc, cur, wr, wc, fr, fq); S.done(cur); }
        if (!has_next) break;
#pragma unroll
        for (int a = 0; a < 2; ++a)
#pragma unroll
            for (int b = 0; b < 2; ++b)
#pragma unroll
                for (int m = 0; m < 4; ++m)
#pragma unroll
                    for (int n = 0; n < 2; ++n) acc[a][b][m][n] = (f32x4){0.f, 0.f, 0.f, 0.f};
        cur = nxt; cA = nA; cB = nB; ++ui;
        if constexpr (ALIGN_EPI) { if (wr == 1) PG8_BAR; }
    }
    PG8_WAIT_V(0);
    if constexpr (!ALIGN_EPI) { if (wr == 0) PG8_BAR; }
    PG8_BAR;
    if constexpr (Epi::AFTER_DRAIN) { E.fused(acc, cur, wr, wc, fr, fq, lds, wid, lane); S.done(cur); }
#undef PG8_SA
#undef PG8_SB
#undef PG8_STAGE
#undef PG8_LDA
#undef PG8_LDB
#undef PG8_MMA
#undef PG8_WAIT_V
#undef PG8_WAIT_L
#undef PG8_BAR
#undef PG8_SCHED
}
}
namespace attn_body {
using bf16=__hip_bfloat16;
using bf16x8=__attribute__((ext_vector_type(8)))short;
using s16x4=__attribute__((ext_vector_type(4)))short;
using f32x16=__attribute__((ext_vector_type(16)))float;
using u32x4=__attribute__((ext_vector_type(4)))unsigned;
constexpr int D=64;
constexpr int NW=8,QBLK=32,QB=QBLK*NW,KVBLK=64;
constexpr int KVP=2816,QP=2816,OP=2816;
__device__ __forceinline__ int crow(int r,int hi){return (r&3)+8*(r>>2)+4*hi;}
#define SBAR() __builtin_amdgcn_sched_barrier(0)
constexpr int NSLOT=3, SLOTB=8192;
constexpr int LDS_K=0, LDS_V=NSLOT*SLOTB, LDS_WS=2*NSLOT*SLOTB, LDS_OST=LDS_WS+NW*64*4, LDS_BYTES=LDS_OST+NW*4096;
constexpr float C2=0.125f*1.4426950408889634f;
__device__ __forceinline__ void glds16(const void*gsrc,unsigned lds_dst){unsigned keep;
  asm volatile("s_mov_b32 %0, m0\n\ts_mov_b32 m0, %2\n\ts_nop 0\n\tglobal_load_lds_dwordx4 %1, off\n\ts_mov_b32 m0, %0":"=&s"(keep):"v"(gsrc),"s"(lds_dst):"memory");}
__device__ __forceinline__ float max3f(float a,float b,float c){float r;asm("v_max3_f32 %0, %1, %2, %3":"=v"(r):"v"(a),"v"(b),"v"(c));return r;}
__device__ __forceinline__ float max2f(float a,float b){float r;asm("v_max_f32_e32 %0, %1, %2":"=v"(r):"v"(a),"v"(b));return r;}
__device__ __forceinline__ float fadd_s(float a,float b){float r;asm("v_add_f32_e32 %0, %1, %2":"=v"(r):"v"(a),"v"(b));return r;}
__device__ __forceinline__ float fsub_s(float a,float b){float r;asm("v_sub_f32_e32 %0, %1, %2":"=v"(r):"v"(a),"v"(b));return r;}
typedef float f32x2_t __attribute__((ext_vector_type(2))); typedef __bf16 bf16x2_t __attribute__((ext_vector_type(2)));
__device__ __forceinline__ unsigned cvtpk_s(float lo,float hi){f32x2_t v={lo,hi};bf16x2_t b=__builtin_convertvector(v,bf16x2_t);return __builtin_bit_cast(unsigned,b);}
#define WAIT_BAR(N) asm volatile("s_waitcnt vmcnt(" #N ") lgkmcnt(0)\n\ts_barrier":::"memory")

__device__ __forceinline__ void qkt(f32x16&p0,f32x16&p1,const char*Kslot,const bf16x8*qr,const f32x16&negm,int r32,int hi){
  const char*kb=Kslot+hi*1024+r32*16;
  #pragma unroll
  for(int d0=0;d0<4;++d0){
    const bf16x8 b0=*reinterpret_cast<const bf16x8*>(kb+d0*2048);
    const bf16x8 b1=*reinterpret_cast<const bf16x8*>(kb+d0*2048+512);
    if(d0==0){p0=__builtin_amdgcn_mfma_f32_32x32x16_bf16(b0,qr[0],negm,0,0,0);p1=__builtin_amdgcn_mfma_f32_32x32x16_bf16(b1,qr[0],negm,0,0,0);}
    else{p0=__builtin_amdgcn_mfma_f32_32x32x16_bf16(b0,qr[d0],p0,0,0,0);p1=__builtin_amdgcn_mfma_f32_32x32x16_bf16(b1,qr[d0],p1,0,0,0);}}
}
typedef __attribute__((address_space(3))) const char* lds_cptr;
typedef short v4i16_t __attribute__((ext_vector_type(4)));
__device__ __forceinline__ void kload8(bf16x8*kf,lds_cptr kp){
  kf[0]=*(const __attribute__((address_space(3))) bf16x8*)(kp);      kf[1]=*(const __attribute__((address_space(3))) bf16x8*)(kp+512);
  kf[2]=*(const __attribute__((address_space(3))) bf16x8*)(kp+2048); kf[3]=*(const __attribute__((address_space(3))) bf16x8*)(kp+2560);
  kf[4]=*(const __attribute__((address_space(3))) bf16x8*)(kp+4096); kf[5]=*(const __attribute__((address_space(3))) bf16x8*)(kp+4608);
  kf[6]=*(const __attribute__((address_space(3))) bf16x8*)(kp+6144); kf[7]=*(const __attribute__((address_space(3))) bf16x8*)(kp+6656);
}
__device__ __forceinline__ void kload2(bf16x8*kf,lds_cptr kp,int j){ kf[2*j]=*(const __attribute__((address_space(3))) bf16x8*)(kp+j*2048); kf[2*j+1]=*(const __attribute__((address_space(3))) bf16x8*)(kp+j*2048+512); }
__device__ __forceinline__ s16x4 vtr(lds_cptr p){ return __builtin_bit_cast(s16x4,__builtin_amdgcn_ds_read_tr16_b64_v4i16((__attribute__((address_space(3))) v4i16_t*)p)); }
__device__ __forceinline__ float rowmax(const f32x16&p0,const f32x16&p1){
  float a=max3f(p0[0],p0[1],p1[0]),b=max3f(p0[2],p0[3],p1[1]);a=max3f(a,p1[2],p1[3]);
  #pragma unroll
  for(int r=4;r<16;r+=4){a=max3f(a,p0[r],p0[r+1]);b=max3f(b,p0[r+2],p0[r+3]);a=max3f(a,p1[r],p1[r+1]);b=max3f(b,p1[r+2],p1[r+3]);}
  const float m=max2f(a,b);
  auto rr=__builtin_amdgcn_permlane32_swap(__float_as_uint(m),__float_as_uint(m),false,false);
  return max2f(__uint_as_float(rr[0]),__uint_as_float(rr[1]));
}
__device__ __forceinline__ void pv(f32x16*o,int vb,bf16x8 pa0,bf16x8 pa1,bf16x8 pa2,bf16x8 pa3){
  #pragma unroll
  for(int d0=0;d0<2;++d0){s16x4 lo[4],hi[4];
    #pragma unroll
    for(int ks=0;ks<4;++ks){
      asm volatile("ds_read_b64_tr_b16 %0,%1 offset:%c2":"=&v"(lo[ks]):"v"(vb),"i"(d0*4096+ks*1024):"memory");
      asm volatile("ds_read_b64_tr_b16 %0,%1 offset:%c2":"=&v"(hi[ks]):"v"(vb),"i"(d0*4096+ks*1024+512):"memory");}
    asm volatile("s_waitcnt lgkmcnt(0)":::"memory");SBAR();
    #define PK(k) (bf16x8){lo[k][0],lo[k][1],lo[k][2],lo[k][3],hi[k][0],hi[k][1],hi[k][2],hi[k][3]}
    o[d0]=__builtin_amdgcn_mfma_f32_32x32x16_bf16(pa0,PK(0),o[d0],0,0,0);
    o[d0]=__builtin_amdgcn_mfma_f32_32x32x16_bf16(pa1,PK(1),o[d0],0,0,0);
    o[d0]=__builtin_amdgcn_mfma_f32_32x32x16_bf16(pa2,PK(2),o[d0],0,0,0);
    o[d0]=__builtin_amdgcn_mfma_f32_32x32x16_bf16(pa3,PK(3),o[d0],0,0,0);
    #undef PK
  }
}
#ifndef ATTN_STORE16
#define ATTN_STORE16(p,v) (*(u32x4*)(p)=(v))
#endif
template<int THRL, bool STORE = true> __device__ __forceinline__ void attn_unit(const int NT,const bf16*Qw,const bf16*__restrict__ Kh,const bf16*__restrict__ Vh,bf16*Ow,char*shm){
  int tid_=threadIdx.x; asm volatile("":"+v"(tid_)); const int tid=tid_,lane=tid&63,r32=lane&31,hi=lane>>5; const int wid=__builtin_amdgcn_readfirstlane(tid>>6);
  const unsigned lds0=(unsigned)(uintptr_t)shm;
  float*wsf=(float*)(shm+LDS_WS)+wid*64;
  const bf16*ksrc=Kh+(long)lane*KVP+wid*8;
  const bf16*vsrc=Vh+(long)(16*(wid&3)+(lane>>2))*KVP+(wid>>2)*32+(lane&3)*8;
  const unsigned kdst=lds0+LDS_K+wid*1024, vdst=lds0+LDS_V+wid*1024;
  #define DMA_K(t,slot) glds16(ksrc+(long)(t)*KVBLK*KVP,(unsigned)__builtin_amdgcn_readfirstlane(kdst+(slot)))
  #define DMA_V(t,slot) glds16(vsrc+(long)(t)*KVBLK*KVP,(unsigned)__builtin_amdgcn_readfirstlane(vdst+(slot)))
  const int vb0=(int)(lds0+LDS_V)+((lane>>4)&1)*32+(lane&3)*8+(4*hi+((lane&15)>>2))*64;
  const char*Kbase=shm+LDS_K; bf16x8 kf[8];
  const lds_cptr shm3=(lds_cptr)shm; const lds_cptr kp0=shm3+LDS_K+hi*1024+r32*16; const lds_cptr vp0=shm3+LDS_V+((lane>>4)&1)*32+(lane&3)*8+(4*hi+((lane&15)>>2))*64;

  DMA_K(0,0);DMA_V(0,0);DMA_K(1,SLOTB);
  bf16x8 qr[4];
  #pragma unroll
  for(int d0=0;d0<4;++d0)qr[d0]=*reinterpret_cast<const bf16x8*>(&Qw[(long)r32*QP+d0*16+hi*8]);
  float mhat=0.f,l_reg=0.f;f32x16 o[2];o[0]=f32x16{};o[1]=f32x16{};f32x16 negm=f32x16{};asm volatile("":"+v"(negm));
  const int qrel=wid*QBLK+r32;
  #define CMASK(P0,P1,t) do{}while(0)
  bool resc=false;
  #define START(P0,P1) do{ const float rm=rowmax(P0,P1); resc=false; \
    { const float dl=rm; mhat=fadd_s(mhat,dl); \
      _Pragma("unroll") for(int r=0;r<16;++r){P0[r]=fsub_s(P0[r],dl);P1[r]=fsub_s(P1[r],dl);} \
      _Pragma("unroll") for(int r=0;r<16;++r)negm[r]=-mhat; asm volatile("":"+v"(negm)); } \
    _Pragma("unroll") for(int r=0;r<16;++r)P0[r]=__builtin_amdgcn_exp2f(P0[r]); }while(0)
  #define RESC() do{ if(resc){ asm volatile("s_waitcnt lgkmcnt(0)":::"memory"); \
      _Pragma("unroll") for(int d_=0;d_<2;++d_) _Pragma("unroll") for(int r=0;r<16;++r)o[d_][r]*=wsf[crow(r,hi)]; } }while(0)
  f32x16 pA0,pA1,pB0,pB1;
  int sl_prev=0,sl_cur=0,sl_next=SLOTB;
  #define ROT() do{sl_prev=sl_cur;sl_cur=sl_next;sl_next=(sl_next==(NSLOT-1)*SLOTB)?0:sl_next+SLOTB;}while(0)
  DMA_K(2,2*SLOTB);
  WAIT_BAR(3);
  qkt(pA0,pA1,Kbase,qr,negm,r32,hi);asm volatile("s_nop 15\n\ts_nop 7":"+v"(pA0),"+v"(pA1));CMASK(pA0,pA1,0);
  START(pA0,pA1);
  _Pragma("unroll") for(int r=0;r<16;++r)pA1[r]=__builtin_amdgcn_exp2f(pA1[r]);
  WAIT_BAR(0);
  DMA_K(3,0);DMA_V(1,SLOTB);
  ROT();
  kload8(kf,kp0+sl_cur);
  WAIT_BAR(2);
  s16x4 vlo[8],vhi[8]; u32x4 pw0,pw1,pw2,pw3;
  #define PKW(P,B) cvtpk_s(P[B],P[B+1])
  #define PAF(k) __builtin_bit_cast(bf16x8,pw##k)
  #define VFR(i) (bf16x8){vlo[i][0],vlo[i][1],vlo[i][2],vlo[i][3],vhi[i][0],vhi[i][1],vhi[i][2],vhi[i][3]}
  #define PIN(x) asm volatile("":"+v"(x))
  #define MX3(a,b,c) __builtin_fmaxf(__builtin_fmaxf((a),(b)),(c))
  #define GAPA(MF,A0,A1,A2,A3,W0,W1,PW) do{ MF; sacc+=A0; sacc+=A1; sacc+=A2; sacc+=A3; PIN(sacc); W0; W1; PIN(PW); SBAR(); }while(0)
  #define EX(v) __builtin_amdgcn_exp2f(v)
  #define GAPB(MF,X,B) do{ MF; X[B]=EX(X[B]); X[B+1]=EX(X[B+1]); X[B+2]=EX(X[B+2]); X[B+3]=EX(X[B+3]); PIN(X); SBAR(); }while(0)
  #define VRD(i) do{ vlo[i]=vtr(vp_+(((i)>>2)*4096+((i)&3)*1024)); vhi[i]=vtr(vp_+(((i)>>2)*4096+((i)&3)*1024+512)); }while(0)
  #define KRD(G,j) do{ if(G){ kload2(kf,kp0+sl_next,j); SBAR(); } }while(0)
  #define STEP(C0,C1,P0,P1,t,GK,GV,GL) do{ SBAR(); \
    const lds_cptr vp_=vp0+sl_prev; \
    VRD(0); SBAR(); float sacc=(P0[0]+P0[1]); \
    GAPA(C0=__builtin_amdgcn_mfma_f32_32x32x16_bf16(kf[0],qr[0],negm,0,0,0), P0[2],P0[3],P0[4],P0[5],     pw0[0]=PKW(P0,0), pw0[1]=PKW(P0,2), pw0); \
    VRD(4); SBAR(); GAPA(C1=__builtin_amdgcn_mfma_f32_32x32x16_bf16(kf[1],qr[0],negm,0,0,0), P0[6],P0[7],P0[8],P0[9],     pw0[2]=PKW(P0,4), pw0[3]=PKW(P0,6), pw0); \
    VRD(1); SBAR(); GAPA(C0=__builtin_amdgcn_mfma_f32_32x32x16_bf16(kf[2],qr[1],C0,0,0,0),   P0[10],P0[11],P0[12],P0[13], pw1[0]=PKW(P0,8), pw1[1]=PKW(P0,10), pw1); \
    VRD(5); SBAR(); GAPA(C1=__builtin_amdgcn_mfma_f32_32x32x16_bf16(kf[3],qr[1],C1,0,0,0),   P0[14],P0[15],P1[0],P1[1],   pw1[2]=PKW(P0,12),pw1[3]=PKW(P0,14), pw1); \
    VRD(2); SBAR(); GAPA(C0=__builtin_amdgcn_mfma_f32_32x32x16_bf16(kf[4],qr[2],C0,0,0,0),   P1[2],P1[3],P1[4],P1[5],     pw2[0]=PKW(P1,0), pw2[1]=PKW(P1,2), pw2); \
    VRD(6); SBAR(); GAPA(C1=__builtin_amdgcn_mfma_f32_32x32x16_bf16(kf[5],qr[2],C1,0,0,0),   P1[6],P1[7],P1[8],P1[9],     pw2[2]=PKW(P1,4), pw2[3]=PKW(P1,6), pw2); \
    VRD(3); SBAR(); GAPA(C0=__builtin_amdgcn_mfma_f32_32x32x16_bf16(kf[6],qr[3],C0,0,0,0),   P1[10],P1[11],P1[12],P1[13], pw3[0]=PKW(P1,8), pw3[1]=PKW(P1,10), pw3); \
    VRD(7); SBAR(); GAPA(C1=__builtin_amdgcn_mfma_f32_32x32x16_bf16(kf[7],qr[3],C1,0,0,0),   P1[14],P1[15],0.f,0.f,       pw3[2]=PKW(P1,12),pw3[3]=PKW(P1,14), pw3); \
    l_reg+=sacc; \
    if(GK){DMA_K((t)+3,sl_cur);} if(GV){DMA_V((t)+1,sl_next);} \
    CMASK(C0,C1,t); \
    { float a=MX3(C0[0],C0[1],C1[0]),b=MX3(C0[2],C0[3],C1[1]); a=MX3(a,C1[2],C1[3]); \
      _Pragma("unroll") for(int r=4;r<16;r+=4){a=MX3(a,C0[r],C0[r+1]);b=MX3(b,C0[r+2],C0[r+3]);a=MX3(a,C1[r],C1[r+1]);b=MX3(b,C1[r+2],C1[r+3]);} \
      float rm=__builtin_fmaxf(a,b); { auto rr=__builtin_amdgcn_permlane32_swap(__float_as_uint(rm),__float_as_uint(rm),false,false); rm=__builtin_fmaxf(__uint_as_float(rr[0]),__uint_as_float(rr[1])); } \
      resc=false; \
      if(__builtin_expect(__any(rm>(float)THRL),0)){ const float dl=__builtin_fmaxf(rm,0.f); mhat+=dl; \
        _Pragma("unroll") for(int r=0;r<16;++r){C0[r]-=dl;C1[r]-=dl;} \
        _Pragma("unroll") for(int r=0;r<16;++r)negm[r]=-mhat; asm volatile("":"+v"(negm)); \
        const float f=__builtin_amdgcn_exp2f(-dl); l_reg*=f; if(hi==0)wsf[r32]=f; resc=true; } } \
    SBAR(); \
    GAPB(o[0]=__builtin_amdgcn_mfma_f32_32x32x16_bf16(PAF(0),VFR(0),o[0],0,0,0), C0,0); \
    GAPB(o[1]=__builtin_amdgcn_mfma_f32_32x32x16_bf16(PAF(0),VFR(4),o[1],0,0,0), C0,4); \
    KRD(GL,0); GAPB(o[0]=__builtin_amdgcn_mfma_f32_32x32x16_bf16(PAF(1),VFR(1),o[0],0,0,0), C0,8); \
    KRD(GL,1); GAPB(o[1]=__builtin_amdgcn_mfma_f32_32x32x16_bf16(PAF(1),VFR(5),o[1],0,0,0), C0,12); \
    KRD(GL,2); GAPB(o[0]=__builtin_amdgcn_mfma_f32_32x32x16_bf16(PAF(2),VFR(2),o[0],0,0,0), C1,0); \
    KRD(GL,3); GAPB(o[1]=__builtin_amdgcn_mfma_f32_32x32x16_bf16(PAF(2),VFR(6),o[1],0,0,0), C1,4); \
    GAPB(o[0]=__builtin_amdgcn_mfma_f32_32x32x16_bf16(PAF(3),VFR(3),o[0],0,0,0), C1,8); \
    GAPB(o[1]=__builtin_amdgcn_mfma_f32_32x32x16_bf16(PAF(3),VFR(7),o[1],0,0,0), C1,12); \
    }while(0)
  int t=1;
  #undef CMASK
  #define CMASK(P0,P1,t) do{}while(0)
  for(;t+5<NT;t+=2){
    STEP(pB0,pB1,pA0,pA1,t,true,true,true);     WAIT_BAR(2); RESC(); ROT();
    STEP(pA0,pA1,pB0,pB1,t+1,true,true,true);   WAIT_BAR(2); RESC(); ROT();
  }
  #undef CMASK
  #define CMASK(P0,P1,t) do{}while(0)
  #define ENDW(tt) do{ if((tt)+3<NT){WAIT_BAR(2);} else if((tt)+2<NT){WAIT_BAR(1);} else {WAIT_BAR(0);} }while(0)
  for(;t+1<NT;t+=2){
    STEP(pB0,pB1,pA0,pA1,t,(t+3<NT),(t+1<NT),(t+1<NT));       ENDW(t);   RESC(); ROT();
    STEP(pA0,pA1,pB0,pB1,t+1,(t+4<NT),(t+2<NT),(t+2<NT));     ENDW(t+1); RESC(); ROT();
  }
  STEP(pB0,pB1,pA0,pA1,NT-1,false,false,false); RESC();
  { float sacc=pB0[0]+pB0[1]; _Pragma("unroll") for(int r=2;r<16;++r)sacc+=pB0[r]; _Pragma("unroll") for(int r=0;r<16;++r)sacc+=pB1[r]; l_reg+=sacc;
    pw0=(u32x4){PKW(pB0,0),PKW(pB0,2),PKW(pB0,4),PKW(pB0,6)};pw1=(u32x4){PKW(pB0,8),PKW(pB0,10),PKW(pB0,12),PKW(pB0,14)};pw2=(u32x4){PKW(pB1,0),PKW(pB1,2),PKW(pB1,4),PKW(pB1,6)};pw3=(u32x4){PKW(pB1,8),PKW(pB1,10),PKW(pB1,12),PKW(pB1,14)};
    SBAR(); pv(o,vb0+sl_cur,PAF(0),PAF(1),PAF(2),PAF(3)); }
  #undef PKW
  #undef PAF
  #undef VFR
  #undef PIN
  #undef MX3
  #undef GAPA
  #undef GAPB
  #undef EX
  #undef VRD
  #undef KRD
  #undef STEP
  #undef ENDW
  {auto rr=__builtin_amdgcn_permlane32_swap(__float_as_uint(l_reg),__float_as_uint(l_reg),false,false);l_reg=__uint_as_float(rr[0])+__uint_as_float(rr[1]);}
  if(hi==0)wsf[32+r32]=l_reg;asm volatile("s_waitcnt lgkmcnt(0)":::"memory");
  float rli[16];
  #pragma unroll
  for(int r=0;r<16;++r)rli[r]=__builtin_amdgcn_rcpf(wsf[32+crow(r,hi)]);

  { bf16*stg=(bf16*)(shm+LDS_OST)+wid*2048;
    #pragma unroll
    for(int r=0;r<16;++r){const int orow=crow(r,hi);
      #pragma unroll
      for(int d0=0;d0<2;++d0)stg[orow*64+d0*32+r32]=__float2bfloat16(o[d0][r]*rli[r]);}
    asm volatile("s_waitcnt lgkmcnt(0)":::"memory");
    #pragma unroll
    for(int i=0;i<4;++i){const int row=i*8+(lane>>3),ch=lane&7; const u32x4 v=*(const u32x4*)(stg+row*64+ch*8); if(STORE)ATTN_STORE16(Ow+(long)row*OP+ch*8,v);} }
  asm volatile("s_waitcnt lgkmcnt(0)\n\ts_barrier":::"memory");
  #undef DMA_K
  #undef DMA_V
  #undef CMASK
  #undef START
  #undef RESC
  #undef ROT
}
constexpr int ATTN_LDS_BYTES=LDS_BYTES;
#undef SBAR
#undef WAIT_BAR
}
#define DEVI __device__ __forceinline__
typedef unsigned short bf16_t;
typedef short bf16x8 __attribute__((ext_vector_type(8)));
typedef float f32x4 __attribute__((ext_vector_type(4)));
typedef unsigned u32x4 __attribute__((ext_vector_type(4)));
typedef unsigned u32x2 __attribute__((ext_vector_type(2)));
typedef short s16x4 __attribute__((ext_vector_type(4)));
#define LAS __attribute__((address_space(3)))

constexpr int T = 98304, TP = 65536, DM = 1024, INW = 2816, DFF = 2816, MEMROWS = 8704;
constexpr int NWAVES = 8;
constexpr float LOG2E = 1.4426950408889634f;
constexpr size_t MiB = 1u << 20;
constexpr size_t W_IN = 0, W_OUT = W_IN + (size_t)2816 * 1024, W_Q = W_OUT + (size_t)1024 * 1024, W_KV = W_Q + (size_t)256 * 1024, W_O = W_KV + (size_t)512 * 1024,
                 W_UP = W_O + (size_t)1024 * 256, W_DN = W_UP + (size_t)5632 * 1024, W_GLU = W_DN + (size_t)1024 * 2816, W_LAYER = W_GLU + (size_t)256 * 256;
constexpr size_t WS_W = 1 * MiB, WS_TAB = 54 * MiB, WS_XK = 55 * MiB, WS_XVT = 64 * MiB, WS_ACT1 = 75 * MiB, WS_BIG = 267 * MiB;
static_assert(WS_W + 2 * W_LAYER * 2 <= WS_TAB, "weights fit");
constexpr size_t TAB_S5A = 0, TAB_S5B = 64 * 1024, TAB_ROPE = 640 * 1024, TAB_LB = 704 * 1024;
constexpr size_t XK_LAYER = (size_t)MEMROWS * 256;
constexpr size_t WS_PROJ = WS_BIG, WS_VTA = WS_BIG + 528 * MiB, WS_HB = WS_VTA + 48 * MiB, WS_ODB = WS_HB + 48 * MiB, WS_S5F = WS_ODB + 48 * MiB,
                 WS_HF = WS_S5F + 12 * MiB, WS_HD = WS_HF + 24 * MiB, WS_SS = 977 * MiB, WS_END = WS_SS + 7 * MiB;
constexpr size_t WS_MN = WS_BIG;
constexpr size_t WS_XQ = WS_BIG, WS_XO = WS_BIG + 48 * MiB;
constexpr size_t WS_G = WS_BIG, WS_H = WS_BIG + 352 * MiB;
static_assert(WS_H + 352 * MiB <= WS_SS && WS_HD + 1 * MiB <= WS_SS && WS_END <= 1024 * MiB, "workspace map");
constexpr int LDS_BYTES = 147456;
constexpr int WLDS = 16384;

struct Args { const float* in[33]; float* out; unsigned char* ws; int grid, pad; };

DEVI float wsum(float v) {
#pragma unroll
    for (int o = 1; o < 64; o <<= 1) v += __shfl_xor(v, o);
    return v;
}
DEVI unsigned cvtpk(float lo, float hi) { return pg8::cvt_pk_bf16(lo, hi); }
DEVI float bflo(unsigned u) { return __uint_as_float(u << 16); }
DEVI float bfhi(unsigned u) { return __uint_as_float(u & 0xffff0000u); }
DEVI float bf1(bf16_t h) { return __uint_as_float((unsigned)h << 16); }
DEVI bf16_t tobf(float f) { return (bf16_t)(cvtpk(f, 0.f) & 0xffffu); }
DEVI void wave_sync() { asm volatile("s_waitcnt lgkmcnt(0)" ::: "memory"); __builtin_amdgcn_wave_barrier(); asm volatile("" ::: "memory"); }
DEVI float sigmoidf_(float x) { return __builtin_amdgcn_rcpf(1.0f + __expf(-x)); }
DEVI void seq_of(int tok, int& start, int& len) { if (tok < TP) { start = tok & ~2047; len = 2048; } else { start = TP + ((tok - TP) & ~16383); len = 16384; } }
DEVI int batch_of(int tok) { return tok < TP ? (tok >> 11) : 32 + ((tok - TP) >> 14); }

DEVI float row_rstd(const float* SS, size_t row) { const f32x4* p = (const f32x4*)(SS + row * 16); const f32x4 a0 = p[0], a1 = p[1], a2 = p[2], a3 = p[3];
    const float s = ((a0[0] + a0[1]) + (a0[2] + a0[3])) + ((a1[0] + a1[1]) + (a1[2] + a1[3])) + ((a2[0] + a2[1]) + (a2[2] + a2[3])) + ((a3[0] + a3[1]) + (a3[2] + a3[3]));
    return rsqrtf(s * (1.0f / 1024.0f) + 1e-6f); }
DEVI void rows_rstd8(const float* SS, int row0, int fq, float (&rs)[8]) {
    f32x4 p[8];
#pragma unroll
    for (int i = 0; i < 8; ++i) p[i] = *(const f32x4*)(SS + (size_t)(row0 + (i >> 2) * 128 + (i & 3) * 16) * 16 + 4 * fq);
    asm volatile("" ::: "memory");
#pragma unroll
    for (int i = 0; i < 8; ++i) { float s = (p[i][0] + p[i][1]) + (p[i][2] + p[i][3]); s += __shfl_xor(s, 16); s += __shfl_xor(s, 32); rs[i] = rsqrtf(s * (1.0f / 1024.0f) + 1e-6f); }
}
struct EpiStore {
    static constexpr bool PERM = true, AFTER_DRAIN = false;
    bf16_t* O; int ldc; int tpn; bf16_t* TB; int tcs, trb, tsh; const float* SS;
    DEVI void operator()(const pg8::f32x4 (&acc)[2][2][4][2], const pg8::Unit& u, int, int, int, int) const {
        int t_ = threadIdx.x; asm volatile("" : "+v"(t_)); const int fr = t_ & 15, fq = (t_ >> 4) & 3, wid_ = __builtin_amdgcn_readfirstlane(t_ >> 6), wr = wid_ >> 2, wc = wid_ & 3;
        const int row0 = u.pm * 256 + wr * 64 + fr, col0 = u.pn * 256 + wc * 32 + 8 * fq;
        float rsv[8];
        if (SS) rows_rstd8(SS, row0, fq, rsv); else {
#pragma unroll
            for (int i = 0; i < 8; ++i) rsv[i] = 1.f; }
        if (u.pn == tpn) {
#pragma unroll
            for (int ai = 0; ai < 2; ++ai)
#pragma unroll
                for (int m = 0; m < 4; ++m) { const int row = row0 + ai * 128 + m * 16; bf16_t* tp = TB + (size_t)(row >> tsh) * trb + (row & ((1 << tsh) - 1)); const float rs = rsv[ai * 4 + m];
#pragma unroll
                    for (int bj = 0; bj < 2; ++bj) { const int tc = wc * 32 + 8 * fq + bj * 128;
#pragma unroll
                        for (int n = 0; n < 2; ++n)
#pragma unroll
                            for (int e = 0; e < 4; ++e) tp[(size_t)(tc + 4 * n + e) * tcs] = tobf(acc[ai][bj][m][n][e] * rs); } }
        } else {
#pragma unroll
            for (int ai = 0; ai < 2; ++ai)
#pragma unroll
                for (int m = 0; m < 4; ++m) { bf16_t* rowp = O + (size_t)(row0 + ai * 128 + m * 16) * ldc + col0; const float rs = rsv[ai * 4 + m];
#pragma unroll
                    for (int bj = 0; bj < 2; ++bj) { const pg8::f32x4 v0 = acc[ai][bj][m][0] * rs, v1 = acc[ai][bj][m][1] * rs; u32x4 w;
                        w.x = cvtpk(v0[0], v0[1]); w.y = cvtpk(v0[2], v0[3]); w.z = cvtpk(v1[0], v1[1]); w.w = cvtpk(v1[2], v1[3]);
                        *(u32x4*)(rowp + bj * 128) = w; } }
        }
    }
};
struct EpiGlu {
    static constexpr bool PERM = true, AFTER_DRAIN = false;
    const bf16_t* HB; bf16_t* O; const float* bias;
    DEVI void operator()(const pg8::f32x4 (&acc)[2][2][4][2], const pg8::Unit& u, int, int, int, int) const {
        int t_ = threadIdx.x; asm volatile("" : "+v"(t_)); const int fr = t_ & 15, fq = (t_ >> 4) & 3, wid_ = __builtin_amdgcn_readfirstlane(t_ >> 6), wr = wid_ >> 2, wc = wid_ & 3;
        const int row0 = u.pm * 256 + wr * 64 + fr, col0 = wc * 32 + 8 * fq;
        f32x4 bb[2][2];
#pragma unroll
        for (int bj = 0; bj < 2; ++bj)
#pragma unroll
            for (int n = 0; n < 2; ++n) bb[bj][n] = *(const f32x4*)(bias + col0 + bj * 128 + 4 * n);
#pragma unroll
        for (int ai = 0; ai < 2; ++ai) {
            u32x4 hv[4][2];
#pragma unroll
            for (int m = 0; m < 4; ++m)
#pragma unroll
                for (int bj = 0; bj < 2; ++bj) hv[m][bj] = *(const u32x4*)(HB + (size_t)(row0 + ai * 128 + m * 16) * 256 + col0 + bj * 128);
            asm volatile("" ::: "memory");
#pragma unroll
            for (int m = 0; m < 4; ++m) { const size_t row = row0 + ai * 128 + m * 16;
#pragma unroll
                for (int bj = 0; bj < 2; ++bj) { const int col = col0 + bj * 128; u32x4 w;
#pragma unroll
                    for (int n = 0; n < 2; ++n) { const f32x4 b = bb[bj][n]; const pg8::f32x4 v = acc[ai][bj][m][n]; const unsigned h0 = hv[m][bj][2 * n], h1 = hv[m][bj][2 * n + 1];
                        const float s0 = __builtin_amdgcn_rcpf(1.f + __expf(-(v[0] + b[0]))), s1 = __builtin_amdgcn_rcpf(1.f + __expf(-(v[1] + b[1])));
                        const float s2 = __builtin_amdgcn_rcpf(1.f + __expf(-(v[2] + b[2]))), s3 = __builtin_amdgcn_rcpf(1.f + __expf(-(v[3] + b[3])));
                        w[2 * n] = cvtpk(bflo(h0) * s0, bfhi(h0) * s1); w[2 * n + 1] = cvtpk(bflo(h1) * s2, bfhi(h1) * s3); }
                    *(u32x4*)(O + row * INW + 768 + col) = w; } }
            asm volatile("" ::: "memory"); }
    }
};
struct EpiRes {
    static constexpr bool PERM = false, AFTER_DRAIN = false;
    float* X; bf16_t* XB; float* SS; const float* S0; const float* S1; int split;
    DEVI void operator()(const pg8::f32x4 (&acc)[2][2][4][2], const pg8::Unit& u, int, int, int, int) const {
        int t_ = threadIdx.x; asm volatile("" : "+v"(t_)); const int fr = t_ & 15, fq = (t_ >> 4) & 3, wid_ = __builtin_amdgcn_readfirstlane(t_ >> 6), wr = wid_ >> 2, wc = wid_ & 3;
        const int row0 = u.pm * 256 + wr * 64 + fr, col0 = u.pn * 256 + wc * 32 + 4 * fq;
#pragma unroll
        for (int ai = 0; ai < 2; ++ai)
#pragma unroll
            for (int mp = 0; mp < 2; ++mp) {
                f32x4 xin[2][2][2];
#pragma unroll
                for (int mm = 0; mm < 2; ++mm) { const size_t row = (size_t)(row0 + ai * 128 + (2 * mp + mm) * 16);
                    const float* srcp = ((int)row < split ? S0 + row * 1024 : S1 + (row - split) * 1024) + col0;
#pragma unroll
                    for (int bj = 0; bj < 2; ++bj)
#pragma unroll
                        for (int n = 0; n < 2; ++n) xin[mm][bj][n] = *(const f32x4*)(srcp + bj * 128 + n * 16); }
                asm volatile("" ::: "memory");
#pragma unroll
                for (int mm = 0; mm < 2; ++mm) { const int m = 2 * mp + mm; const size_t row = (size_t)(row0 + ai * 128 + m * 16); float* rowp = X + row * 1024 + col0; bf16_t* rowb = XB + row * 1024 + col0; float ssq = 0.f;
#pragma unroll
                    for (int bj = 0; bj < 2; ++bj)
#pragma unroll
                        for (int n = 0; n < 2; ++n) { f32x4 x = xin[mm][bj][n]; const pg8::f32x4 a = acc[ai][bj][m][n];
                            x[0] += a[0]; x[1] += a[1]; x[2] += a[2]; x[3] += a[3]; *(f32x4*)(rowp + bj * 128 + n * 16) = x; ssq += (x[0] * x[0] + x[1] * x[1]) + (x[2] * x[2] + x[3] * x[3]);
                            u32x2 w; w.x = cvtpk(x[0], x[1]); w.y = cvtpk(x[2], x[3]); *(u32x2*)(rowb + bj * 128 + n * 16) = w; }
                    ssq += __shfl_xor(ssq, 16); ssq += __shfl_xor(ssq, 32);
                    if (fq == 0) SS[row * 16 + u.pn * 4 + wc] = ssq; }
                asm volatile("" ::: "memory");
            }
    }
};
struct EpiConv {
    static constexpr bool PERM = true, AFTER_DRAIN = false;
    const bf16_t* G; bf16_t* H; const float* cw; const float* cb; int tok0; const float* SS;
    DEVI void operator()(const pg8::f32x4 (&acc)[2][2][4][2], const pg8::Unit& u, int, int, int, int) const {
        int t_ = threadIdx.x; asm volatile("" : "+v"(t_)); const int fr = t_ & 15, fq = (t_ >> 4) & 3, wid_ = __builtin_amdgcn_readfirstlane(t_ >> 6), wr = wid_ >> 2, wc = wid_ & 3;
        const int row0 = u.pm * 256 + wr * 64 + fr, col0 = u.pn * 256 + wc * 32 + 8 * fq;
        float rsv[8]; rows_rstd8(SS, row0, fq, rsv);
#pragma unroll
        for (int bj = 0; bj < 2; ++bj) { const int col = col0 + bj * 128;
            float w0[8], w1[8], w2[8], b[8];
#pragma unroll
            for (int e = 0; e < 8; e += 4) { const f32x4 a0 = *(const f32x4*)(cw + col + e), a1 = *(const f32x4*)(cw + DFF + col + e), a2 = *(const f32x4*)(cw + 2 * DFF + col + e), bb = *(const f32x4*)(cb + col + e);
#pragma unroll
                for (int q = 0; q < 4; ++q) { w0[e + q] = a0[q]; w1[e + q] = a1[q]; w2[e + q] = a2[q]; b[e + q] = bb[q]; } }
#pragma unroll
            for (int ai = 0; ai < 2; ++ai) {
#pragma unroll
              for (int mp = 0; mp < 2; ++mp) {
                u32x4 gl[4], gm[4], gr[4];
#pragma unroll
                for (int m = 2 * mp; m < 2 * mp + 2; ++m) { const int row = row0 + ai * 128 + m * 16; const int tok = tok0 + row; int ss, sl; seq_of(tok, ss, sl); const int pos = tok - ss;
                    const bf16_t* gp = G + (size_t)row * DFF + col; const u32x4 z4 = {0u, 0u, 0u, 0u};
                    gm[m] = *(const u32x4*)gp; gl[m] = pos > 0 ? *(const u32x4*)(gp - DFF) : z4; gr[m] = pos < sl - 1 ? *(const u32x4*)(gp + DFF) : z4; }
                asm volatile("" ::: "memory");
#pragma unroll
                for (int m = 2 * mp; m < 2 * mp + 2; ++m) { const int row = row0 + ai * 128 + m * 16; const float rs = rsv[ai * 4 + m];
                    float o[8];
#pragma unroll
                    for (int e = 0; e < 4; ++e) { const unsigned l2 = gl[m][e], m2 = gm[m][e], r2 = gr[m][e];
                        const float c0 = b[2 * e] + w0[2 * e] * bflo(l2) + w1[2 * e] * bflo(m2) + w2[2 * e] * bflo(r2);
                        const float c1 = b[2 * e + 1] + w0[2 * e + 1] * bfhi(l2) + w1[2 * e + 1] * bfhi(m2) + w2[2 * e + 1] * bfhi(r2);
                        o[2 * e] = c0 * sigmoidf_(c0) * rs * acc[ai][bj][m][e >> 1][(2 * e) & 3]; o[2 * e + 1] = c1 * sigmoidf_(c1) * rs * acc[ai][bj][m][e >> 1][(2 * e + 1) & 3]; }
                    u32x4 w; w.x = cvtpk(o[0], o[1]); w.y = cvtpk(o[2], o[3]); w.z = cvtpk(o[4], o[5]); w.w = cvtpk(o[6], o[7]);
                    *(u32x4*)(H + (size_t)row * DFF + col) = w; }
                asm volatile("" ::: "memory"); } } }
    }
};
DEVI void transpose_item(const float* W, int K, int N, bf16_t* WT, float* scr, int item, int lane, const float* ksc = nullptr) {
    const int nblk = N / 32, kb = item / nblk, nb = item % nblk, k0 = 64 * kb, n0 = 32 * nb;
#pragma unroll 8
    for (int i = 0; i < 32; ++i) { const int kk = 2 * i + (lane >> 5); scr[kk * 33 + (lane & 31)] = W[(size_t)(k0 + kk) * N + n0 + (lane & 31)] * (ksc ? ksc[k0 + kk] : 1.0f); }
    wave_sync();
    const int c = lane & 7;
#pragma unroll
    for (int j = 0; j < 4; ++j) { const int n = (lane >> 3) + 8 * j; const float* s = scr + (8 * c) * 33 + n;
        u32x4 o; o.x = cvtpk(s[0 * 33], s[1 * 33]); o.y = cvtpk(s[2 * 33], s[3 * 33]); o.z = cvtpk(s[4 * 33], s[5 * 33]); o.w = cvtpk(s[6 * 33], s[7 * 33]);
        *(u32x4*)(WT + (size_t)(n0 + n) * K + k0 + 8 * c) = o; }
    wave_sync();
}
DEVI void norm_row(const float* xrow, const float* w, bf16_t* orow, float* copy, int lane) {
    const f32x4* xr = (const f32x4*)xrow + lane; f32x4 v[4]; float s = 0.f;
#pragma unroll
    for (int j = 0; j < 4; ++j) { v[j] = xr[64 * j]; s += (v[j][0] * v[j][0] + v[j][1] * v[j][1]) + (v[j][2] * v[j][2] + v[j][3] * v[j][3]); }
    if (copy) {
#pragma unroll
        for (int j = 0; j < 4; ++j) ((f32x4*)copy + lane)[64 * j] = v[j]; }
    const float r = rsqrtf(wsum(s) * (1.0f / 1024.0f) + 1e-6f);
    const f32x4* wr = (const f32x4*)w + lane;
#pragma unroll
    for (int j = 0; j < 4; ++j) { const f32x4 ww = wr[64 * j]; u32x2 o; o.x = cvtpk(v[j][0] * r * ww[0], v[j][1] * r * ww[1]); o.y = cvtpk(v[j][2] * r * ww[2], v[j][3] * r * ww[3]);
        ((u32x2*)orow + lane)[64 * j] = o; }
}
DEVI void copy_rows2(const float* xa, const float* xb_, bf16_t* oa, bf16_t* ob, float* ssa, float* ssb, int lane) {
    const f32x4* pa = (const f32x4*)xa + lane; const f32x4* pb = (const f32x4*)xb_ + lane; f32x4 v[4], u[4];
#pragma unroll
    for (int j = 0; j < 4; ++j) { v[j] = pa[64 * j]; u[j] = pb[64 * j]; }
    asm volatile("" ::: "memory");
    float s = 0.f, q = 0.f;
#pragma unroll
    for (int j = 0; j < 4; ++j) { s += (v[j][0] * v[j][0] + v[j][1] * v[j][1]) + (v[j][2] * v[j][2] + v[j][3] * v[j][3]); q += (u[j][0] * u[j][0] + u[j][1] * u[j][1]) + (u[j][2] * u[j][2] + u[j][3] * u[j][3]);
        u32x2 o; o.x = cvtpk(v[j][0], v[j][1]); o.y = cvtpk(v[j][2], v[j][3]); ((u32x2*)oa + lane)[64 * j] = o; u32x2 p; p.x = cvtpk(u[j][0], u[j][1]); p.y = cvtpk(u[j][2], u[j][3]); ((u32x2*)ob + lane)[64 * j] = p; }
    s = wsum(s); q = wsum(q);
    if (lane < 16) { ssa[lane] = lane == 0 ? s : 0.f; ssb[lane] = lane == 0 ? q : 0.f; }
}
DEVI void final_norm_rows2(float* xrow0, float* xrow1, const float* w, int lane) {
    f32x4* x0 = (f32x4*)xrow0 + lane; f32x4* x1 = (f32x4*)xrow1 + lane; f32x4 v[4], u[4];
#pragma unroll
    for (int j = 0; j < 4; ++j) { v[j] = x0[64 * j]; u[j] = x1[64 * j]; }
    asm volatile("" ::: "memory");
    float s = 0.f, q = 0.f;
#pragma unroll
    for (int j = 0; j < 4; ++j) { s += (v[j][0] * v[j][0] + v[j][1] * v[j][1]) + (v[j][2] * v[j][2] + v[j][3] * v[j][3]); q += (u[j][0] * u[j][0] + u[j][1] * u[j][1]) + (u[j][2] * u[j][2] + u[j][3] * u[j][3]); }
    const float r = rsqrtf(wsum(s) * (1.0f / 1024.0f) + 1e-6f), r2 = rsqrtf(wsum(q) * (1.0f / 1024.0f) + 1e-6f);
    const f32x4* wr = (const f32x4*)w + lane;
#pragma unroll
    for (int j = 0; j < 4; ++j) { const f32x4 ww = wr[64 * j]; f32x4 o, p; o[0] = v[j][0] * r * ww[0]; o[1] = v[j][1] * r * ww[1]; o[2] = v[j][2] * r * ww[2]; o[3] = v[j][3] * r * ww[3];
        p[0] = u[j][0] * r2 * ww[0]; p[1] = u[j][1] * r2 * ww[1]; p[2] = u[j][2] * r2 * ww[2]; p[3] = u[j][3] * r2 * ww[3]; x0[64 * j] = o; x1[64 * j] = p; }
}

template <class G, bool BATCH = true, bool STORE = true> DEVI void attn256(const bf16_t* qrow, const G& g, bf16_t* orow, float scale2, int lane) {
    const int fq = lane >> 4;
    const bf16x8 qb0 = *(const bf16x8*)(qrow + 8 * fq), qb1 = *(const bf16x8*)(qrow + 32 + 8 * fq);
    f32x4 st[16];
#pragma unroll
    for (int half = 0; half < 2; ++half) {
        bf16x8 ka[8][2];
#pragma unroll
        for (int i = 0; i < 8; ++i) { const bf16_t* kp = g.krow(8 * half + i); ka[i][0] = *(const bf16x8*)(kp + 8 * fq); ka[i][1] = *(const bf16x8*)(kp + 32 + 8 * fq); }
        asm volatile("" ::: "memory");
#pragma unroll
        for (int i = 0; i < 8; ++i) { f32x4 acc = {0.f, 0.f, 0.f, 0.f};
            acc = __builtin_amdgcn_mfma_f32_16x16x32_bf16(ka[i][0], qb0, acc, 0, 0, 0);
            acc = __builtin_amdgcn_mfma_f32_16x16x32_bf16(ka[i][1], qb1, acc, 0, 0, 0);
            st[8 * half + i] = acc; }
    }
    u32x4 vv0[4][4];
    if (BATCH) {
#pragma unroll
        for (int k4 = 0; k4 < 4; ++k4)
#pragma unroll
            for (int dt = 0; dt < 4; ++dt) vv0[k4][dt] = *(const u32x4*)g.vt(k4, dt);
        asm volatile("" ::: "memory");
    }
    float mx = -INFINITY;
    {   f32x4 bz[16];
#pragma unroll
        for (int nt = 0; nt < 16; ++nt)
#pragma unroll
            for (int r = 0; r < 4; ++r) bz[nt][r] = g.bias2(nt, r);
        asm volatile("" ::: "memory");
#pragma unroll
        for (int nt = 0; nt < 16; ++nt)
#pragma unroll
            for (int r = 0; r < 4; ++r) { const float v = st[nt][r] * scale2 + bz[nt][r]; st[nt][r] = v; mx = fmaxf(mx, v); } }
    mx = fmaxf(mx, __shfl_xor(mx, 16)); mx = fmaxf(mx, __shfl_xor(mx, 32));
    float sum = 0.f;
#pragma unroll
    for (int nt = 0; nt < 16; ++nt)
#pragma unroll
        for (int r = 0; r < 4; ++r) { const float p = __builtin_amdgcn_exp2f(st[nt][r] - mx); st[nt][r] = p; sum += p; }
    sum += __shfl_xor(sum, 16); sum += __shfl_xor(sum, 32);
    const float inv = 1.0f / sum;
    f32x4 o[4];
#pragma unroll
    for (int dt = 0; dt < 4; ++dt) o[dt] = (f32x4){0.f, 0.f, 0.f, 0.f};
    if (BATCH)
#pragma unroll
    for (int half = 0; half < 2; ++half) {
        u32x4 vv[4][4];
#pragma unroll
        for (int k4 = 0; k4 < 4; ++k4)
#pragma unroll
            for (int dt = 0; dt < 4; ++dt) { if (half == 0) vv[k4][dt] = vv0[k4][dt]; else vv[k4][dt] = *(const u32x4*)g.vt(4 + k4, dt); }
        asm volatile("" ::: "memory");
#pragma unroll
        for (int k4 = 0; k4 < 4; ++k4) { const int ks = 4 * half + k4;
            u32x4 pw; pw.x = cvtpk(st[2 * ks][0], st[2 * ks][1]); pw.y = cvtpk(st[2 * ks][2], st[2 * ks][3]); pw.z = cvtpk(st[2 * ks + 1][0], st[2 * ks + 1][1]); pw.w = cvtpk(st[2 * ks + 1][2], st[2 * ks + 1][3]);
            const bf16x8 pb = __builtin_bit_cast(bf16x8, pw);
#pragma unroll
            for (int dt = 0; dt < 4; ++dt) o[dt] = __builtin_amdgcn_mfma_f32_16x16x32_bf16(__builtin_bit_cast(bf16x8, vv[k4][dt]), pb, o[dt], 0, 0, 0); }
    }
    if (!BATCH) {
#pragma unroll
        for (int ks = 0; ks < 8; ++ks) {
            u32x4 pw; pw.x = cvtpk(st[2 * ks][0], st[2 * ks][1]); pw.y = cvtpk(st[2 * ks][2], st[2 * ks][3]); pw.z = cvtpk(st[2 * ks + 1][0], st[2 * ks + 1][1]); pw.w = cvtpk(st[2 * ks + 1][2], st[2 * ks + 1][3]);
            const bf16x8 pb = __builtin_bit_cast(bf16x8, pw);
#pragma unroll
            for (int dt = 0; dt < 4; ++dt) { const u32x4 vw = *(const u32x4*)g.vt(ks, dt);
                o[dt] = __builtin_amdgcn_mfma_f32_16x16x32_bf16(__builtin_bit_cast(bf16x8, vw), pb, o[dt], 0, 0, 0); } }
    }
#pragma unroll
    for (int dt = 0; dt < 4; ++dt) { u32x2 w; w.x = cvtpk(o[dt][0] * inv, o[dt][1] * inv); w.y = cvtpk(o[dt][2] * inv, o[dt][3] * inv); if (STORE || w.x == 0x12345678u) *(u32x2*)(orow + 16 * dt + 4 * fq) = w; }
}
struct NaGeom {
    const bf16_t* proj; const bf16_t* vta; const float* rpb; int seq_start, r, r0, qs, ks, h, fr, fq;
    DEVI const bf16_t* krow(int nt) const { const int i = nt >> 1, kc = 8 * (fr >> 2) + 4 * (nt & 1) + (fr & 3); const size_t tok = (size_t)(seq_start + (r0 + i) * 64 + ks + kc); return proj + tok * INW + 256 + h * 64; }
    DEVI const bf16_t* vt(int kstep, int dt) const { const int d = 16 * dt + fr; const size_t tok = (size_t)(seq_start + (r0 + kstep) * 64 + ks + 8 * fq); return vta + ((tok >> 6) * 256 + (size_t)(h * 64 + d)) * 64 + (tok & 63); }
    DEVI float bias2(int nt, int reg) const { const int i = nt >> 1, kcol = ks + 8 * fq + 4 * (nt & 1) + reg, qcol = qs + fr; const int c0 = min(max(qcol - 8, 0), 48);
        const bool in = (kcol >= c0) && (kcol < c0 + 16); const int dr = (r0 + i) - r + 7, dc = min(max(kcol - qcol, -15), 15) + 15;
        const float bv = rpb[(h * 15 + dr) * 31 + dc]; return in ? bv * LOG2E : -INFINITY; }
};
struct XaGeomL {
    const bf16_t* kl; const bf16_t* vtl; int fr, fq;
    DEVI const bf16_t* krow(int nt) const { return kl + (32 * (nt >> 1) + 8 * (fr >> 2) + 4 * (nt & 1) + (fr & 3)) * 72; }
    DEVI const bf16_t* vt(int kstep, int dt) const { return vtl + (16 * dt + fr) * 264 + 32 * kstep + 8 * fq; }
    DEVI float bias2(int, int) const { return 0.f; }
};
DEVI void s5_load_b(const float* S5B, int pg, int lane, bf16x8 (&bB)[8]) {
    const int fr = lane & 15, fq = lane >> 4;
    f32x4 x[8], y[8];
#pragma unroll
    for (int nt = 0; nt < 8; ++nt) { const float* src = S5B + ((size_t)pg * 64 + 16 * (nt & 3) + fr) * 32 + (nt >> 2) * 16 + 8 * (fq & 1); x[nt] = *(const f32x4*)src; y[nt] = *(const f32x4*)(src + 4); }
    asm volatile("" ::: "memory");
#pragma unroll
    for (int nt = 0; nt < 8; ++nt) { u32x4 w = {0u, 0u, 0u, 0u};
        if (fq < 2) { w.x = cvtpk(x[nt][0], x[nt][1]); w.y = cvtpk(x[nt][2], x[nt][3]); w.z = cvtpk(y[nt][0], y[nt][1]); w.w = cvtpk(y[nt][2], y[nt][3]); }
        bB[nt] = __builtin_bit_cast(bf16x8, w); }
}
DEVI void s5_bu_block(const bf16_t* Ubf, unsigned* BUX, const bf16x8 (&bB)[8], int lane) {
    const int fr = lane & 15, fq = lane >> 4;
    u32x4 aw = {0u, 0u, 0u, 0u}; if (fq < 2) aw = *(const u32x4*)(Ubf + fr * 16 + 8 * fq);
    const bf16x8 aU = __builtin_bit_cast(bf16x8, aw);
#pragma unroll
    for (int q = 0; q < 4; ++q) { f32x4 dre = {0.f, 0.f, 0.f, 0.f}, dim = {0.f, 0.f, 0.f, 0.f};
        dre = __builtin_amdgcn_mfma_f32_16x16x32_bf16(aU, bB[q], dre, 0, 0, 0); dim = __builtin_amdgcn_mfma_f32_16x16x32_bf16(aU, bB[q + 4], dim, 0, 0, 0);
#pragma unroll
        for (int r = 0; r < 4; ++r) BUX[(4 * fq + r) * 68 + 16 * q + fr] = cvtpk(dre[r], dim[r]); }
}
DEVI void s5_pass1(const bf16_t* proj, const float* S5A, const float* S5B, float* S5F, int l, unsigned char* wl, int gw, int NGW, int lane) {
    bf16_t* Ubf = (bf16_t*)wl;
    unsigned* BUX = (unsigned*)(wl + 512);
    const int srow = lane >> 2, spc = lane & 3;
    for (int u = gw; u < 768 * 32; u += NGW) {
        const int dir = u & 1, g = (u >> 1) & 15, chunk = u >> 5; const size_t cs = (size_t)chunk * 128;
        const int pg = (l * 2 + dir) * 16 + g; const int p = pg * 64 + lane;
        const f32x4 a4 = *(const f32x4*)(S5A + (size_t)p * 4); const float ar = a4[0], ai = a4[1];
        bf16x8 bB[8]; s5_load_b(S5B, pg, lane, bB);
        float xr = 0.f, xi = 0.f;
        const bf16_t* ub = proj + 768 + g * 16 + spc * 4;
        u32x2 cur = *(const u32x2*)(ub + ((dir ? cs + 112 : cs) + srow) * INW);
        for (int blk = 0; blk < 8; ++blk) {
            u32x2 nxt = cur;
            if (blk < 7) { const size_t tb = dir ? cs + 112 - 16 * (blk + 1) : cs + 16 * (blk + 1); nxt = *(const u32x2*)(ub + (tb + srow) * INW); }
            *(u32x2*)(Ubf + srow * 16 + spc * 4) = cur;
            wave_sync();
            s5_bu_block(Ubf, BUX, bB, lane);
            wave_sync();
#pragma unroll
            for (int k = 0; k < 16; ++k) { const int row = dir ? 15 - k : k; const unsigned bw = BUX[row * 68 + lane]; const float bur = bflo(bw), bui = bfhi(bw);
                const float nr = ar * xr - ai * xi + bur, ni = ar * xi + ai * xr + bui; xr = nr; xi = ni; }
            wave_sync();
            cur = nxt;
        }
        float* f = S5F + ((size_t)(chunk * 16 + g) * 2 + dir) * 128;
        f[lane] = xr; f[64 + lane] = xi;
    }
}
DEVI float gelu_tanh(float y) { const float z = 0.7978845608028654f * (y + 0.044715f * y * y * y); const float e = __expf(2.0f * z); const float th = 1.0f - 2.0f * __builtin_amdgcn_rcpf(1.0f + e); return 0.5f * y * (1.0f + th); }
DEVI void s5_pass2(const bf16_t* proj, const float* S5A, const float* S5B, const float* S5F, const float* cre, const float* cim, const float* dskip, bf16_t* HB,
                   int l, unsigned char* wl, int gw, int NGW, int lane) {
    bf16_t* Ubf = (bf16_t*)wl;
    unsigned* BUX = (unsigned*)(wl + 512);
    float* YL = (float*)(wl + 512 + 4352);
    const int srow = lane >> 2, spc = lane & 3, fr = lane & 15, fq = lane >> 4;
    for (int u = gw; u < 768 * 16; u += NGW) {
        const int g = u & 15, chunk = u >> 4; const int csi = chunk * 128; const size_t cs = (size_t)csi;
        int ss, sl; seq_of(csi, ss, sl); const int nch = sl >> 7, cj = (csi - ss) >> 7, cb0 = ss >> 7;
        const bf16_t* ub = proj + 768 + g * 16 + spc * 4;
        for (int dir = 0; dir < 2; ++dir) {
            const int pg = (l * 2 + dir) * 16 + g; const int p = pg * 64 + lane;
            const f32x4 a4 = *(const f32x4*)(S5A + (size_t)p * 4); const float ar = a4[0], ai = a4[1], pr = a4[2], pi = a4[3];
            bf16x8 bB[8]; s5_load_b(S5B, pg, lane, bB);
            bf16x8 Cb[4];
            { f32x4 cx[4], cy[4];
#pragma unroll
              for (int s = 0; s < 4; ++s) { const size_t o_ = ((size_t)pg * 16 + fr) * 64 + 16 * s + 4 * fq; cx[s] = *(const f32x4*)(cre + o_); cy[s] = *(const f32x4*)(cim + o_); }
              asm volatile("" ::: "memory");
#pragma unroll
              for (int s = 0; s < 4; ++s) { const f32x4 x = cx[s], y = cy[s]; u32x4 w;
                w.x = cvtpk(x[0], -y[0]); w.y = cvtpk(x[1], -y[1]); w.z = cvtpk(x[2], -y[2]); w.w = cvtpk(x[3], -y[3]); Cb[s] = __builtin_bit_cast(bf16x8, w); } }
            float xr = 0.f, xi = 0.f;
            {
                const int n = dir == 0 ? cj : nch - 1 - cj; const int c0 = dir == 0 ? cb0 : cb0 + nch - 1; const int cstep = dir == 0 ? 1 : -1;
                for (int i0 = 0; i0 < n; i0 += 8) { float fr_[8], fi_[8];
#pragma unroll
                    for (int j = 0; j < 8; ++j) { const int i = min(i0 + j, n - 1); const float* f = S5F + ((size_t)((c0 + cstep * i) * 16 + g) * 2 + dir) * 128; fr_[j] = f[lane]; fi_[j] = f[64 + lane]; }
#pragma unroll
                    for (int j = 0; j < 8; ++j) if (i0 + j < n) { const float nr = pr * xr - pi * xi + fr_[j], ni = pr * xi + pi * xr + fi_[j]; xr = nr; xi = ni; } }
            }
            u32x2 cur = *(const u32x2*)(ub + ((dir ? cs + 112 : cs) + srow) * INW);
            for (int blk = 0; blk < 8; ++blk) {
                const int tl0 = dir ? 112 - 16 * blk : 16 * blk;
                u32x2 nxt = cur;
                if (blk < 7) { const size_t tb = dir ? cs + 112 - 16 * (blk + 1) : cs + 16 * (blk + 1); nxt = *(const u32x2*)(ub + (tb + srow) * INW); }
                *(u32x2*)(Ubf + srow * 16 + spc * 4) = cur;
                wave_sync();
                s5_bu_block(Ubf, BUX, bB, lane);
                wave_sync();
#pragma unroll
                for (int k = 0; k < 16; ++k) { const int row = dir ? 15 - k : k; const unsigned bw = BUX[row * 68 + lane]; const float bur = bflo(bw), bui = bfhi(bw);
                    const float nr = ar * xr - ai * xi + bur, ni = ar * xi + ai * xr + bui; xr = nr; xi = ni;
                    BUX[row * 68 + lane] = cvtpk(xr, xi); }
                wave_sync();
                f32x4 acc = {0.f, 0.f, 0.f, 0.f};
#pragma unroll
                for (int s = 0; s < 4; ++s) { const bf16x8 a = *(const bf16x8*)((const bf16_t*)BUX + fr * 136 + 32 * s + 8 * fq); acc = __builtin_amdgcn_mfma_f32_16x16x32_bf16(a, Cb[s], acc, 0, 0, 0); }
#pragma unroll
                for (int r = 0; r < 4; ++r) { float* yp = YL + (tl0 + 4 * fq + r) * 17 + fr; if (dir == 0) *yp = acc[r]; else *yp += acc[r]; }
                wave_sync();
                cur = nxt;
            }
        }
        for (int i0 = 0; i0 < 32; i0 += 16) { bf16_t ur[16];
#pragma unroll
            for (int j = 0; j < 16; ++j) { const int idx = (i0 + j) * 64 + lane, t = idx >> 4, c = idx & 15; ur[j] = proj[(cs + t) * INW + 768 + g * 16 + c]; }
            asm volatile("" ::: "memory");
#pragma unroll
            for (int j = 0; j < 16; ++j) { const int idx = (i0 + j) * 64 + lane, t = idx >> 4, c = idx & 15;
                const float y = YL[t * 17 + c] + dskip[g * 16 + c] * bf1(ur[j]); HB[(cs + t) * 256 + g * 16 + c] = tobf(gelu_tanh(y)); } }
        wave_sync();
    }
}

template <int PASS> DEVI void hgrn_pass(const bf16_t* proj, const float* LB, float* HF, float* HD, bf16_t* OF, LAS unsigned char* wll, int l, unsigned char* wl, int gw, int NGW, int lane) {
    bf16_t* Qt = (bf16_t*)wl;
    bf16_t* Kt = (bf16_t*)(wl + 2304);
    bf16_t* Vt = (bf16_t*)(wl + 4608);
    bf16_t* K2t = (bf16_t*)(wl + 6656);
    float* EB = (float*)(wl + 8704);
    float* EC = (float*)(wl + 8960);
    const bf16_t* RZ = (const bf16_t*)(wl + 9216);
    const bf16_t* RV = (const bf16_t*)(wl + 11264);
    const bf16_t* RQ = (const bf16_t*)(wl + 13312);
    const int fr = lane & 15, fq = lane >> 4;
#define HG_DMA(tbv) do { _Pragma("unroll") for (int i_ = 0; i_ < 2; ++i_) { const int r_ = 8 * i_ + (lane >> 3); const size_t go_ = ((tbv) + (dir ? 15 - r_ : r_)) * INW + (lane & 7) * 8; \
        __builtin_amdgcn_global_load_lds((const unsigned*)(zb + go_), (LAS unsigned*)(wll + 9216 + i_ * 1024), 16, 0, 0); \
        __builtin_amdgcn_global_load_lds((const unsigned*)(vb + go_), (LAS unsigned*)(wll + 11264 + i_ * 1024), 16, 0, 0); \
        if (PASS == 2) __builtin_amdgcn_global_load_lds((const unsigned*)(qbp + go_), (LAS unsigned*)(wll + 13312 + i_ * 1024), 16, 0, 0); } \
        asm volatile("" ::: "memory"); } while (0)
    for (int u = gw; u < 192 * 8; u += NGW) {
        const int dir = u & 1, h = (u >> 1) & 3, chunk = u >> 3; const size_t cs = (size_t)chunk * 512;
        const float lb = LB[l * 256 + h * 64 + lane], oml = 1.f - lb;
        f32x4 S[4][4];
        float* hf = HF + (size_t)u * 4096;
        if (PASS == 2) {
#pragma unroll
            for (int mt = 0; mt < 4; ++mt)
#pragma unroll
                for (int nt = 0; nt < 4; ++nt)
#pragma unroll
                    for (int r = 0; r < 4; ++r) S[mt][nt][r] = hf[(16 * mt + 4 * fq + r) * 64 + 16 * nt + fr];
        } else {
#pragma unroll
            for (int mt = 0; mt < 4; ++mt)
#pragma unroll
                for (int nt = 0; nt < 4; ++nt) S[mt][nt] = (f32x4){0.f, 0.f, 0.f, 0.f};
        }
        float bsum = 0.f;
        const bf16_t* zb = proj + (dir ? 2048 : 1792) + h * 64;
        const bf16_t* vb = proj + 2304 + h * 64;
        const bf16_t* qbp = proj + 1536 + h * 64;
        size_t tb = dir ? cs + 496 : cs;
        asm volatile("s_waitcnt vmcnt(0)" ::: "memory");
        HG_DMA(tb);
        asm volatile("s_waitcnt vmcnt(0)" ::: "memory");
        for (int blk = 0; blk < 32; ++blk) {
            if (blk > 0) { if (PASS == 2) asm volatile("s_waitcnt vmcnt(16)" ::: "memory"); else asm volatile("s_waitcnt vmcnt(0)" ::: "memory"); }
            wave_sync();
            float bs[16]; unsigned omp[8]; float c = 0.f, Bt = 0.f;
            { float b = 0.f;
#pragma unroll
              for (int s = 0; s < 16; ++s) { const float e = __expf(fminf(fmaxf(bf1(RZ[s * 64 + lane]), -20.f), 20.f)); const float o_ = oml * __builtin_amdgcn_rcpf(1.f + e);
                  if (s & 1) omp[s >> 1] |= (unsigned)tobf(o_) << 16; else omp[s >> 1] = (unsigned)tobf(o_);
                  b += __logf(1.f - o_); bs[s] = b; }
              c = bs[7]; Bt = b; }
            bsum += Bt;
            { u32x4 va, vbw; unsigned vw[8];
#pragma unroll
              for (int s = 0; s < 16; s += 2) vw[s >> 1] = (unsigned)RV[s * 64 + lane] | ((unsigned)RV[(s + 1) * 64 + lane] << 16);
              va.x = vw[0]; va.y = vw[1]; va.z = vw[2]; va.w = vw[3]; vbw.x = vw[4]; vbw.y = vw[5]; vbw.z = vw[6]; vbw.w = vw[7];
              *(u32x4*)(Vt + lane * 16) = va; *(u32x4*)(Vt + lane * 16 + 8) = vbw; }
            { u32x4 k2a, k2b; unsigned k2w[8];
#pragma unroll
              for (int s = 0; s < 16; s += 2) {
                  const float om0 = bflo(omp[s >> 1]), om1 = bfhi(omp[s >> 1]), b0 = bs[s], b1 = bs[s + 1];
                  const float k2_0 = om0 * __expf(Bt - b0), k2_1 = om1 * __expf(Bt - b1); k2w[s >> 1] = cvtpk(k2_0, k2_1);
                  Kt[s * 72 + lane] = tobf(om0 * __expf(c - b0)); Kt[(s + 1) * 72 + lane] = tobf(om1 * __expf(c - b1));
                  if (PASS == 2) { Qt[s * 72 + lane] = tobf(bf1(RQ[s * 64 + lane]) * __expf(b0 - c)); Qt[(s + 1) * 72 + lane] = tobf(bf1(RQ[(s + 1) * 64 + lane]) * __expf(b1 - c)); } }
              k2a.x = k2w[0]; k2a.y = k2w[1]; k2a.z = k2w[2]; k2a.w = k2w[3]; k2b.x = k2w[4]; k2b.y = k2w[5]; k2b.z = k2w[6]; k2b.w = k2w[7];
              *(u32x4*)(K2t + lane * 16) = k2a; *(u32x4*)(K2t + lane * 16 + 8) = k2b;
              EB[lane] = __expf(Bt); EC[lane] = __expf(c); }
            wave_sync();
            const size_t tcur = tb;
            if (blk < 31) { tb = dir ? tb - 16 : tb + 16; HG_DMA(tb); }
            s16x4 vB[4];
#pragma unroll
            for (int nt = 0; nt < 4; ++nt) vB[nt] = *(const s16x4*)(Vt + (16 * nt + fr) * 16 + 4 * fq);
            if (PASS == 2) {
                f32x4 at = {0.f, 0.f, 0.f, 0.f};
#pragma unroll
                for (int ks = 0; ks < 2; ++ks) { const bf16x8 ka = *(const bf16x8*)(Kt + fr * 72 + 32 * ks + 8 * fq), qb = *(const bf16x8*)(Qt + fr * 72 + 32 * ks + 8 * fq);
                    at = __builtin_amdgcn_mfma_f32_16x16x32_bf16(ka, qb, at, 0, 0, 0); }
#pragma unroll
                for (int r = 0; r < 4; ++r) at[r] = (4 * fq + r <= fr) ? at[r] : 0.f;
                u32x2 aw; aw.x = cvtpk(at[0], at[1]); aw.y = cvtpk(at[2], at[3]); const s16x4 aP = __builtin_bit_cast(s16x4, aw);
                bf16x8 qP[2];
#pragma unroll
                for (int ks = 0; ks < 2; ++ks) { const u32x2 x = *(const u32x2*)(Qt + fr * 72 + 32 * ks + 4 * fq), y = *(const u32x2*)(Qt + fr * 72 + 32 * ks + 16 + 4 * fq); u32x4 w; w.x = x.x; w.y = x.y; w.z = y.x; w.w = y.y; qP[ks] = __builtin_bit_cast(bf16x8, w); }
                f32x4 ec[4];
#pragma unroll
                for (int mt = 0; mt < 4; ++mt) ec[mt] = *(const f32x4*)(EC + 16 * mt + 4 * fq);
#pragma unroll
                for (int nt = 0; nt < 4; ++nt) { f32x4 o = {0.f, 0.f, 0.f, 0.f};
#pragma unroll
                    for (int ks = 0; ks < 2; ++ks) { const f32x4 e0 = ec[2 * ks], e1 = ec[2 * ks + 1]; u32x4 w; w.x = cvtpk(S[2 * ks][nt][0] * e0[0], S[2 * ks][nt][1] * e0[1]); w.y = cvtpk(S[2 * ks][nt][2] * e0[2], S[2 * ks][nt][3] * e0[3]);
                        w.z = cvtpk(S[2 * ks + 1][nt][0] * e1[0], S[2 * ks + 1][nt][1] * e1[1]); w.w = cvtpk(S[2 * ks + 1][nt][2] * e1[2], S[2 * ks + 1][nt][3] * e1[3]);
                        o = __builtin_amdgcn_mfma_f32_16x16x32_bf16(qP[ks], __builtin_bit_cast(bf16x8, w), o, 0, 0, 0); }
                    o = __builtin_amdgcn_mfma_f32_16x16x16bf16_1k(aP, vB[nt], o, 0, 0, 0);
#pragma unroll
                    for (int r = 0; r < 4; ++r) { const int t = 4 * fq + r; const int tl = dir ? 15 - t : t;
                        (OF + tcur * INW + (dir ? 2048 : 1792) + h * 64 + 16 * nt)[tl * INW + fr] = tobf(o[r]); } }
            }
#pragma unroll
            for (int mt = 0; mt < 4; ++mt) { const s16x4 k2A = *(const s16x4*)(K2t + (16 * mt + fr) * 16 + 4 * fq);
                const f32x4 eb = *(const f32x4*)(EB + 16 * mt + 4 * fq);
#pragma unroll
                for (int nt = 0; nt < 4; ++nt) { f32x4 cin; cin[0] = S[mt][nt][0] * eb[0]; cin[1] = S[mt][nt][1] * eb[1]; cin[2] = S[mt][nt][2] * eb[2]; cin[3] = S[mt][nt][3] * eb[3];
                    S[mt][nt] = __builtin_amdgcn_mfma_f32_16x16x16bf16_1k(k2A, vB[nt], cin, 0, 0, 0); } }
        }
        if (PASS == 1) {
#pragma unroll
            for (int mt = 0; mt < 4; ++mt)
#pragma unroll
                for (int nt = 0; nt < 4; ++nt)
#pragma unroll
                    for (int r = 0; r < 4; ++r) hf[(16 * mt + 4 * fq + r) * 64 + 16 * nt + fr] = S[mt][nt][r];
            HD[(size_t)u * 64 + lane] = __expf(bsum);
        }
    }
#undef HG_DMA
}
DEVI void hgrn_chain(float* HF, const float* HD, int gw, int NGW, int lane) {
    for (int w = gw; w < 34 * 8 * 4; w += NGW) {
        const int slab = w & 3, dir = (w >> 2) & 1, h = (w >> 3) & 3, sq = w >> 5;
        const int cb0 = sq < 32 ? sq * 4 : 128 + (sq - 32) * 32, nch = sq < 32 ? 4 : 32;
        float C[16], F[16], Dd[16];
#pragma unroll
        for (int k = 0; k < 16; ++k) C[k] = 0.f;
        { const int ci = dir ? nch - 1 : 0; const size_t uidx = ((size_t)(cb0 + ci) * 4 + h) * 2 + dir; const float* hf = HF + uidx * 4096 + (size_t)slab * 16 * 64 + lane; const float* hd = HD + uidx * 64 + slab * 16;
#pragma unroll
          for (int k = 0; k < 16; ++k) { F[k] = hf[k * 64]; Dd[k] = hd[k]; } }
        for (int i = 0; i < nch; ++i) { const int ci = dir ? nch - 1 - i : i; const size_t uidx = ((size_t)(cb0 + ci) * 4 + h) * 2 + dir;
            float* hf = HF + uidx * 4096 + (size_t)slab * 16 * 64 + lane;
            float Fn[16], Dn[16];
            { const int i2 = min(i + 1, nch - 1); const int ci2 = dir ? nch - 1 - i2 : i2; const size_t u2 = ((size_t)(cb0 + ci2) * 4 + h) * 2 + dir; const float* hf2 = HF + u2 * 4096 + (size_t)slab * 16 * 64 + lane; const float* hd2 = HD + u2 * 64 + slab * 16;
#pragma unroll
              for (int k = 0; k < 16; ++k) { Fn[k] = hf2[k * 64]; Dn[k] = hd2[k]; } }
#pragma unroll
            for (int k = 0; k < 16; ++k) { hf[k * 64] = C[k]; C[k] = Dd[k] * C[k] + F[k]; }
#pragma unroll
            for (int k = 0; k < 16; ++k) { F[k] = Fn[k]; Dd[k] = Dn[k]; } }
    }
}

DEVI void qk_finish(bf16_t* base, unsigned a, unsigned b, const f32x4 cs4, const f32x4 nw, float sc, int i) {
    float x0 = bflo(a), x1 = bfhi(a), y0 = bflo(b), y1 = bfhi(b);
    float s = x0 * x0 + x1 * x1 + y0 * y0 + y1 * y1;
    s += __shfl_xor(s, 1); s += __shfl_xor(s, 2); s += __shfl_xor(s, 4); s += __shfl_xor(s, 8);
    const float r = rsqrtf(s * (1.0f / 64.0f) + 1e-6f);
    x0 *= r * nw[0]; x1 *= r * nw[1]; y0 *= r * nw[2]; y1 *= r * nw[3];
    const float o0 = (x0 * cs4[0] - y0 * cs4[1]) * sc, o1 = (x1 * cs4[2] - y1 * cs4[3]) * sc, p0 = (y0 * cs4[0] + x0 * cs4[1]) * sc, p1 = (y1 * cs4[2] + x1 * cs4[3]) * sc;
    *(unsigned*)(base + 2 * i) = cvtpk(o0, o1); *(unsigned*)(base + 32 + 2 * i) = cvtpk(p0, p1);
}
DEVI void qk_prep(bf16_t* proj, const float* qw, const float* kw, const float* rope, int gw, int NGW, int lane) {
    const int i = lane & 15;
    const f32x4 qn = {qw[2 * i], qw[2 * i + 1], qw[32 + 2 * i], qw[33 + 2 * i]}, kn = {kw[2 * i], kw[2 * i + 1], kw[32 + 2 * i], kw[33 + 2 * i]};
    for (int tok0 = gw; tok0 < T; tok0 += 4 * NGW) {
        unsigned qa[4], qb[4], ka[4], kb[4]; f32x4 cs[4];
#pragma unroll
        for (int j = 0; j < 4; ++j) { const int tok = min(tok0 + j * NGW, T - 1);
            int ss, sl; seq_of(tok, ss, sl); const int pos = tok - ss, pr = pos >> 6, pc = pos & 63; const int pp = (2 * i < 16) ? pr : pc, fi = (2 * i) & 15;
            cs[j] = *(const f32x4*)(rope + ((size_t)pp * 16 + fi) * 2);
            const bf16_t* bq = proj + (size_t)tok * INW + 1024 + (lane >> 4) * 64; const bf16_t* bk = proj + (size_t)tok * INW + 1280 + ((lane >> 4) & 1) * 64;
            qa[j] = *(const unsigned*)(bq + 2 * i); qb[j] = *(const unsigned*)(bq + 32 + 2 * i); ka[j] = *(const unsigned*)(bk + 2 * i); kb[j] = *(const unsigned*)(bk + 32 + 2 * i); }
        asm volatile("" ::: "memory");
#pragma unroll
        for (int j = 0; j < 4; ++j) { const int tok = tok0 + j * NGW; if (tok < T) {
            qk_finish(proj + (size_t)tok * INW + 1024 + (lane >> 4) * 64, qa[j], qb[j], cs[j], qn, 0.125f * LOG2E, i);
            if (lane < 32) qk_finish(proj + (size_t)tok * INW + 1280 + (lane >> 4) * 64, ka[j], kb[j], cs[j], kn, 1.0f, i); } }
    }
}
DEVI void merge_row_finish(bf16_t* row, const u32x2 (&in)[6], const f32x4 (&w)[4]) {
#pragma unroll
    for (int gi = 0; gi < 4; ++gi) {
        const u32x2 a = in[gi]; float v0 = bflo(a.x), v1 = bfhi(a.x), v2 = bflo(a.y), v3 = bfhi(a.y);
        if (gi == 3) { const u32x2 b = in[4]; v0 += bflo(b.x); v1 += bfhi(b.x); v2 += bflo(b.y); v3 += bfhi(b.y); }
        const float s = wsum(v0 * v0 + v1 * v1 + v2 * v2 + v3 * v3); const float r = rsqrtf(s * (1.0f / 256.0f) + 1e-6f);
        v0 *= r * w[gi][0]; v1 *= r * w[gi][1]; v2 *= r * w[gi][2]; v3 *= r * w[gi][3];
        if (gi == 3) { const u32x2 g = in[5]; const float g0 = bflo(g.x), g1 = bfhi(g.x), g2 = bflo(g.y), g3 = bfhi(g.y);
            v0 *= g0 * sigmoidf_(g0); v1 *= g1 * sigmoidf_(g1); v2 *= g2 * sigmoidf_(g2); v3 *= g3 * sigmoidf_(g3); }
        u32x2 o; o.x = cvtpk(v0, v1); o.y = cvtpk(v2, v3); *(u32x2*)(row + gi * 256) = o;
    }
}
DEVI void merge_norm(bf16_t* proj, const float* gw_, int gwv, int NGW, int lane) {
    f32x4 w[4];
#pragma unroll
    for (int gi = 0; gi < 4; ++gi) w[gi] = *(const f32x4*)(gw_ + gi * 256 + 4 * lane);
    for (int tok = gwv; tok < T; tok += 2 * NGW) {
        bf16_t* r0 = proj + (size_t)tok * INW + 4 * lane; const bool two = tok + NGW < T; bf16_t* r1 = proj + (size_t)(two ? tok + NGW : tok) * INW + 4 * lane;
        u32x2 a[6], b[6];
        a[0] = *(const u32x2*)(r0); a[1] = *(const u32x2*)(r0 + 768); a[2] = *(const u32x2*)(r0 + 1024); a[3] = *(const u32x2*)(r0 + 1792); a[4] = *(const u32x2*)(r0 + 2048); a[5] = *(const u32x2*)(r0 + 2560);
        b[0] = *(const u32x2*)(r1); b[1] = *(const u32x2*)(r1 + 768); b[2] = *(const u32x2*)(r1 + 1024); b[3] = *(const u32x2*)(r1 + 1792); b[4] = *(const u32x2*)(r1 + 2048); b[5] = *(const u32x2*)(r1 + 2560);
        asm volatile("" ::: "memory");
        merge_row_finish(r0, a, w);
        if (two) merge_row_finish(r1, b, w);
    }
}
#define XB_TMO      128
#define XB_XCNT(j)  (256  + 64 * (j))
#define XB_XSUB(j)  (1280 + 64 * (j))
#define XB_XGEN(j)  (2304 + 64 * (j))
#define XB_TOP      3328
#define XB_TOPGEN   3392
#define XCD_BAR_WORDS 3456
#define XB_SPIN_CAP (1u << 18)

__device__ __forceinline__ unsigned xb_ld(unsigned* p)              { return __hip_atomic_load(p, __ATOMIC_RELAXED, __HIP_MEMORY_SCOPE_AGENT); }
__device__ __forceinline__ unsigned xb_add(unsigned* p, unsigned v) { return __hip_atomic_fetch_add(p, v, __ATOMIC_RELAXED, __HIP_MEMORY_SCOPE_AGENT); }
__device__ __forceinline__ unsigned xb_xcc_id() { return (unsigned)__builtin_amdgcn_s_getreg((3 << 11) | 20) & 0xFu; }
#define XB_SPIN(cond, bar) do { unsigned _sp = 0; while (cond) { __builtin_amdgcn_s_sleep(1); \
    if ((++_sp & 255u) == 0u) { if (xb_ld(&(bar)[XB_TMO])) break; if (_sp > XB_SPIN_CAP) { atomicAdd(&(bar)[XB_TMO], 1u); break; } } } } while (0)

struct XcdBarrier {
    unsigned* bar; unsigned x;
    volatile LAS unsigned* st;
};

__device__ __forceinline__ XcdBarrier xcd_barrier_post(unsigned* bar, volatile LAS unsigned* st) {
    XcdBarrier b; b.bar = bar; b.x = xb_xcc_id(); b.st = st;
    if (threadIdx.x == 0) (void)xb_add(&bar[XB_XCNT(b.x)], 1u);
    return b;
}
__device__ __forceinline__ void xcd_barrier_complete(unsigned* bar, unsigned x, unsigned& nloc, unsigned& nx) {
    const unsigned G = gridDim.x * gridDim.y * gridDim.z;
    unsigned sum, cnt, mine, sp = 0u;
    for (;;) {
        sum = 0u; cnt = 0u; mine = 0u;
#pragma unroll
        for (unsigned j = 0; j < 16; ++j) { const unsigned c = xb_ld(&bar[XB_XCNT(j)]); sum += c; cnt += (c > 0u) ? 1u : 0u; mine = (j == x) ? c : mine; }
        if (sum == G) break;
        __builtin_amdgcn_s_sleep(1);
        if ((++sp & 255u) == 0u) { if (xb_ld(&bar[XB_TMO])) break; if (sp > XB_SPIN_CAP) { atomicAdd(&bar[XB_TMO], 1u); break; } }
    }
    nloc = mine > 0u ? mine : 1u; nx = cnt > 0u ? cnt : 1u;
}

__device__ __forceinline__ void xcd_barrier(const XcdBarrier& b) {
    asm volatile("s_waitcnt vmcnt(0)" ::: "memory");
    __syncthreads();
    if (threadIdx.x == 0) {
        unsigned* bar = b.bar;
        __builtin_amdgcn_s_waitcnt(0);
        unsigned nloc = b.st[0], nx = b.st[1];
        if (nloc == 0u) { xcd_barrier_complete(bar, b.x, nloc, nx); b.st[0] = nloc; b.st[1] = nx; }
        const unsigned old = xb_add(&bar[XB_XSUB(b.x)], 1u);
        const unsigned gen = old / nloc;
        if (old + 1u == (gen + 1u) * nloc) {
            __builtin_amdgcn_fence(__ATOMIC_RELEASE, "agent");
            asm volatile("s_waitcnt vmcnt(0)" ::: "memory");
            const unsigned og = xb_add(&bar[XB_TOP], 1u);
            const unsigned tg = og / nx;
            if (og + 1u == (tg + 1u) * nx) xb_add(&bar[XB_TOPGEN], 1u);
            else XB_SPIN(xb_ld(&bar[XB_TOPGEN]) == tg, bar);
            __builtin_amdgcn_fence(__ATOMIC_ACQUIRE, "agent");
            xb_add(&bar[XB_XGEN(b.x)], 1u);
            asm volatile("s_waitcnt vmcnt(0)" ::: "memory");
        } else {
            XB_SPIN(xb_ld(&bar[XB_XGEN(b.x)]) == gen, bar);
            __builtin_amdgcn_fence(__ATOMIC_ACQUIRE, "agent");
            asm volatile("s_waitcnt vmcnt(0)" ::: "memory");
        }
    }
    __syncthreads();
}
typedef const Args __attribute__((address_space(4)))* ArgsP;
DEVI ArgsP argsp() { ArgsP p = (ArgsP)__builtin_amdgcn_kernarg_segment_ptr(); asm volatile("" : "+s"(p)); return p; }
DEVI int wave_id() { int t = threadIdx.x; asm volatile("" : "+v"(t)); return __builtin_amdgcn_readfirstlane(t >> 6); }
DEVI int lane_id() { int t = threadIdx.x; asm volatile("" : "+v"(t)); return t & 63; }
#define AIN(k) (argsp()->in[k])
#define WSP(off) (argsp()->ws + (off))
#define Wt ((bf16_t*)WSP(WS_W))
#define S5A ((float*)WSP(WS_TAB + TAB_S5A))
#define S5B ((float*)WSP(WS_TAB + TAB_S5B))
#define ROPE ((float*)WSP(WS_TAB + TAB_ROPE))
#define LBT ((float*)WSP(WS_TAB + TAB_LB))
#define XK ((bf16_t*)WSP(WS_XK))
#define XVT ((bf16_t*)WSP(WS_XVT))
#define ACT1 ((bf16_t*)WSP(WS_ACT1))
#define PROJ ((bf16_t*)WSP(WS_PROJ))
#define VTA ((bf16_t*)WSP(WS_VTA))
#define HB ((bf16_t*)WSP(WS_HB))
#define ODB ((bf16_t*)WSP(WS_ODB))
#define S5F ((float*)WSP(WS_S5F))
#define HF ((float*)WSP(WS_HF))
#define HD ((float*)WSP(WS_HD))
#define MN ((bf16_t*)WSP(WS_MN))
#define XQ ((bf16_t*)WSP(WS_XQ))
#define XO ((bf16_t*)WSP(WS_XO))
#define GB ((bf16_t*)WSP(WS_G))
#define HH ((bf16_t*)WSP(WS_H))
#define SSQ ((float*)WSP(WS_SS))
#define X (argsp()->out)
#define GRIDN (argsp()->grid)
#define WCTX const int lane = lane_id(), wave = wave_id(), G = GRIDN, gw = (int)blockIdx.x * NWAVES + wave, NGW = G * NWAVES; unsigned char* wl = lds + wave * WLDS; (void)lane; (void)gw; (void)NGW; (void)wl
#define SYNC_CG() cg::this_grid().sync()
#define SYNC() do { XcdBarrier b_; b_.bar = (unsigned*)WSP(4096); b_.x = xb_xcc_id(); b_.st = (volatile LAS unsigned*)(lds + 131072); xcd_barrier(b_); } while (0)
#ifndef REP_GEMM
#define REP_GEMM 1
#endif
#ifndef REP_GQA
#define REP_GQA 1
#endif
#ifndef REP_XA
#define REP_XA 1
#endif
#ifndef REP_S5
#define REP_S5 1
#endif
#ifndef REP_HG
#define REP_HG 1
#endif
#ifndef REP_NA
#define REP_NA 1
#endif
#define GEMM_CALL(EPI, KC_, g_, S_, E_) pg8::gemm_phase<EPI, pg8::StaticOrder, true, true, KC_>((PG8_LAS unsigned char*)lds, g_, S_, E_)
#define GEMM_CALL_LDA(EPI, KC_, LDA_, g_, S_, E_) pg8::gemm_phase<EPI, pg8::StaticOrder, true, true, KC_, LDA_>((PG8_LAS unsigned char*)lds, g_, S_, E_)
#define WL_(l) (Wt + (size_t)(l) * W_LAYER)
__global__ void __launch_bounds__(NWAVES * 64, 2) fwd_mega(Args a_unused) {
    extern __shared__ __attribute__((aligned(16))) unsigned char lds[];
    if (threadIdx.x < 64) ((volatile LAS unsigned*)(lds + 131072))[threadIdx.x] = 0u;
    __syncthreads();
    (void)xcd_barrier_post((unsigned*)WSP(4096), (volatile LAS unsigned*)(lds + 131072));
    {
        WCTX; float* scr = (float*)wl;
        for (int l = 0; l < 2; ++l) {
            bf16_t* wl_ = WL_(l);
            constexpr int I0 = 16 * 88, I1 = I0 + 16 * 32, I2 = I1 + 16 * 8, I3 = I2 + 16 * 16, I4 = I3 + 4 * 32, I5 = I4 + 16 * 176, I6 = I5 + 44 * 32, I7 = I6 + 4 * 8;
            for (int it = gw; it < I7; it += NGW) {
                if (it < I0) transpose_item(AIN(5) + (size_t)l * 1024 * 2816, 1024, 2816, wl_ + W_IN, scr, it, lane, AIN(4) + l * 1024);
                else if (it < I1) transpose_item(AIN(21) + (size_t)l * 1024 * 1024, 1024, 1024, wl_ + W_OUT, scr, it - I0, lane);
                else if (it < I2) transpose_item(AIN(24) + (size_t)l * 1024 * 256, 1024, 256, wl_ + W_Q, scr, it - I1, lane, AIN(22) + l * 1024);
                else if (it < I3) transpose_item(AIN(25) + (size_t)l * 1024 * 512, 1024, 512, wl_ + W_KV, scr, it - I2, lane);
                else if (it < I4) transpose_item(AIN(26) + (size_t)l * 256 * 1024, 256, 1024, wl_ + W_O, scr, it - I3, lane);
                else if (it < I5) transpose_item(AIN(28) + (size_t)l * 1024 * 5632, 1024, 5632, wl_ + W_UP, scr, it - I4, lane, AIN(27) + l * 1024);
                else if (it < I6) transpose_item(AIN(31) + (size_t)l * 2816 * 1024, 2816, 1024, wl_ + W_DN, scr, it - I5, lane);
                else transpose_item(AIN(15) + (size_t)l * 256 * 256, 256, 256, wl_ + W_GLU, scr, it - I6, lane);
            }
        }
        const int gt = (int)blockIdx.x * (NWAVES * 64) + (int)threadIdx.x, NGT = G * NWAVES * 64;
        for (int idx = gt; idx < 4096; idx += NGT) {
            const int ldg = idx >> 6;
            const double lre = fmin((double)AIN(7)[idx], -1e-4), lim = (double)AIN(8)[idx], dt = exp((double)AIN(9)[ldg]);
            const double mag = exp(lre * dt), are = mag * cos(lim * dt), aim = mag * sin(lim * dt);
            const double mag2 = exp(lre * dt * 128.0), pre = mag2 * cos(lim * dt * 128.0), pim = mag2 * sin(lim * dt * 128.0);
            const double den = lre * lre + lim * lim, nre = are - 1.0, nim = aim;
            const double cr = (nre * lre + nim * lim) / den, ci = (nim * lre - nre * lim) / den;
            float* sa = S5A; float* sb = S5B;
            sa[idx * 4 + 0] = (float)are; sa[idx * 4 + 1] = (float)aim; sa[idx * 4 + 2] = (float)pre; sa[idx * 4 + 3] = (float)pim;
            for (int c = 0; c < 16; ++c) { const double br = (double)AIN(10)[(size_t)idx * 16 + c], bi = (double)AIN(11)[(size_t)idx * 16 + c];
                sb[(size_t)idx * 32 + c] = (float)(cr * br - ci * bi); sb[(size_t)idx * 32 + 16 + c] = (float)(cr * bi + ci * br); }
        }
        for (int idx = gt; idx < 4096; idx += NGT) {
            const int p = idx >> 4, f = idx & 15; const float inv = (float)exp(-(double)f * (log(10000.0) / 16.0)); const float ang = (float)p * inv;
            float* rp = ROPE; rp[idx * 2] = (float)cos((double)ang); rp[idx * 2 + 1] = (float)sin((double)ang);
        }
        for (int idx = gt; idx < 512; idx += NGT) {
            const int c = idx & 255; const float p0 = AIN(19)[c], p1 = AIN(19)[256 + c];
            LBT[idx] = idx < 256 ? 0.f : 1.0f / (1.0f + __expf(p1 - p0));
        }
        for (int r = gw; r < 2 * MEMROWS; r += NGW) {
            const int l = r / MEMROWS, row = r % MEMROWS;
            const float* src = row < 8192 ? AIN(2) + (size_t)row * 1024 : AIN(3) + (size_t)(row - 8192) * 1024;
            norm_row(src, AIN(23) + l * 1024, MN + (size_t)r * 1024, nullptr, lane);
        }
        for (int r = gw; r < T; r += 2 * NGW) {
            const int r2 = r + NGW < T ? r + NGW : r;
            const float* s0 = r < TP ? AIN(0) + (size_t)r * 1024 : AIN(1) + (size_t)(r - TP) * 1024; const float* s1 = r2 < TP ? AIN(0) + (size_t)r2 * 1024 : AIN(1) + (size_t)(r2 - TP) * 1024;
            copy_rows2(s0, s1, ACT1 + (size_t)r * 1024, ACT1 + (size_t)r2 * 1024, SSQ + (size_t)r * 16, SSQ + (size_t)r2 * 16, lane);
        }
    }
    SYNC_CG();
    for (int l = 0; l < 2; ++l) {
        pg8::Gemm g{MN + (size_t)l * MEMROWS * 1024, WL_(l) + W_KV, MEMROWS, 512, 1024}; pg8::StaticOrder S; S.init(MEMROWS, 512, GRIDN, (int)blockIdx.x);
        EpiStore E{XK + (size_t)l * XK_LAYER, 256, 1, XVT + (size_t)l * XK_LAYER, 256, 65536, 8, nullptr};
        GEMM_CALL(EpiStore, 1024, g, S, E);
    }
    SYNC();
    for (int l = 0; l < 2; ++l) {
        {
            pg8::Gemm g{ACT1, WL_(l) + W_IN, T, INW, 1024}; EpiStore E{PROJ, INW, 2, VTA, 64, 16384, 6, SSQ}; pg8::StaticOrder S; S.init(T, INW, GRIDN, (int)blockIdx.x);
            for (int rep = 0; rep < REP_GEMM; ++rep) GEMM_CALL(EpiStore, 1024, g, S, E);
        }
        SYNC();
        {
            WCTX;
            qk_prep(PROJ, AIN(17) + l * 64, AIN(18) + l * 64, ROPE, gw, NGW, lane);
            for (int rep = 0; rep < REP_S5; ++rep) s5_pass1(PROJ, S5A, S5B, S5F, l, wl, gw, NGW, lane);
            for (int rep = 0; rep < REP_HG; ++rep) hgrn_pass<1>(PROJ, LBT, HF, HD, nullptr, (LAS unsigned char*)lds + wave * WLDS, l, wl, gw, NGW, lane);
#if REP_NA > 1
#define ATTN_NA attn256<NaGeom, true, false>
            for (int w = gw; w < (T / 16) * 4; w += NGW) {
                const int h = w & 3, blk = w >> 2, tok0 = blk * 16; int ss, sl; seq_of(tok0, ss, sl);
                const int pos = tok0 - ss, r = pos >> 6, cb = (pos & 63) >> 4, rows = sl >> 6;
                NaGeom ng; ng.proj = PROJ; ng.vta = VTA; ng.rpb = AIN(6) + (size_t)l * 4 * 15 * 31; ng.seq_start = ss; ng.r = r; ng.r0 = min(max(r - 4, 0), rows - 8);
                ng.qs = cb * 16; ng.ks = min(max(cb * 16 - 8, 0), 32); ng.h = h; ng.fr = lane & 15; ng.fq = lane >> 4;
                const size_t qtok = (size_t)tok0 + (lane & 15);
                ATTN_NA(ng.proj + qtok * INW + h * 64, ng, PROJ + qtok * INW + h * 64, 0.125f * LOG2E, lane);
            }
#undef ATTN_NA
#endif
#define ATTN_NA attn256<NaGeom, true, true>
            for (int w = gw; w < (T / 16) * 4; w += NGW) {
                const int h = w & 3, blk = w >> 2, tok0 = blk * 16; int ss, sl; seq_of(tok0, ss, sl);
                const int pos = tok0 - ss, r = pos >> 6, cb = (pos & 63) >> 4, rows = sl >> 6;
                NaGeom ng; ng.proj = PROJ; ng.vta = VTA; ng.rpb = AIN(6) + (size_t)l * 4 * 15 * 31; ng.seq_start = ss; ng.r = r; ng.r0 = min(max(r - 4, 0), rows - 8);
                ng.qs = cb * 16; ng.ks = min(max(cb * 16 - 8, 0), 32); ng.h = h; ng.fr = lane & 15; ng.fq = lane >> 4;
                const size_t qtok = (size_t)tok0 + (lane & 15);
                ATTN_NA(ng.proj + qtok * INW + h * 64, ng, PROJ + qtok * INW + h * 64, 0.125f * LOG2E, lane);
            }
#undef ATTN_NA
        }
        SYNC();
        {
            {
                const int G = GRIDN, bx = (int)blockIdx.x, wave = wave_id();
                const int vcu = (G % 8 == 0) ? (bx % 8) * (G / 8) + bx / 8 : bx;
                const int nun = (G == 256) ? 6 : (1536 + G - 1) / G;
                for (int ui = 0; ui < nun; ++ui) {
                    int sq, hh, qb;
                    if (G == 256) {
                        if (ui < 2) { const int grp = vcu >> 6; sq = 32 + (grp >> 1); hh = (grp & 1) * 2 + ui; qb = vcu & 63; }
                        else { const int pg = vcu >> 2, uu = (vcu & 3) * 4 + (ui - 2); sq = pg >> 1; hh = (pg & 1) * 2 + (uu >> 3); qb = uu & 7; }
                    } else {
                        const int idx = ui * G + bx; if (idx >= 1536) break;
                        if (idx < 512) { sq = 32 + (idx >> 8); hh = (idx >> 6) & 3; qb = idx & 63; } else { const int j = idx - 512; sq = j >> 5; hh = (j >> 3) & 3; qb = j & 7; }
                    }
                    const int ss = sq < 32 ? sq * 2048 : TP + (sq - 32) * 16384, sl = sq < 32 ? 2048 : 16384;
                    const size_t qrow = (size_t)ss + qb * 256 + wave * 32;
                    const bf16_t* pj = PROJ;
#if REP_GQA > 1
                    attn_body::attn_unit<8, false>(sl / 64, (const attn_body::bf16*)(pj + qrow * INW + 1024 + hh * 64), (const attn_body::bf16*)(pj + (size_t)ss * INW + 1280 + (hh >> 1) * 64),
                                            (const attn_body::bf16*)(pj + (size_t)ss * INW + 1408 + (hh >> 1) * 64), (attn_body::bf16*)(PROJ + qrow * INW + 1024 + hh * 64), (char*)lds);
#endif
                    attn_body::attn_unit<8>(sl / 64, (const attn_body::bf16*)(pj + qrow * INW + 1024 + hh * 64), (const attn_body::bf16*)(pj + (size_t)ss * INW + 1280 + (hh >> 1) * 64),
                                            (const attn_body::bf16*)(pj + (size_t)ss * INW + 1408 + (hh >> 1) * 64), (attn_body::bf16*)(PROJ + qrow * INW + 1024 + hh * 64), (char*)lds);
                }
            }
            __syncthreads();
            WCTX;
            for (int rep = 0; rep < REP_S5; ++rep) s5_pass2(PROJ, S5A, S5B, S5F, AIN(12), AIN(13), AIN(14) + l * 256, HB, l, wl, gw, NGW, lane);
            hgrn_chain(HF, HD, gw, NGW, lane);
        }
        SYNC();
        {
            { const int G = GRIDN, bx = (int)blockIdx.x; const bool split = (G == 256);
              pg8::Gemm g{HB, WL_(l) + W_GLU, T, 256, 256}; pg8::StaticOrder S; S.init(T, 256, split ? 64 : G, split ? (bx >= 192 ? bx - 192 : 0x3fffffff) : bx); EpiGlu E{HB, PROJ, AIN(16) + l * 256}; GEMM_CALL(EpiGlu, 256, g, S, E); }
            __syncthreads();
            WCTX;
            for (int rep = 0; rep < REP_HG; ++rep) hgrn_pass<2>(PROJ, LBT, HF, HD, PROJ, (LAS unsigned char*)lds + wave * WLDS, l, wl, gw, NGW, lane);
        }
        SYNC();
        { WCTX; merge_norm(PROJ, AIN(20) + l * 1024, gw, NGW, lane); }
        SYNC();
        { pg8::Gemm g{PROJ, WL_(l) + W_OUT, T, 1024, 1024}; EpiRes E{X, ACT1, SSQ, l == 0 ? AIN(0) : (const float*)X, l == 0 ? AIN(1) : (const float*)X + (size_t)TP * 1024, TP}; pg8::StaticOrder S; S.init(T, 1024, GRIDN, (int)blockIdx.x); GEMM_CALL_LDA(EpiRes, 1024, 2816, g, S, E); }
        SYNC();
        { pg8::Gemm g{ACT1, WL_(l) + W_Q, T, 256, 1024}; EpiStore E{XQ, 256, -1, nullptr, 0, 0, 0, SSQ}; pg8::StaticOrder S; S.init(T, 256, GRIDN, (int)blockIdx.x); GEMM_CALL(EpiStore, 1024, g, S, E); }
        SYNC();
        {
            WCTX;
            for (int rep = 0; rep < REP_XA; ++rep)
            for (int uidx = (int)blockIdx.x; uidx < 192; uidx += G) {
                const int h = uidx & 3, seg = uidx >> 2, tokS = seg * 2048, b = batch_of(tokS); int tid = (int)threadIdx.x; asm volatile("" : "+v"(tid));
                bf16_t* Kl = (bf16_t*)lds; bf16_t* VTl = (bf16_t*)(lds + 36864);
                const bf16_t* xk = XK + (size_t)l * XK_LAYER + (size_t)b * 65536 + h * 64;
                const bf16_t* xv = XVT + (size_t)l * XK_LAYER + ((size_t)b * 256 + h * 64) * 256;
#pragma unroll
                for (int i = tid; i < 2048; i += 512) { const int key = i >> 3, ch = i & 7; *(u32x4*)(Kl + key * 72 + ch * 8) = *(const u32x4*)(xk + (size_t)key * 256 + ch * 8); }
#pragma unroll
                for (int i = tid; i < 2048; i += 512) { const int d = i >> 5, ch = i & 31; *(u32x4*)(VTl + d * 264 + ch * 8) = *(const u32x4*)(xv + (size_t)d * 256 + ch * 8); }
                __syncthreads();
                XaGeomL xg; xg.kl = Kl; xg.vtl = VTl; xg.fr = lane & 15; xg.fq = lane >> 4;
                for (int t = wave; t < 128; t += NWAVES) { const size_t qt = (size_t)tokS + t * 16 + (lane & 15);
                    attn256<XaGeomL, false>(XQ + qt * 256 + h * 64, xg, XO + qt * 256 + h * 64, 0.125f * LOG2E, lane); }
                __syncthreads();
            }
        }
        SYNC();
        { pg8::Gemm g{XO, WL_(l) + W_O, T, 1024, 256}; EpiRes E{X, ACT1, SSQ, X, X, 0x7fffffff}; pg8::StaticOrder S; S.init(T, 1024, GRIDN, (int)blockIdx.x); GEMM_CALL(EpiRes, 256, g, S, E); }
        SYNC();
        for (int chunk = 0; chunk < 2; ++chunk) {
            { const int c_row0 = chunk ? TP : 0, c_rows = chunk ? (T - TP) : TP;
              pg8::Gemm g{ACT1 + (size_t)c_row0 * 1024, WL_(l) + W_UP + (size_t)DFF * 1024, c_rows, DFF, 1024}; EpiStore E{GB, DFF, -1, nullptr, 0, 0, 0, SSQ + (size_t)c_row0 * 16}; pg8::StaticOrder S; S.init(c_rows, DFF, GRIDN, (int)blockIdx.x);
              for (int rep = 0; rep < REP_GEMM; ++rep) GEMM_CALL(EpiStore, 1024, g, S, E); }
            SYNC();
            { const int c_row0 = chunk ? TP : 0, c_rows = chunk ? (T - TP) : TP;
              pg8::Gemm g{ACT1 + (size_t)c_row0 * 1024, WL_(l) + W_UP, c_rows, DFF, 1024}; pg8::StaticOrder S; S.init(c_rows, DFF, GRIDN, (int)blockIdx.x);
              EpiConv E{GB, HH, AIN(29) + (size_t)l * 3 * DFF, AIN(30) + (size_t)l * DFF, c_row0, SSQ + (size_t)c_row0 * 16};
              for (int rep = 0; rep < REP_GEMM; ++rep) GEMM_CALL(EpiConv, 1024, g, S, E); }
            SYNC();
            { const int c_row0 = chunk ? TP : 0, c_rows = chunk ? (T - TP) : TP;
              pg8::Gemm g{HH, WL_(l) + W_DN, c_rows, 1024, DFF}; EpiRes E{X + (size_t)c_row0 * 1024, ACT1 + (size_t)c_row0 * 1024, SSQ + (size_t)c_row0 * 16, X + (size_t)c_row0 * 1024, X, 0x7fffffff}; pg8::StaticOrder S; S.init(c_rows, 1024, GRIDN, (int)blockIdx.x); GEMM_CALL(EpiRes, 2816, g, S, E); }
            SYNC();
        }
        if (l == 1) { WCTX; for (int r = gw; r < T; r += 2 * NGW) { const int r1 = r + NGW < T ? r + NGW : r; if (r1 != r) final_norm_rows2(X + (size_t)r * 1024, X + (size_t)r1 * 1024, AIN(32), lane); else final_norm_rows2(X + (size_t)r * 1024, X + (size_t)r * 1024, AIN(32), lane); } }
    }
}

extern "C" void kernel_launch(void* const* d_in, const int* in_sizes, int n_in, void* d_out, int out_size, void* d_ws, size_t ws_size, hipStream_t stream) {
    static int grid = 0;
    if (grid == 0) {
        if (n_in != 33 || out_size != T * DM || ws_size < WS_END) { fprintf(stderr, "kernel_launch: unexpected shapes (n_in %d out %d ws %zu, need %zu)\n", n_in, out_size, ws_size, (size_t)WS_END); grid = -1; return; }
        int dev = 0, cus = 0, per_cu = 0;
        hipGetDevice(&dev); hipDeviceGetAttribute(&cus, hipDeviceAttributeMultiprocessorCount, dev);
        if (hipFuncSetAttribute((const void*)fwd_mega, hipFuncAttributeMaxDynamicSharedMemorySize, LDS_BYTES) != hipSuccess) { fprintf(stderr, "kernel_launch: hipFuncSetAttribute failed\n"); grid = -1; return; }
        hipOccupancyMaxActiveBlocksPerMultiprocessor(&per_cu, (const void*)fwd_mega, NWAVES * 64, LDS_BYTES);
        (void)hipGetLastError();
        if (per_cu < 1) per_cu = 1;
        grid = cus * 1;
        fprintf(stderr, "kernel_launch: cus %d per_cu %d grid %d\n", cus, per_cu, grid);
    }
    if (grid < 0) return;
    if (hipMemsetAsync(d_ws, 0, 65536, stream) != hipSuccess) { fprintf(stderr, "kernel_launch: memset failed\n"); return; }
    Args a{};
    for (int i = 0; i < 33; ++i) a.in[i] = (const float*)d_in[i];
    a.out = (float*)d_out; a.ws = (unsigned char*)d_ws; a.grid = grid; a.pad = 0;
    void* args[] = {&a};
    hipError_t e = hipLaunchCooperativeKernel((const void*)fwd_mega, dim3(grid), dim3(NWAVES * 64), args, LDS_BYTES, stream);
    if (e != hipSuccess) fprintf(stderr, "kernel_launch: cooperative launch failed: %s (grid %d)\n", hipGetErrorString(e), grid);
}
```
